# Optimizing an MI355X kernel written in HIP

```python
import jax, jax.numpy as jnp
from jax import lax
import numpy as np

D_MODEL = 1024
BATCH = 4
SEQ = 8192
DEPTH = 2

HEAD_DIM = 64
ATTN_WIDTH = D_MODEL // 2
N_Q_HEADS = ATTN_WIDTH // HEAD_DIM
N_KV_HEADS = 2
Q_PER_KV = N_Q_HEADS // N_KV_HEADS
KV_WIDTH = N_KV_HEADS * HEAD_DIM
WINDOW = 128
BLOCK = 128
CONV_WIDTH = D_MODEL // 4
CONV_KERNEL = 31
LRU_WIDTH = D_MODEL // 4
LRU_HEADS = 4
LRU_HEAD_DIM = LRU_WIDTH // LRU_HEADS
LRU_CONV_KERNEL = 4
LRU_C = 8.0
MIX_WIDTH = ATTN_WIDTH + CONV_WIDTH + LRU_WIDTH
IN_SPLIT_SIZES = (ATTN_WIDTH, KV_WIDTH, KV_WIDTH, CONV_WIDTH, CONV_WIDTH, LRU_WIDTH, LRU_WIDTH)
IN_WIDTH = sum(IN_SPLIT_SIZES)
IN_SPLIT_IDX = [int(v) for v in np.cumsum(IN_SPLIT_SIZES)[:-1]]
D_FF = 4 * D_MODEL
RMS_EPS = 1e-6
LN_EPS = 1e-5
MASK_VALUE = -1e30

kernel_name = "hymba_style_swa_conformer_rglru_hybrid"


def rms_norm(x, g):
    xf = x.astype(jnp.float32)
    y = xf * lax.rsqrt(jnp.mean(xf * xf, axis=-1, keepdims=True) + RMS_EPS)
    return (y * g.astype(jnp.float32)).astype(x.dtype)


def layer_norm(x, g, b):
    xf = x.astype(jnp.float32)
    mu = jnp.mean(xf, axis=-1, keepdims=True)
    xc = xf - mu
    y = xc * lax.rsqrt(jnp.mean(xc * xc, axis=-1, keepdims=True) + LN_EPS)
    return (y * g.astype(jnp.float32) + b.astype(jnp.float32)).astype(x.dtype)


def causal_depthwise_conv(x, w, b):
    k_width, c = w.shape
    out = lax.conv_general_dilated(
        x, w[:, None, :].astype(x.dtype), window_strides=(1,), padding=[(k_width - 1, 0)],
        dimension_numbers=("NWC", "WIO", "NWC"), feature_group_count=c)
    return out + b.astype(x.dtype)


def sliding_window_attention(q, k, v, sinks):
    b, s, _ = q.shape
    nb = s // BLOCK
    q = q.reshape(b, nb, BLOCK, N_KV_HEADS, Q_PER_KV, HEAD_DIM)
    k = k.reshape(b, nb, BLOCK, N_KV_HEADS, HEAD_DIM)
    v = v.reshape(b, nb, BLOCK, N_KV_HEADS, HEAD_DIM)
    k_band = jnp.concatenate([jnp.concatenate([jnp.zeros_like(k[:, :1]), k[:, :-1]], axis=1), k], axis=2)
    v_band = jnp.concatenate([jnp.concatenate([jnp.zeros_like(v[:, :1]), v[:, :-1]], axis=1), v], axis=2)
    scores = jnp.einsum("bnqhgd,bnkhd->bnhgqk", q, k_band).astype(jnp.float32) * (HEAD_DIM ** -0.5)
    blk = jnp.arange(nb)[:, None]
    q_pos = blk * BLOCK + jnp.arange(BLOCK)[None, :]
    k_pos = (blk - 1) * BLOCK + jnp.arange(2 * BLOCK)[None, :]
    diff = q_pos[:, :, None] - k_pos[:, None, :]
    mask = (diff >= 0) & (diff < WINDOW) & (k_pos[:, None, :] >= 0)
    scores = jnp.where(mask[None, :, None, None], scores, MASK_VALUE)
    sink = sinks.astype(jnp.float32).reshape(N_KV_HEADS, Q_PER_KV)[None, None, :, :, None, None]
    m = jnp.maximum(jnp.max(scores, axis=-1, keepdims=True), sink)
    p = jnp.exp(scores - m)
    probs = p / (jnp.sum(p, axis=-1, keepdims=True) + jnp.exp(sink - m))
    out = jnp.einsum("bnhgqk,bnkhd->bnqhgd", probs.astype(v.dtype), v_band)
    return out.reshape(b, s, ATTN_WIDTH)


def conformer_conv(u_val, u_gate, dw_w, dw_b, ln_g, ln_b):
    u = u_val * jax.nn.sigmoid(u_gate)
    u = causal_depthwise_conv(u, dw_w, dw_b)
    u = layer_norm(u, ln_g, ln_b)
    return jax.nn.silu(u)


def _linear_recurrence_combine(c1, c2):
    a1, b1 = c1
    a2, b2 = c2
    return a1 * a2, a2 * b1 + b2


def rglru_branch(u_x, u_gate, conv_w, conv_b, wa, ba, wx, bx, lam):
    xc = causal_depthwise_conv(u_x, conv_w, conv_b)
    b, s, _ = xc.shape
    xh = xc.reshape(b, s, LRU_HEADS, LRU_HEAD_DIM)
    r = jax.nn.sigmoid(jnp.einsum("bshi,hij->bshj", xh, wa) + ba).reshape(b, s, LRU_WIDTH)
    i = jax.nn.sigmoid(jnp.einsum("bshi,hij->bshj", xh, wx) + bx).reshape(b, s, LRU_WIDTH)
    log_a = (-LRU_C * r.astype(jnp.float32)) * jax.nn.softplus(-lam.astype(jnp.float32))
    a = jnp.exp(log_a)
    gated_x = jnp.sqrt(-jnp.expm1(2.0 * log_a)) * (i * xc).astype(jnp.float32)
    _, h = lax.associative_scan(_linear_recurrence_combine, (a, gated_x), axis=1)
    return h.astype(u_x.dtype) * jax.nn.gelu(u_gate)


def setup_inputs(seed: int = 0) -> dict:
    key = jax.random.key(seed)
    ks = jax.random.split(key, 24)
    f32 = jnp.float32

    def nrm(k, shape, scale):
        return jax.random.normal(k, shape, f32) * scale

    def gain(k, shape):
        return 1.0 + 0.02 * jax.random.normal(k, shape, f32)

    a0 = jax.random.uniform(ks[14], (DEPTH, LRU_WIDTH), f32, 0.9, 0.999)
    s0 = a0 ** (1.0 / LRU_C)
    lru_lambda = jnp.log(s0) - jnp.log1p(-s0)
    return {
        "x": jax.random.normal(ks[0], (BATCH, SEQ, D_MODEL), f32),
        "norm1": gain(ks[1], (DEPTH, D_MODEL)),
        "w_in": nrm(ks[2], (DEPTH, D_MODEL, IN_WIDTH), D_MODEL ** -0.5),
        "attn_sinks": nrm(ks[3], (DEPTH, N_Q_HEADS), 0.5),
        "conv_dw_w": nrm(ks[4], (DEPTH, CONV_KERNEL, CONV_WIDTH), CONV_KERNEL ** -0.5),
        "conv_dw_b": nrm(ks[5], (DEPTH, CONV_WIDTH), 0.01),
        "conv_ln_g": gain(ks[6], (DEPTH, CONV_WIDTH)),
        "conv_ln_b": nrm(ks[7], (DEPTH, CONV_WIDTH), 0.01),
        "lru_conv_w": nrm(ks[8], (DEPTH, LRU_CONV_KERNEL, LRU_WIDTH), LRU_CONV_KERNEL ** -0.5),
        "lru_conv_b": nrm(ks[9], (DEPTH, LRU_WIDTH), 0.01),
        "lru_wa": nrm(ks[10], (DEPTH, LRU_HEADS, LRU_HEAD_DIM, LRU_HEAD_DIM), LRU_HEAD_DIM ** -0.5),
        "lru_ba": nrm(ks[11], (DEPTH, LRU_HEADS, LRU_HEAD_DIM), 0.01),
        "lru_wx": nrm(ks[12], (DEPTH, LRU_HEADS, LRU_HEAD_DIM, LRU_HEAD_DIM), LRU_HEAD_DIM ** -0.5),
        "lru_bx": nrm(ks[13], (DEPTH, LRU_HEADS, LRU_HEAD_DIM), 0.01),
        "lru_lambda": lru_lambda,
        "mix_norm": gain(ks[15], (DEPTH, MIX_WIDTH)),
        "w_out": nrm(ks[16], (DEPTH, MIX_WIDTH, D_MODEL), MIX_WIDTH ** -0.5),
        "norm2": gain(ks[17], (DEPTH, D_MODEL)),
        "w_up": nrm(ks[18], (DEPTH, D_MODEL, D_FF), D_MODEL ** -0.5),
        "w_down": nrm(ks[19], (DEPTH, D_FF, D_MODEL), D_FF ** -0.5),
        "final_norm": gain(ks[20], (D_MODEL,)),
    }


def reference(x, norm1, w_in, attn_sinks, conv_dw_w, conv_dw_b, conv_ln_g, conv_ln_b,
              lru_conv_w, lru_conv_b, lru_wa, lru_ba, lru_wx, lru_bx, lru_lambda,
              mix_norm, w_out, norm2, w_up, w_down, final_norm):
    h = x
    a_end = ATTN_WIDTH
    c_end = ATTN_WIDTH + CONV_WIDTH
    for l in range(DEPTH):
        hn = rms_norm(h, norm1[l])
        z = hn @ w_in[l]
        q, k, v, c_val, c_gate, r_x, r_gate = jnp.split(z, IN_SPLIT_IDX, axis=-1)
        y_attn = sliding_window_attention(q, k, v, attn_sinks[l])
        y_conv = conformer_conv(c_val, c_gate, conv_dw_w[l], conv_dw_b[l], conv_ln_g[l], conv_ln_b[l])
        y_lru = rglru_branch(r_x, r_gate, lru_conv_w[l], lru_conv_b[l], lru_wa[l], lru_ba[l],
                             lru_wx[l], lru_bx[l], lru_lambda[l])
        g = mix_norm[l]
        y = jnp.concatenate([rms_norm(y_attn, g[:a_end]),
                             rms_norm(y_conv, g[a_end:c_end]),
                             rms_norm(y_lru, g[c_end:])], axis=-1)
        h = h + y @ w_out[l]
        hn = rms_norm(h, norm2[l])
        h = h + jnp.square(jax.nn.relu(hn @ w_up[l])) @ w_down[l]
    return rms_norm(h, final_norm)
```

```cpp
#include <hip/hip_runtime.h>
#include <cstdio>
#include <cstdint>

typedef unsigned short bf16;
typedef float f32x4 __attribute__((ext_vector_type(4)));
typedef unsigned u32x4 __attribute__((ext_vector_type(4)));

constexpr int D = 1024, BATCH = 4, SEQ = 8192, DEPTH = 2;
constexpr int M = BATCH * SEQ;
constexpr int NIN = 1792, FF = 4096;
constexpr int ZQ = 0, ZK = 512, ZV = 640, ZCV = 768, ZCG = 1024, ZRX = 1280, ZRG = 1536;
constexpr float RMS_EPS = 1e-6f, LN_EPS = 1e-5f;

constexpr size_t MiB = 1u << 20;
constexpr size_t WS_W = 2 * MiB, W_LAYER = 22 * MiB, W_IN = 0, W_OUT = 4 * MiB, W_UP = 6 * MiB, W_DOWN = 14 * MiB;
constexpr size_t WS_SS = 46 * MiB;
constexpr size_t WS_HB = 48 * MiB;
constexpr size_t WS_Z = 112 * MiB;
constexpr size_t WS_YMIX = 224 * MiB;
constexpr size_t WS_HH = 112 * MiB;
constexpr size_t WS_A = 288 * MiB;
constexpr size_t WS_GX = 320 * MiB;
constexpr size_t WS_YRAW = 368 * MiB;
constexpr size_t WS_END = 496 * MiB;

__device__ __forceinline__ unsigned f2bf(float f) { unsigned u = __builtin_bit_cast(unsigned, f); return (u + 0x7fffu + ((u >> 16) & 1u)) >> 16; }
__device__ __forceinline__ float bf2f(unsigned short b) { return __builtin_bit_cast(float, (unsigned)b << 16); }
__device__ __forceinline__ float wave_sum(float v) {
#pragma unroll
    for (int o = 1; o < 64; o <<= 1) v += __shfl_xor(v, o);
    return v;
}
__device__ __forceinline__ float sigmoidf_(float x) { return 1.f / (1.f + __expf(-x)); }

__global__ void __launch_bounds__(256) k_wprep(const float* W, const float* gain, int K, int N, bf16* WT) {
    __shared__ float scr_all[4][64 * 33];
    const int lane = threadIdx.x & 63, wave = threadIdx.x >> 6;
    float* scr = scr_all[wave];
    const int nblk = N / 32, nitems = (K / 64) * nblk;
    for (int item = blockIdx.x * 4 + wave; item < nitems; item += gridDim.x * 4) {
        const int kb = item / nblk, nb = item % nblk, k0 = 64 * kb, n0 = 32 * nb;
        for (int i = 0; i < 32; ++i) { const int kk = 2 * i + (lane >> 5);
            float g = gain ? gain[k0 + kk] : 1.f;
            scr[kk * 33 + (lane & 31)] = g * W[(size_t)(k0 + kk) * N + n0 + (lane & 31)]; }
        asm volatile("s_waitcnt lgkmcnt(0)" ::: "memory");
        const int c = lane & 7;
        for (int j = 0; j < 4; ++j) { const int n = (lane >> 3) + 8 * j; const float* s = scr + (8 * c) * 33 + n;
            u32x4 o;
            o.x = f2bf(s[0 * 33]) | (f2bf(s[1 * 33]) << 16); o.y = f2bf(s[2 * 33]) | (f2bf(s[3 * 33]) << 16);
            o.z = f2bf(s[4 * 33]) | (f2bf(s[5 * 33]) << 16); o.w = f2bf(s[6 * 33]) | (f2bf(s[7 * 33]) << 16);
            *(u32x4*)(WT + (size_t)(n0 + n) * K + k0 + 8 * c) = o; }
        asm volatile("s_waitcnt lgkmcnt(0)" ::: "memory");
    }
}

__global__ void __launch_bounds__(256) k_rowprep(const float* h, bf16* hb, float* ss) {
    const int lane = threadIdx.x & 63, row = blockIdx.x * 4 + (threadIdx.x >> 6);
    const f32x4* hr = (const f32x4*)(h + (size_t)row * D) + lane;
    float s = 0.f;
#pragma unroll
    for (int j = 0; j < 4; ++j) { f32x4 v = hr[64 * j]; s += v.x * v.x + v.y * v.y + v.z * v.z + v.w * v.w;
        unsigned long long o = (unsigned long long)(f2bf(v.x) | (f2bf(v.y) << 16)) | ((unsigned long long)(f2bf(v.z) | (f2bf(v.w) << 16)) << 32);
        ((unsigned long long*)(hb + (size_t)row * D))[lane + 64 * j] = o; }
    s = wave_sum(s);
    if (lane == 0) ss[row] = s;
}
__global__ void __launch_bounds__(256) k_finalnorm(float* h, const float* g) {
    const int lane = threadIdx.x & 63, row = blockIdx.x * 4 + (threadIdx.x >> 6);
    f32x4* hr = (f32x4*)(h + (size_t)row * D) + lane;
    f32x4 v[4]; float s = 0.f;
#pragma unroll
    for (int j = 0; j < 4; ++j) { v[j] = hr[64 * j]; s += v[j].x * v[j].x + v[j].y * v[j].y + v[j].z * v[j].z + v[j].w * v[j].w; }
    const float rs = rsqrtf(wave_sum(s) * (1.f / D) + RMS_EPS);
#pragma unroll
    for (int j = 0; j < 4; ++j) { const f32x4 gv = ((const f32x4*)g)[lane + 64 * j]; hr[64 * j] = v[j] * rs * gv; }
}

template <int EPI> __global__ void __launch_bounds__(256) k_gemm(const bf16* A, const bf16* Bt, int N, int K, const float* ss, const float* res, void* out) {
    __shared__ float As[16][132], Bs[16][132];
    const int tid = threadIdx.x, tx = tid & 15, ty = tid >> 4;
    const int m0 = blockIdx.y * 128, n0 = blockIdx.x * 128;
    float acc[8][8];
#pragma unroll
    for (int i = 0; i < 8; ++i)
#pragma unroll
        for (int j = 0; j < 8; ++j) acc[i][j] = 0.f;
    const int lr = tid >> 1, lk = (tid & 1) * 8;
    for (int k0 = 0; k0 < K; k0 += 16) {
        const u32x4 av = *(const u32x4*)(A + (size_t)(m0 + lr) * K + k0 + lk);
        const u32x4 bv = *(const u32x4*)(Bt + (size_t)(n0 + lr) * K + k0 + lk);
        __syncthreads();
        const unsigned aw[4] = {av.x, av.y, av.z, av.w}, bw[4] = {bv.x, bv.y, bv.z, bv.w};
#pragma unroll
        for (int j = 0; j < 4; ++j) {
            As[lk + 2 * j][lr] = __builtin_bit_cast(float, aw[j] << 16); As[lk + 2 * j + 1][lr] = __builtin_bit_cast(float, aw[j] & 0xffff0000u);
            Bs[lk + 2 * j][lr] = __builtin_bit_cast(float, bw[j] << 16); Bs[lk + 2 * j + 1][lr] = __builtin_bit_cast(float, bw[j] & 0xffff0000u); }
        __syncthreads();
#pragma unroll
        for (int k = 0; k < 16; ++k) {
            float a[8], b[8];
#pragma unroll
            for (int i = 0; i < 8; ++i) { a[i] = As[k][ty * 8 + i]; b[i] = Bs[k][tx * 8 + i]; }
#pragma unroll
            for (int i = 0; i < 8; ++i)
#pragma unroll
                for (int j = 0; j < 8; ++j) acc[i][j] += a[i] * b[j];
        }
    }
#pragma unroll
    for (int i = 0; i < 8; ++i) {
        const int row = m0 + ty * 8 + i;
        float rs = 1.f;
        if (EPI == 0 || EPI == 2) rs = rsqrtf(ss[row] * (1.f / D) + RMS_EPS);
#pragma unroll
        for (int j = 0; j < 8; ++j) {
            const int col = n0 + tx * 8 + j; const size_t o = (size_t)row * N + col;
            if (EPI == 0) ((bf16*)out)[o] = (bf16)f2bf(rs * acc[i][j]);
            else if (EPI == 1) ((float*)out)[o] = res[o] + acc[i][j];
            else { float v = rs * acc[i][j]; v = v > 0.f ? v * v : 0.f; ((bf16*)out)[o] = (bf16)f2bf(v); }
        }
    }
}

__global__ void __launch_bounds__(256) k_attn(const bf16* z, const float* sinks, float* yraw) {
    const int row = blockIdx.x * 256 + threadIdx.x, hq = blockIdx.y, hkv = hq >> 2;
    const int t = row % SEQ;
    float q[64], o[64];
    const bf16* qp = z + (size_t)row * NIN + ZQ + hq * 64;
#pragma unroll
    for (int d = 0; d < 64; ++d) { q[d] = bf2f(qp[d]); o[d] = 0.f; }
    float m = sinks[hq], l = 1.f;
    const int nk = t < 127 ? t + 1 : 128;
    for (int j = 0; j < nk; ++j) {
        const u32x4* kp = (const u32x4*)(z + (size_t)(row - j) * NIN + ZK + hkv * 64);
        const u32x4* vp = (const u32x4*)(z + (size_t)(row - j) * NIN + ZV + hkv * 64);
        float s = 0.f;
#pragma unroll
        for (int c = 0; c < 8; ++c) { const u32x4 w = kp[c]; const unsigned ww[4] = {w.x, w.y, w.z, w.w};
#pragma unroll
            for (int e = 0; e < 4; ++e) { s += q[c * 8 + 2 * e] * __builtin_bit_cast(float, ww[e] << 16); s += q[c * 8 + 2 * e + 1] * __builtin_bit_cast(float, ww[e] & 0xffff0000u); } }
        s *= 0.125f;
        const float mn = fmaxf(m, s), f = __expf(m - mn), p = __expf(s - mn);
        l = l * f + p; m = mn;
#pragma unroll
        for (int c = 0; c < 8; ++c) { const u32x4 w = vp[c]; const unsigned ww[4] = {w.x, w.y, w.z, w.w};
#pragma unroll
            for (int e = 0; e < 4; ++e) { o[c * 8 + 2 * e] = o[c * 8 + 2 * e] * f + p * __builtin_bit_cast(float, ww[e] << 16); o[c * 8 + 2 * e + 1] = o[c * 8 + 2 * e + 1] * f + p * __builtin_bit_cast(float, ww[e] & 0xffff0000u); } }
    }
    const float inv = 1.f / l;
    float* op = yraw + (size_t)row * D + hq * 64;
#pragma unroll
    for (int d = 0; d < 64; ++d) op[d] = o[d] * inv;
}

__global__ void __launch_bounds__(256) k_conv(const bf16* z, const float* w, const float* b, float* yraw) {
    const int c = threadIdx.x;
    float wk[31];
#pragma unroll
    for (int k = 0; k < 31; ++k) wk[k] = w[k * 256 + c];
    const float bias = b[c];
    for (int i = 0; i < 16; ++i) {
        const int row = blockIdx.x * 16 + i, t = row % SEQ;
        float acc = bias;
#pragma unroll
        for (int k = 0; k < 31; ++k) { const int tt = t - 30 + k;
            if (tt >= 0) { const bf16* zp = z + (size_t)(row - 30 + k) * NIN; const float val = bf2f(zp[ZCV + c]), gate = bf2f(zp[ZCG + c]); acc += wk[k] * (val * sigmoidf_(gate)); } }
        yraw[(size_t)row * D + 512 + c] = acc;
    }
}
__global__ void __launch_bounds__(256) k_convln(float* yraw, const float* g, const float* b) {
    const int lane = threadIdx.x & 63, row = blockIdx.x * 4 + (threadIdx.x >> 6);
    f32x4* p = (f32x4*)(yraw + (size_t)row * D + 512) + lane;
    f32x4 v = *p;
    const float mu = wave_sum(v.x + v.y + v.z + v.w) * (1.f / 256.f);
    v = v - mu;
    const float var = wave_sum(v.x * v.x + v.y * v.y + v.z * v.z + v.w * v.w) * (1.f / 256.f);
    const float rstd = rsqrtf(var + LN_EPS);
    const f32x4 gv = ((const f32x4*)g)[lane], bv = ((const f32x4*)b)[lane];
    f32x4 y = v * rstd * gv + bv;
    y.x = y.x * sigmoidf_(y.x); y.y = y.y * sigmoidf_(y.y); y.z = y.z * sigmoidf_(y.z); y.w = y.w * sigmoidf_(y.w);
    *p = y;
}

__global__ void __launch_bounds__(256) k_lrugate(const bf16* z, const float* cw, const float* cb, const float* wa, const float* ba, const float* wx, const float* bx,
                                                 const float* lam, float* abuf, float* gxbuf) {
    __shared__ float xs[256];
    const int c = threadIdx.x, hd = c >> 6, jj = c & 63;
    const float w0 = cw[c], w1 = cw[256 + c], w2 = cw[512 + c], w3 = cw[768 + c], cbias = cb[c];
    const float lm = -lam[c];
    const float sp = fmaxf(lm, 0.f) + log1pf(__expf(-fabsf(lm)));
    const float bav = ba[c], bxv = bx[c];
    for (int i = 0; i < 16; ++i) {
        const int row = blockIdx.x * 16 + i, t = row % SEQ;
        float xc = cbias;
        { const bf16* zp = z + (size_t)row * NIN + ZRX + c;
          xc += w3 * bf2f(zp[0]);
          if (t >= 1) xc += w2 * bf2f(zp[-(ptrdiff_t)NIN]);
          if (t >= 2) xc += w1 * bf2f(zp[-2 * (ptrdiff_t)NIN]);
          if (t >= 3) xc += w0 * bf2f(zp[-3 * (ptrdiff_t)NIN]); }
        __syncthreads();
        xs[c] = xc;
        __syncthreads();
        float r = bav, ig = bxv;
        for (int ii = 0; ii < 64; ++ii) { const float xv = xs[hd * 64 + ii]; r += xv * wa[(size_t)(hd * 64 + ii) * 64 + jj]; ig += xv * wx[(size_t)(hd * 64 + ii) * 64 + jj]; }
        r = sigmoidf_(r); ig = sigmoidf_(ig);
        const float log_a = -8.f * r * sp;
        const float a = __expf(log_a);
        const float gx = sqrtf(-expm1f(2.f * log_a)) * (ig * xc);
        abuf[(size_t)row * 256 + c] = a; gxbuf[(size_t)row * 256 + c] = gx;
    }
}
__device__ __forceinline__ float gelu_tanh(float x) { const float u = 0.7978845608028654f * (x + 0.044715f * x * x * x); return 0.5f * x * (1.f + tanhf(u)); }
__global__ void __launch_bounds__(64) k_lruscan(const bf16* z, const float* abuf, const float* gxbuf, float* yraw) {
    const int gid = blockIdx.x * 64 + threadIdx.x, b = gid >> 8, c = gid & 255;
    float h = 0.f;
    for (int t = 0; t < SEQ; t += 8) {
        float a[8], g[8], gt[8];
#pragma unroll
        for (int u = 0; u < 8; ++u) { const size_t row = (size_t)b * SEQ + t + u; a[u] = abuf[row * 256 + c]; g[u] = gxbuf[row * 256 + c]; gt[u] = bf2f(z[row * NIN + ZRG + c]); }
#pragma unroll
        for (int u = 0; u < 8; ++u) { const size_t row = (size_t)b * SEQ + t + u; h = a[u] * h + g[u]; yraw[row * D + 768 + c] = h * gelu_tanh(gt[u]); }
    }
}

__global__ void __launch_bounds__(256) k_groupnorm(const float* yraw, bf16* ymix) {
    const int lane = threadIdx.x & 63, row = blockIdx.x * 4 + (threadIdx.x >> 6);
    const f32x4* p = (const f32x4*)(yraw + (size_t)row * D);
    f32x4 a0 = p[lane], a1 = p[64 + lane], bq = p[128 + lane], cq = p[192 + lane];
    const float sa = wave_sum(a0.x * a0.x + a0.y * a0.y + a0.z * a0.z + a0.w * a0.w + a1.x * a1.x + a1.y * a1.y + a1.z * a1.z + a1.w * a1.w);
    const float sb = wave_sum(bq.x * bq.x + bq.y * bq.y + bq.z * bq.z + bq.w * bq.w);
    const float sc = wave_sum(cq.x * cq.x + cq.y * cq.y + cq.z * cq.z + cq.w * cq.w);
    const float ra = rsqrtf(sa * (1.f / 512.f) + RMS_EPS), rb = rsqrtf(sb * (1.f / 256.f) + RMS_EPS), rc = rsqrtf(sc * (1.f / 256.f) + RMS_EPS);
    a0 = a0 * ra; a1 = a1 * ra; bq = bq * rb; cq = cq * rc;
    unsigned long long* o = (unsigned long long*)(ymix + (size_t)row * D);
#define PK4(v) ((unsigned long long)(f2bf(v.x) | (f2bf(v.y) << 16)) | ((unsigned long long)(f2bf(v.z) | (f2bf(v.w) << 16)) << 32))
    o[lane] = PK4(a0); o[64 + lane] = PK4(a1); o[128 + lane] = PK4(bq); o[192 + lane] = PK4(cq);
#undef PK4
}

extern "C" void kernel_launch(void* const* d_in, const int* in_sizes, int n_in, void* d_out, int out_size, void* d_ws, size_t ws_size, hipStream_t stream) {
    if (n_in != 21 || in_sizes[0] != M * D || out_size != M * D || ws_size < WS_END) {
        fprintf(stderr, "kernel_launch: unexpected shapes n_in %d in0 %d out %d ws %zu\n", n_in, n_in > 0 ? in_sizes[0] : -1, out_size, ws_size); return; }
    const float* x = (const float*)d_in[0];
    const float* norm1 = (const float*)d_in[1]; const float* w_in = (const float*)d_in[2]; const float* sinks = (const float*)d_in[3];
    const float* cdw = (const float*)d_in[4]; const float* cdb = (const float*)d_in[5]; const float* clg = (const float*)d_in[6]; const float* clb = (const float*)d_in[7];
    const float* lcw = (const float*)d_in[8]; const float* lcb = (const float*)d_in[9]; const float* lwa = (const float*)d_in[10]; const float* lba = (const float*)d_in[11];
    const float* lwx = (const float*)d_in[12]; const float* lbx = (const float*)d_in[13]; const float* lam = (const float*)d_in[14];
    const float* mixn = (const float*)d_in[15]; const float* w_out = (const float*)d_in[16]; const float* norm2 = (const float*)d_in[17];
    const float* w_up = (const float*)d_in[18]; const float* w_down = (const float*)d_in[19]; const float* fnorm = (const float*)d_in[20];
    unsigned char* ws = (unsigned char*)d_ws; float* out = (float*)d_out;
    float* ss = (float*)(ws + WS_SS); bf16* hb = (bf16*)(ws + WS_HB); bf16* z = (bf16*)(ws + WS_Z); bf16* ymix = (bf16*)(ws + WS_YMIX); bf16* hh = (bf16*)(ws + WS_HH);
    float* abuf = (float*)(ws + WS_A); float* gxbuf = (float*)(ws + WS_GX); float* yraw = (float*)(ws + WS_YRAW);
    for (int l = 0; l < DEPTH; ++l) {
        unsigned char* wl = ws + WS_W + l * W_LAYER;
        k_wprep<<<1024, 256, 0, stream>>>(w_in + (size_t)l * D * NIN, norm1 + l * D, D, NIN, (bf16*)(wl + W_IN));
        k_wprep<<<1024, 256, 0, stream>>>(w_out + (size_t)l * D * D, mixn + l * D, D, D, (bf16*)(wl + W_OUT));
        k_wprep<<<1024, 256, 0, stream>>>(w_up + (size_t)l * D * FF, norm2 + l * D, D, FF, (bf16*)(wl + W_UP));
        k_wprep<<<1024, 256, 0, stream>>>(w_down + (size_t)l * FF * D, nullptr, FF, D, (bf16*)(wl + W_DOWN));
    }
    for (int l = 0; l < DEPTH; ++l) {
        unsigned char* wl = ws + WS_W + l * W_LAYER;
        const float* hcur = l == 0 ? x : out;
        k_rowprep<<<M / 4, 256, 0, stream>>>(hcur, hb, ss);
        k_gemm<0><<<dim3(NIN / 128, M / 128), 256, 0, stream>>>(hb, (const bf16*)(wl + W_IN), NIN, D, ss, nullptr, z);
        k_attn<<<dim3(M / 256, 8), 256, 0, stream>>>(z, sinks + l * 8, yraw);
        k_conv<<<M / 16, 256, 0, stream>>>(z, cdw + l * 31 * 256, cdb + l * 256, yraw);
        k_convln<<<M / 4, 256, 0, stream>>>(yraw, clg + l * 256, clb + l * 256);
        k_lrugate<<<M / 16, 256, 0, stream>>>(z, lcw + l * 4 * 256, lcb + l * 256, lwa + (size_t)l * 4 * 64 * 64, lba + l * 256, lwx + (size_t)l * 4 * 64 * 64, lbx + l * 256, lam + l * 256, abuf, gxbuf);
        k_lruscan<<<BATCH * 256 / 64, 64, 0, stream>>>(z, abuf, gxbuf, yraw);
        k_groupnorm<<<M / 4, 256, 0, stream>>>(yraw, ymix);
        k_gemm<1><<<dim3(D / 128, M / 128), 256, 0, stream>>>(ymix, (const bf16*)(wl + W_OUT), D, D, nullptr, hcur, out);
        k_rowprep<<<M / 4, 256, 0, stream>>>(out, hb, ss);
        k_gemm<2><<<dim3(FF / 128, M / 128), 256, 0, stream>>>(hb, (const bf16*)(wl + W_UP), FF, D, ss, nullptr, hh);
        k_gemm<1><<<dim3(D / 128, M / 128), 256, 0, stream>>>(hh, (const bf16*)(wl + W_DOWN), D, FF, nullptr, out, out);
    }
    k_finalnorm<<<M / 4, 256, 0, stream>>>(out, fnorm);
}
```

```cpp
#include <hip/hip_runtime.h>
#include <cstdio>
#include <cstdint>
namespace pg8 {
#define PG8_LAS __attribute__((address_space(3)))
typedef unsigned short bf16_t;
typedef short bf16x8 __attribute__((ext_vector_type(8)));
typedef float f32x4 __attribute__((ext_vector_type(4)));
typedef unsigned u32x4 __attribute__((ext_vector_type(4)));
constexpr int BM = 256, BK = 64, HALF = 128, HTB = HALF * BK * 2  , STAGE_BYTES = 8 * HTB, NXCD = 8;
#ifndef PG8_WGM
#define PG8_WGM 4
#endif
constexpr int WGM = PG8_WGM;

__host__ __device__ __forceinline__ int lds_byte(int r, int c) { const int st = (r >> 4) * 2 + (c >> 5), rr = r & 15, cc = c & 31, ob = rr * 64 + cc * 2; return st * 1024 + (ob ^ (((ob >> 9) & 1) << 5)); }
__host__ __device__ __forceinline__ void stage_rc(int b, int& R, int& C) { const int st = b / 1024, sb = b % 1024, swz = sb ^ (((sb >> 9) & 1) << 5); R = (st >> 1) * 16 + swz / 64; C = (st & 1) * 32 + (swz % 64) / 2; }
__host__ __device__ __forceinline__ int perm32(int rho) { const int n = rho >> 4, i = rho & 15; return 8 * (i >> 2) + 4 * n + (i & 3); }

struct Unit { int pm, pn, slot; };
struct Gemm { const bf16_t* A; const bf16_t* Bt; int M, N, K; int adj; };

struct StaticOrder {
    int nM, nN, nwg, G, c; int rev16; unsigned pnperm;
    __host__ __device__ __forceinline__ void init(int M, int N, int G_, int c_) { nM = M / BM; nN = N / BM; nwg = nM * nN; G = G_; c = c_; pnperm = 0u; rev16 = 0; }
    __host__ __device__ __forceinline__ bool next(int i, Unit& u) const {
        const long L = (long)i * G + c; if (L >= nwg) return false;
        int wgid = (int)L; { const int q = nwg / NXCD, r = nwg % NXCD, xcd = wgid % NXCD, off = wgid / NXCD; wgid = (xcd < r ? xcd * (q + 1) : r * (q + 1) + (xcd - r) * q) + off; }
        const int nig = WGM * nN, gid = wgid / nig, fm = gid * WGM, gsz = (nM - fm) < WGM ? (nM - fm) : WGM;
        u.pm = fm + ((wgid % nig) % gsz); u.pn = (wgid % nig) / gsz; if (pnperm) u.pn = (int)((pnperm >> (3 * u.pn)) & 7u); if (rev16) u.pm = (u.pm & ~15) | (15 - (u.pm & 15)); u.slot = i; return true;
    }
    __device__ __forceinline__ void a_ready(const Unit&) const {}
    __device__ __forceinline__ void done(const Unit&) const {}
};

__device__ __forceinline__ unsigned cvt_pk_bf16(float lo, float hi) { typedef float f2_ __attribute__((ext_vector_type(2))); typedef __bf16 b2_ __attribute__((ext_vector_type(2))); f2_ v = {lo, hi}; b2_ b = __builtin_convertvector(v, b2_); return __builtin_bit_cast(unsigned, b); }

constexpr float EPI_RMS_EPS = 1e-6f;
__device__ __forceinline__ float rows4_sum(float v) {
    auto a = __builtin_amdgcn_permlane32_swap(__float_as_uint(v), __float_as_uint(v), false, false); v = __uint_as_float(a[0]) + __uint_as_float(a[1]);
    auto b = __builtin_amdgcn_permlane16_swap(__float_as_uint(v), __float_as_uint(v), false, false); return __uint_as_float(b[0]) + __uint_as_float(b[1]);
}
__device__ __forceinline__ float epi_sigmoid(float x) { return __builtin_amdgcn_rcpf(1.f + __builtin_amdgcn_exp2f(-1.4426950408889634f * x)); }
__device__ __forceinline__ float epi_gelu_tanh(float x) { const float u = 0.7978845608028654f * (x + 0.044715f * x * x * x); const float ex = __builtin_amdgcn_exp2f(2.f * 1.4426950408889634f * u); return 0.5f * x * (2.f - 2.f * __builtin_amdgcn_rcpf(ex + 1.f)); }
#ifndef HH_PLAIN
#define HH_STORE(w, p) __builtin_nontemporal_store(w, p)
#else
#define HH_STORE(w, p) (*(p) = (w))
#endif
__device__ __forceinline__ constexpr unsigned ssp_idx(int row, int part) { return (unsigned)(((row >> 4) * 16 + part) * 16 + (row & 15)); }
__device__ __forceinline__ unsigned ror8(unsigned v) { return (unsigned)__builtin_amdgcn_update_dpp((int)v, (int)v, 0x128, 0xf, 0xf, false); }
__device__ __forceinline__ u32x4 ror8(u32x4 v) { u32x4 r; r.x = ror8(v.x); r.y = ror8(v.y); r.z = ror8(v.z); r.w = ror8(v.w); return r; }
__device__ __forceinline__ u32x4 sel4(bool c, u32x4 a, u32x4 b) { u32x4 r; r.x = c ? a.x : b.x; r.y = c ? a.y : b.y; r.z = c ? a.z : b.z; r.w = c ? a.w : b.w; return r; }
struct EpiAny {
    static constexpr bool PERM = true, AFTER_DRAIN = false;
    int mode; bf16_t* O; int ldc; const float* ssp_r; float* ssp_w; int qcols; float qscale; const PG8_LAS float* rs_tab; float* fout; const float* fgain; unsigned* fcnt; bf16_t* ubuf; const bf16_t* R;

    __device__ __forceinline__ void final_rows(const f32x4 (&acc)[2][2][4][2], const Unit& u, int wr, int wc, int fr, int fq) const {
        typedef float f32x2 __attribute__((ext_vector_type(2)));
        const int row0 = u.pm * BM + wr * 64 + fr, col0 = u.pn * BM + wc * 64 + 8 * fq;
        const bool hi = (fr & 8) != 0;
        f32x4 h[2][2][4][2];
        { f32x4 pp[2][4]; int rowp_ = row0; asm volatile("" : "+v"(rowp_));
#pragma unroll
            for (int ai = 0; ai < 2; ++ai)
#pragma unroll
                for (int m = 0; m < 4; ++m) { _Pragma("unroll") for (int e = 0; e < 4; ++e) pp[ai][m][e] = ssp_r[ssp_idx(rowp_ + ai * HALF + m * 16, 4 * fq + e)]; }
#pragma unroll
            for (int ai = 0; ai < 2; ++ai)
#pragma unroll
                for (int m = 0; m < 4; ++m) { const f32x4 p = pp[ai][m]; float s = (p[0] + p[1]) + (p[2] + p[3]); s = rows4_sum(s); const float r2 = __builtin_amdgcn_rcpf(s * (1.0f / 1024.0f) + EPI_RMS_EPS);
#pragma unroll
                    for (int bj = 0; bj < 2; ++bj) { h[ai][bj][m][0] = acc[ai][bj][m][0] * r2; h[ai][bj][m][1] = acc[ai][bj][m][1] * r2; } }
            asm volatile("" ::: "memory"); }
        float sqv[2][4];
        { u32x4 rb[2][4][2]; int rowl_ = row0 - (hi ? 8 : 0), coll_ = col0 + (hi ? 32 : 0); asm volatile("" : "+v"(rowl_), "+v"(coll_));
#pragma unroll
            for (int ai = 0; ai < 2; ++ai)
#pragma unroll
                for (int m = 0; m < 4; ++m) {
                    rb[ai][m][0] = *(const u32x4*)(R + (size_t)(unsigned)((rowl_ + ai * HALF + m * 16) * ldc + coll_));
                    rb[ai][m][1] = *(const u32x4*)(R + (size_t)(unsigned)((rowl_ + ai * HALF + m * 16 + 8) * ldc + (coll_ ^ 32))); }
#pragma unroll
            for (int ai = 0; ai < 2; ++ai)
#pragma unroll
                for (int m = 0; m < 4; ++m) { f32x2 sq2 = {0.f, 0.f};
                    const u32x4 rx = sel4(hi, rb[ai][m][1], rb[ai][m][0]), ry = ror8(sel4(hi, rb[ai][m][0], rb[ai][m][1]));
#pragma unroll
                    for (int bj = 0; bj < 2; ++bj) { const u32x4 r = bj ? ry : rx; f32x4 a0 = h[ai][bj][m][0], a1 = h[ai][bj][m][1];
                        a0[0] += __builtin_bit_cast(float, r.x << 16); a0[1] += __builtin_bit_cast(float, r.x & 0xffff0000u); a0[2] += __builtin_bit_cast(float, r.y << 16); a0[3] += __builtin_bit_cast(float, r.y & 0xffff0000u);
                        a1[0] += __builtin_bit_cast(float, r.z << 16); a1[1] += __builtin_bit_cast(float, r.z & 0xffff0000u); a1[2] += __builtin_bit_cast(float, r.w << 16); a1[3] += __builtin_bit_cast(float, r.w & 0xffff0000u);
                        h[ai][bj][m][0] = a0; h[ai][bj][m][1] = a1;
                        sq2 += (f32x2){a0[0], a0[1]} * (f32x2){a0[0], a0[1]} + (f32x2){a0[2], a0[3]} * (f32x2){a0[2], a0[3]}; sq2 += (f32x2){a1[0], a1[1]} * (f32x2){a1[0], a1[1]} + (f32x2){a1[2], a1[3]} * (f32x2){a1[2], a1[3]}; }
                    sqv[ai][m] = rows4_sum(sq2[0] + sq2[1]); } }
        { int rows_ = row0; asm volatile("" : "+v"(rows_));
#pragma unroll
            for (int ai = 0; ai < 2; ++ai)
#pragma unroll
                for (int m = 0; m < 4; ++m)
                    if (fq == 0) __hip_atomic_store(ssp_w + ssp_idx(rows_ + ai * HALF + m * 16, u.pn * 4 + wc), sqv[ai][m], __ATOMIC_RELAXED, __HIP_MEMORY_SCOPE_AGENT); }
        asm volatile("s_waitcnt vmcnt(0)" ::: "memory");
        unsigned* cnt = fcnt + 64 * (2 * u.pm + wr);
        if ((threadIdx.x & 63) == 0) __hip_atomic_fetch_add(cnt, 1u, __ATOMIC_RELAXED, __HIP_MEMORY_SCOPE_AGENT);
        { unsigned sp_ = 0; while ((unsigned)__builtin_amdgcn_readfirstlane(__hip_atomic_load(cnt, __ATOMIC_RELAXED, __HIP_MEMORY_SCOPE_AGENT)) < 16u) { __builtin_amdgcn_s_sleep(1); if (++sp_ > (1u << 20)) break; } }
        float rsv[2][4];
        { float pt[2][4][4]; int rowq_ = row0; asm volatile("" : "+v"(rowq_));
#pragma unroll
            for (int ai = 0; ai < 2; ++ai)
#pragma unroll
                for (int m = 0; m < 4; ++m)
#pragma unroll
                    for (int e = 0; e < 4; ++e) pt[ai][m][e] = __hip_atomic_load(ssp_w + ssp_idx(rowq_ + ai * HALF + m * 16, 4 * fq + e), __ATOMIC_RELAXED, __HIP_MEMORY_SCOPE_AGENT);
#pragma unroll
            for (int ai = 0; ai < 2; ++ai)
#pragma unroll
                for (int m = 0; m < 4; ++m) { float s = (pt[ai][m][0] + pt[ai][m][1]) + (pt[ai][m][2] + pt[ai][m][3]); s = rows4_sum(s); rsv[ai][m] = __builtin_amdgcn_rsqf(s * (1.0f / 1024.0f) + EPI_RMS_EPS); } }
        f32x4 g[2][2];
#pragma unroll
        for (int bj = 0; bj < 2; ++bj) { g[bj][0] = *(const f32x4*)(fgain + col0 + bj * 32); g[bj][1] = *(const f32x4*)(fgain + col0 + bj * 32 + 4); }
        asm volatile("" ::: "memory");
        int rowo_ = row0; asm volatile("" : "+v"(rowo_));
#pragma unroll
        for (int ai = 0; ai < 2; ++ai)
#pragma unroll
            for (int m = 0; m < 4; ++m)
#pragma unroll
                for (int bj = 0; bj < 2; ++bj) { float* op = fout + (size_t)(unsigned)((rowo_ + ai * HALF + m * 16) * ldc + col0 + bj * 32);
                    *(f32x4*)op = h[ai][bj][m][0] * rsv[ai][m] * g[bj][0]; *(f32x4*)(op + 4) = h[ai][bj][m][1] * rsv[ai][m] * g[bj][1]; }
    }
    __device__ __forceinline__ void operator()(const f32x4 (&acc)[2][2][4][2], const Unit& u, int wr, int wc, int fr_, int fq_) const {
        int fr = fr_, fq = fq_; asm volatile("" : "+v"(fr), "+v"(fq));
        const int row0 = u.pm * BM + wr * 64 + fr, col0 = u.pn * BM + wc * 32 + 8 * fq;
        if (mode > 4) return;
        if (mode == 4) { final_rows(acc, u, wr, wc, fr, fq); return; }
        if (mode == 1) {
            typedef float f32x2 __attribute__((ext_vector_type(2)));
            const bool hi1 = (fr & 8) != 0; const int rowa_ = row0 - (hi1 ? 8 : 0), cola_ = u.pn * BM + wc * 64 + 8 * fq + (hi1 ? 32 : 0);
#pragma unroll
            for (int ai = 0; ai < 2; ++ai)
#pragma unroll
                for (int m = 0; m < 4; ++m) { u32x4 wx, wy;
#pragma unroll
                    for (int bj = 0; bj < 2; ++bj) { const f32x4 a0 = acc[ai][bj][m][0], a1 = acc[ai][bj][m][1];
                        f32x2 p0 = __builtin_elementwise_max((f32x2){a0[0], a0[1]}, (f32x2){0.f, 0.f}), p1 = __builtin_elementwise_max((f32x2){a0[2], a0[3]}, (f32x2){0.f, 0.f});
                        f32x2 p2 = __builtin_elementwise_max((f32x2){a1[0], a1[1]}, (f32x2){0.f, 0.f}), p3 = __builtin_elementwise_max((f32x2){a1[2], a1[3]}, (f32x2){0.f, 0.f});
                        p0 = p0 * p0; p1 = p1 * p1; p2 = p2 * p2; p3 = p3 * p3;
                        u32x4 w; w.x = cvt_pk_bf16(p0[0], p0[1]); w.y = cvt_pk_bf16(p1[0], p1[1]); w.z = cvt_pk_bf16(p2[0], p2[1]); w.w = cvt_pk_bf16(p3[0], p3[1]);
                        if (bj) wy = w; else wx = w; }
                    const u32x4 wyr = ror8(wy); bf16_t* pa = O + (size_t)(unsigned)((rowa_ + ai * HALF + m * 16) * ldc + cola_);
                    HH_STORE(sel4(hi1, wyr, wx), (u32x4*)pa);
                    HH_STORE(sel4(hi1, wx, wyr), (u32x4*)(O + (size_t)(unsigned)((rowa_ + ai * HALF + m * 16 + 8) * ldc + (cola_ ^ 32)))); }
            return;
        }
        if (mode < 2) {
            const float sc = (u.pn * BM < qcols) ? qscale : 1.f;
            const int kind = (u.pn == 3 || u.pn == 4) ? 1 : (u.pn == 6) ? 2 : 0;
            const bool hi0 = (fr & 8) != 0; const int cola0_ = u.pn * BM + wc * 64 + 8 * fq + (hi0 ? 32 : 0);
#pragma unroll
            for (int ai = 0; ai < 2; ++ai)
#pragma unroll
                for (int m = 0; m < 4; ++m) { const int row = row0 + ai * HALF + m * 16;
                    const float rs = rs_tab[u.slot * BM + wr * 64 + fr + ai * HALF + m * 16] * sc;
                    if (kind == 1) {
                        f32x4 v0 = acc[ai][0][m][0] * rs, v1 = acc[ai][0][m][1] * rs; const f32x4 g0 = acc[ai][1][m][0] * rs, g1 = acc[ai][1][m][1] * rs;
#pragma unroll
                        for (int e = 0; e < 4; ++e) { v0[e] *= epi_sigmoid(g0[e]); v1[e] *= epi_sigmoid(g1[e]); }
                        u32x4 w; w.x = cvt_pk_bf16(v0[0], v0[1]); w.y = cvt_pk_bf16(v0[2], v0[3]); w.z = cvt_pk_bf16(v1[0], v1[1]); w.w = cvt_pk_bf16(v1[2], v1[3]);
                        *(u32x4*)(ubuf + (size_t)row * 256 + (u.pn - 3) * HALF + wc * 32 + 8 * fq) = w;
                    } else {
                    u32x4 wx, wy;
#pragma unroll
                    for (int bj = 0; bj < 2; ++bj) { f32x4 v0 = acc[ai][bj][m][0] * rs, v1 = acc[ai][bj][m][1] * rs;
                        if (kind == 2) {
#pragma unroll
                            for (int e = 0; e < 4; ++e) { v0[e] = epi_gelu_tanh(v0[e]); v1[e] = epi_gelu_tanh(v1[e]); } }
                        u32x4 w; w.x = cvt_pk_bf16(v0[0], v0[1]); w.y = cvt_pk_bf16(v0[2], v0[3]); w.z = cvt_pk_bf16(v1[0], v1[1]); w.w = cvt_pk_bf16(v1[2], v1[3]);
                        if (bj) wy = w; else wx = w; }
                    const u32x4 wyr = ror8(wy);
                    *(u32x4*)(O + (size_t)(unsigned)((row - (hi0 ? 8 : 0)) * ldc + cola0_)) = sel4(hi0, wyr, wx);
                    *(u32x4*)(O + (size_t)(unsigned)((row - (hi0 ? 8 : 0) + 8) * ldc + (cola0_ ^ 32))) = sel4(hi0, wx, wyr); } }
        } else {
            typedef float f32x2 __attribute__((ext_vector_type(2)));
            f32x4 sa[2][2][4][2];
            if (mode == 3) {
                f32x4 pp[2][4]; int rowp_ = row0; asm volatile("" : "+v"(rowp_));
#pragma unroll
                for (int ai = 0; ai < 2; ++ai)
#pragma unroll
                    for (int m = 0; m < 4; ++m) { _Pragma("unroll") for (int e = 0; e < 4; ++e) pp[ai][m][e] = ssp_r[ssp_idx(rowp_ + ai * HALF + m * 16, 4 * fq + e)]; }
#pragma unroll
                for (int ai = 0; ai < 2; ++ai)
#pragma unroll
                    for (int m = 0; m < 4; ++m) { const f32x4 p = pp[ai][m]; float s = (p[0] + p[1]) + (p[2] + p[3]); s = rows4_sum(s); const float r2 = __builtin_amdgcn_rcpf(s * (1.0f / 1024.0f) + EPI_RMS_EPS);
#pragma unroll
                        for (int bj = 0; bj < 2; ++bj) { sa[ai][bj][m][0] = acc[ai][bj][m][0] * r2; sa[ai][bj][m][1] = acc[ai][bj][m][1] * r2; } }
                asm volatile("" ::: "memory");
            } else {
#pragma unroll
                for (int ai = 0; ai < 2; ++ai)
#pragma unroll
                    for (int m = 0; m < 4; ++m)
#pragma unroll
                        for (int bj = 0; bj < 2; ++bj) { sa[ai][bj][m][0] = acc[ai][bj][m][0]; sa[ai][bj][m][1] = acc[ai][bj][m][1]; }
            }
            const bool hi = (fr & 8) != 0;
            int rowl_ = row0 - (hi ? 8 : 0), coll_ = u.pn * BM + wc * 64 + 8 * fq + (hi ? 32 : 0); asm volatile("" : "+v"(rowl_), "+v"(coll_));
            u32x4 rb[2][4][2];
#pragma unroll
            for (int ai = 0; ai < 2; ++ai)
#pragma unroll
                for (int m = 0; m < 4; ++m) {
                    rb[ai][m][0] = *(const u32x4*)(R + (size_t)(unsigned)((rowl_ + ai * HALF + m * 16) * ldc + coll_));
                    rb[ai][m][1] = *(const u32x4*)(R + (size_t)(unsigned)((rowl_ + ai * HALF + m * 16 + 8) * ldc + (coll_ ^ 32))); }
#pragma unroll
            for (int ai = 0; ai < 2; ++ai)
#pragma unroll
                for (int m = 0; m < 4; ++m) { int row = row0 + ai * HALF + m * 16; asm volatile("" : "+v"(row));
                    f32x2 sq2 = {0.f, 0.f};
                    const u32x4 rx = sel4(hi, rb[ai][m][1], rb[ai][m][0]), ry = ror8(sel4(hi, rb[ai][m][0], rb[ai][m][1]));
                    u32x4 wx, wy;
#pragma unroll
                    for (int bj = 0; bj < 2; ++bj) {
                        const u32x4 r = bj ? ry : rx; const f32x4 a0 = sa[ai][bj][m][0], a1 = sa[ai][bj][m][1];
                        const f32x2 v0 = (f32x2){a0[0], a0[1]} + (f32x2){__builtin_bit_cast(float, r.x << 16), __builtin_bit_cast(float, r.x & 0xffff0000u)};
                        const f32x2 v1 = (f32x2){a0[2], a0[3]} + (f32x2){__builtin_bit_cast(float, r.y << 16), __builtin_bit_cast(float, r.y & 0xffff0000u)};
                        const f32x2 v2 = (f32x2){a1[0], a1[1]} + (f32x2){__builtin_bit_cast(float, r.z << 16), __builtin_bit_cast(float, r.z & 0xffff0000u)};
                        const f32x2 v3 = (f32x2){a1[2], a1[3]} + (f32x2){__builtin_bit_cast(float, r.w << 16), __builtin_bit_cast(float, r.w & 0xffff0000u)};
                        sq2 += v0 * v0 + v1 * v1; sq2 += v2 * v2 + v3 * v3;
                        u32x4 w; w.x = cvt_pk_bf16(v0[0], v0[1]); w.y = cvt_pk_bf16(v1[0], v1[1]); w.z = cvt_pk_bf16(v2[0], v2[1]); w.w = cvt_pk_bf16(v3[0], v3[1]);
                        if (bj) wy = w; else wx = w; }
                    const u32x4 wyr = ror8(wy);
                    const unsigned offa = (unsigned)((row - (hi ? 8 : 0)) * ldc + coll_);
                    *(u32x4*)(O + (size_t)offa) = sel4(hi, wyr, wx);
                    *(u32x4*)(O + (size_t)(unsigned)((row - (hi ? 8 : 0) + 8) * ldc + (coll_ ^ 32))) = sel4(hi, wx, wyr);
                    float sq = sq2[0] + sq2[1];
                    sq = rows4_sum(sq);
                    if (fq == 0) ssp_w[ssp_idx(row, u.pn * 4 + wc)] = sq; }
        }
    }
};
template <class Epi, class Sched, bool ALIGN_EPI = false, bool SP2 = false>
__device__ __forceinline__ void gemm_phase(PG8_LAS unsigned char* lds, const Gemm g, const Sched& S, const Epi& E) {
    int tid_ = threadIdx.x; asm volatile("" : "+v"(tid_));
    const int tid = tid_, wid = __builtin_amdgcn_readfirstlane(tid >> 6), lane = tid & 63, wr = wid >> 2, wc = wid & 3, fr = lane & 15, fq = lane >> 4;
    const int K = g.K, nt = K / BK;
    unsigned voffA[2], voffB[2];
#pragma unroll
    for (int i = 0; i < 2; ++i) { int R, C; stage_rc(tid * 16 + i * 8192, R, C); const int Rb = Epi::PERM ? ((g.adj ? (R >> 5) * 64 : (R & ~31)) + perm32(R & 31)) : R;
        voffA[i] = (unsigned)(R * K + C) * 2u; voffB[i] = (unsigned)(Rb * K + C) * 2u; }
    const size_t kstep = (size_t)(BK * 2);
    const size_t hstep = (size_t)HALF * K * 2;
    const size_t tstep = 2 * hstep;
    const size_t hstepB = g.adj ? (size_t)32 * K * 2 : hstep;
    const unsigned ldsw = (unsigned)wid * 1024u;
    const int aoff = lds_byte(wr * 64 + fr, fq * 8), boff = lds_byte(wc * 32 + fr, fq * 8);
#define PG8_SA(b, h) (((b) * 2 + (h)) * HTB)
#define PG8_SB(b, h) ((4 + (b) * 2 + (h)) * HTB)
#define PG8_STAGE(bufoff, gbase, voff) do { _Pragma("unroll") for (int _i = 0; _i < 2; ++_i) \
        __builtin_amdgcn_global_load_lds((const unsigned*)((const char*)(gbase) + (voff)[_i]), (PG8_LAS unsigned*)(lds + (bufoff) + ldsw + _i * 8192), 16, 0, 0); } while (0)
#define PG8_LDA(dst, b, h) do { _Pragma("unroll") for (int m = 0; m < 4; ++m) _Pragma("unroll") for (int k = 0; k < 2; ++k) dst[m][k] = *(const PG8_LAS bf16x8*)(lds + PG8_SA(b, h) + aoff + m * 2048 + k * 1024); } while (0)
#define PG8_LDB(dst, b, h) do { _Pragma("unroll") for (int n = 0; n < 2; ++n) _Pragma("unroll") for (int k = 0; k < 2; ++k) dst[n][k] = *(const PG8_LAS bf16x8*)(lds + PG8_SB(b, h) + boff + n * 2048 + k * 1024); } while (0)
#define PG8_MMA(ai, bj, At, Bt) do { __builtin_amdgcn_s_setprio(1); _Pragma("unroll") for (int m = 0; m < 4; ++m) _Pragma("unroll") for (int n = 0; n < 2; ++n) _Pragma("unroll") for (int k = 0; k < 2; ++k) \
        acc[ai][bj][m][n] = __builtin_amdgcn_mfma_f32_16x16x32_bf16(Bt[n][k], At[m][k], acc[ai][bj][m][n], 0, 0, 0); __builtin_amdgcn_s_setprio(0); } while (0)
#define PG8_WAIT_V(n) asm volatile("s_waitcnt vmcnt(" #n ")" ::: "memory")
#define PG8_WAIT_L(n) asm volatile("s_waitcnt lgkmcnt(" #n ")" ::: "memory")
#define PG8_BAR __builtin_amdgcn_s_barrier()
#define PG8_SCHED __builtin_amdgcn_sched_barrier(0)
    Unit cur, nxt; int ui = 0;
    if (!S.next(0, cur)) return;
    f32x4 acc[2][2][4][2];
#pragma unroll
    for (int a = 0; a < 2; ++a)
#pragma unroll
        for (int b = 0; b < 2; ++b)
#pragma unroll
            for (int m = 0; m < 4; ++m)
#pragma unroll
                for (int n = 0; n < 2; ++n) acc[a][b][m][n] = (f32x4){0.f, 0.f, 0.f, 0.f};
    bf16x8 At[4][2], B0[2][2], B1[2][2];
    const char* cA = (const char*)g.A + (size_t)cur.pm * tstep; const char* cB = (const char*)g.Bt + (size_t)cur.pn * tstep;
    S.a_ready(cur);
    if constexpr (SP2) {
        PG8_STAGE(PG8_SB(0, 0), cB, voffB); PG8_STAGE(PG8_SB(0, 1), cB + hstepB, voffB); PG8_STAGE(PG8_SA(0, 0), cA, voffA); PG8_STAGE(PG8_SA(0, 1), cA + hstep, voffA);
        if (wr == 1) PG8_BAR;
        PG8_WAIT_V(2); PG8_BAR;
        PG8_STAGE(PG8_SB(1, 0), cB + kstep, voffB); PG8_STAGE(PG8_SA(1, 0), cA + kstep, voffA); PG8_STAGE(PG8_SB(1, 1), cB + hstepB + kstep, voffB);
        PG8_WAIT_V(6); PG8_BAR;
    } else {
        PG8_STAGE(PG8_SB(0, 0), cB, voffB); PG8_STAGE(PG8_SA(0, 0), cA, voffA); PG8_STAGE(PG8_SB(0, 1), cB + hstepB, voffB); PG8_STAGE(PG8_SA(0, 1), cA + hstep, voffA);
        if (wr == 1) PG8_BAR;
        PG8_WAIT_V(4); PG8_BAR;
        PG8_STAGE(PG8_SB(1, 0), cB + kstep, voffB); PG8_STAGE(PG8_SA(1, 0), cA + kstep, voffA); PG8_STAGE(PG8_SB(1, 1), cB + hstepB + kstep, voffB);
        PG8_WAIT_V(6); PG8_BAR;
    }
    for (;;) {
        const bool has_next = S.next(ui + 1, nxt);
        const char* nA = has_next ? (const char*)g.A + (size_t)nxt.pm * tstep : cA; const char* nB = has_next ? (const char*)g.Bt + (size_t)nxt.pn * tstep : cB;
        for (int t = 0; t < nt; t += 2) {
            const bool last = (t == nt - 2);
            const char* a1 = cA + (size_t)(t + 1) * kstep;
            const char* a2 = last ? nA : cA + (size_t)(t + 2) * kstep; const char* b2 = last ? nB : cB + (size_t)(t + 2) * kstep;
            const char* a3 = a2 + kstep; const char* b3 = b2 + kstep;
            if (last && has_next) S.a_ready(nxt);
            if constexpr (SP2) {
            PG8_LDB(B0, 0, 0); PG8_LDB(B1, 0, 1); PG8_SCHED; PG8_LDA(At, 0, 0); PG8_STAGE(PG8_SA(1, 1), a1 + hstep, voffA);
            PG8_WAIT_V(8); PG8_WAIT_L(0); PG8_BAR; PG8_MMA(0, 0, At, B0); PG8_MMA(0, 1, At, B1); PG8_BAR; PG8_SCHED;
            PG8_LDA(At, 0, 1); PG8_STAGE(PG8_SB(0, 0), b2, voffB); PG8_STAGE(PG8_SB(0, 1), b2 + hstepB, voffB); PG8_STAGE(PG8_SA(0, 0), a2, voffA);
            PG8_WAIT_V(8); PG8_WAIT_L(0); PG8_BAR; PG8_MMA(1, 0, At, B0); PG8_MMA(1, 1, At, B1); PG8_BAR; PG8_SCHED;
            PG8_LDB(B0, 1, 0); PG8_LDB(B1, 1, 1); PG8_SCHED; PG8_LDA(At, 1, 0); PG8_STAGE(PG8_SA(0, 1), a2 + hstep, voffA);
            PG8_WAIT_V(8); PG8_WAIT_L(0); PG8_BAR; PG8_MMA(0, 0, At, B0); PG8_MMA(0, 1, At, B1); PG8_BAR; PG8_SCHED;
            PG8_LDA(At, 1, 1); PG8_STAGE(PG8_SB(1, 0), b3, voffB); PG8_STAGE(PG8_SB(1, 1), b3 + hstepB, voffB); PG8_STAGE(PG8_SA(1, 0), a3, voffA);
            PG8_WAIT_V(8); PG8_WAIT_L(0); PG8_BAR; PG8_MMA(1, 0, At, B0); PG8_MMA(1, 1, At, B1); PG8_BAR; PG8_SCHED;
            } else {
            PG8_LDB(B0, 0, 0); PG8_SCHED; PG8_LDA(At, 0, 0); PG8_STAGE(PG8_SA(1, 1), a1 + hstep, voffA);
            PG8_WAIT_L(8); PG8_BAR; PG8_WAIT_L(0); PG8_MMA(0, 0, At, B0); PG8_BAR; PG8_SCHED;
            PG8_LDB(B1, 0, 1); PG8_STAGE(PG8_SB(0, 0), b2, voffB);
            PG8_BAR; PG8_WAIT_L(0); PG8_MMA(0, 1, At, B1); PG8_BAR;
            PG8_LDA(At, 0, 1); PG8_STAGE(PG8_SA(0, 0), a2, voffA);
            PG8_BAR; PG8_WAIT_L(0); PG8_MMA(1, 0, At, B0); PG8_BAR; PG8_SCHED;
            PG8_STAGE(PG8_SB(0, 1), b2 + hstepB, voffB);
            PG8_WAIT_V(6); PG8_BAR; PG8_MMA(1, 1, At, B1); PG8_BAR;
            PG8_LDB(B0, 1, 0); PG8_SCHED; PG8_LDA(At, 1, 0); PG8_STAGE(PG8_SA(0, 1), a2 + hstep, voffA);
            PG8_WAIT_L(8); PG8_BAR; PG8_WAIT_L(0); PG8_MMA(0, 0, At, B0); PG8_BAR; PG8_SCHED;
            PG8_LDB(B1, 1, 1); PG8_STAGE(PG8_SB(1, 0), b3, voffB);
            PG8_BAR; PG8_WAIT_L(0); PG8_MMA(0, 1, At, B1); PG8_BAR;
            PG8_LDA(At, 1, 1); PG8_STAGE(PG8_SA(1, 0), a3, voffA);
            PG8_BAR; PG8_WAIT_L(0); PG8_MMA(1, 0, At, B0); PG8_BAR; PG8_SCHED;
            PG8_STAGE(PG8_SB(1, 1), b3 + hstepB, voffB);
            PG8_WAIT_V(6); PG8_BAR; PG8_MMA(1, 1, At, B1); PG8_BAR;
            }
        }
        if constexpr (ALIGN_EPI) { if (wr == 0) PG8_BAR; }
        if constexpr (!Epi::AFTER_DRAIN) { E(acc, cur, wr, wc, fr, fq); S.done(cur); }
        if (!has_next) break;
#pragma unroll
        for (int a = 0; a < 2; ++a)
#pragma unroll
            for (int b = 0; b < 2; ++b)
#pragma unroll
                for (int m = 0; m < 4; ++m)
#pragma unroll
                    for (int n = 0; n < 2; ++n) acc[a][b][m][n] = (f32x4){0.f, 0.f, 0.f, 0.f};
        cur = nxt; cA = nA; cB = nB; ++ui;
        if constexpr (ALIGN_EPI) { if (wr == 1) PG8_BAR; }
    }
    PG8_WAIT_V(0);
    if constexpr (!ALIGN_EPI) { if (wr == 0) PG8_BAR; }
    PG8_BAR;
    if constexpr (Epi::AFTER_DRAIN) { E.fused(acc, cur, wr, wc, fr, fq, lds, wid, lane); S.done(cur); }
#undef PG8_SA
#undef PG8_SB
#undef PG8_STAGE
#undef PG8_LDA
#undef PG8_LDB
#undef PG8_MMA
#undef PG8_WAIT_V
#undef PG8_WAIT_L
#undef PG8_BAR
#undef PG8_SCHED
}
}

#ifndef PG8_SP2
#define PG8_SP2 true
#endif
#ifndef PG8_ALIGN
#define PG8_ALIGN true
#endif
constexpr int NWAVES = 8;
constexpr int D = 1024, BATCH = 4, SEQ = 8192, DEPTH = 2;
constexpr int M = BATCH * SEQ;
constexpr int NIN = 1792, FF = 4096;
constexpr int ZQ = 0, ZK = 512, ZV = 640, ZCV = 768, ZCG = 1024, ZRX = 1280, ZRG = 1536;
constexpr float RMS_EPS = 1e-6f, LN_EPS = 1e-5f;
constexpr size_t MiB = 1u << 20;
constexpr size_t WS_CTL = 0, CTL_ZERO_BYTES = 160 * 1024;
constexpr size_t WS_WFRAG = 1 * MiB; constexpr int WFRAG_LAYER = 64 * 512;
constexpr size_t WS_W = 2 * MiB, W_LAYER = 22 * MiB, W_IN = 0, W_OUT = 4 * MiB, W_UP = 6 * MiB, W_DOWN = 14 * MiB;
constexpr size_t WS_SSP = 46 * MiB;
constexpr size_t WS_HB = 48 * MiB;
constexpr size_t WS_Z = 112 * MiB;
constexpr size_t WS_YMIX = 224 * MiB;
constexpr size_t WS_HH = 112 * MiB;


constexpr size_t WS_SSP2 = 368 * MiB;
constexpr size_t WS_UBUF = 370 * MiB;
constexpr size_t WS_H1 = 386 * MiB;
constexpr size_t WS_END = 450 * MiB;
constexpr int CW_FIN = 18432;
constexpr int CW_BAR = 4096;
constexpr int RING_OFF = 0, RING_BYTES = 131072;
constexpr int LDSCTL_OFF = RING_BYTES, MISC_OFF = LDSCTL_OFF + 320;
static_assert((CW_FIN + 256 * 64) * 4 <= (int)CTL_ZERO_BYTES && (CW_BAR + 4 * 3456) <= CW_FIN, "control words inside the memset region");
constexpr int LDS_BYTES = 163840;
#define GAS __attribute__((address_space(1)))
#define LAS __attribute__((address_space(3)))
typedef unsigned short bf16;
typedef unsigned v4u __attribute__((ext_vector_type(4)));
typedef float f32x4 __attribute__((ext_vector_type(4)));
typedef short bf16x8 __attribute__((ext_vector_type(8)));
typedef GAS unsigned gu32;
typedef GAS unsigned long long gu64;
#define RLX_AGENT __ATOMIC_RELAXED, __HIP_MEMORY_SCOPE_AGENT
#define LDS_WAIT() asm volatile("s_waitcnt lgkmcnt(0)" ::: "memory")
#define VM_WAIT() asm volatile("s_waitcnt vmcnt(0)" ::: "memory")
__device__ __forceinline__ unsigned long long rt() { return __builtin_amdgcn_s_memrealtime(); }
__device__ __forceinline__ unsigned f2bf(float f) { unsigned u = __builtin_bit_cast(unsigned, f); return (u + 0x7fffu + ((u >> 16) & 1u)) >> 16; }
__device__ __forceinline__ unsigned pk2(float lo, float hi) { return f2bf(lo) | (f2bf(hi) << 16); }
#define XB_TMO      128
#define XB_XCNT(j)  (256  + 64 * (j))
#define XB_XSUB(j)  (1280 + 64 * (j))
#define XB_XGEN(j)  (2304 + 64 * (j))
#define XB_TOP      3328
#define XB_TOPGEN   3392
#define XCD_BAR_WORDS 3456
#define XB_SPIN_CAP (1u << 18)

__device__ __forceinline__ unsigned xb_ld(unsigned* p)              { return __hip_atomic_load(p, __ATOMIC_RELAXED, __HIP_MEMORY_SCOPE_AGENT); }
__device__ __forceinline__ unsigned xb_add(unsigned* p, unsigned v) { return __hip_atomic_fetch_add(p, v, __ATOMIC_RELAXED, __HIP_MEMORY_SCOPE_AGENT); }
__device__ __forceinline__ unsigned xb_xcc_id() { return (unsigned)__builtin_amdgcn_s_getreg((3 << 11) | 20) & 0xFu; }
#define XB_SPIN(cond, bar) do { unsigned _sp = 0; while (cond) { __builtin_amdgcn_s_sleep(1); \
    if ((++_sp & 255u) == 0u) { if (xb_ld(&(bar)[XB_TMO])) break; if (_sp > XB_SPIN_CAP) { atomicAdd(&(bar)[XB_TMO], 1u); break; } } } } while (0)

struct XcdBarrier {
    unsigned* bar; unsigned x;
    volatile LAS unsigned* st;
};

__device__ __forceinline__ XcdBarrier xcd_barrier_post(unsigned* bar, volatile LAS unsigned* st) {
    XcdBarrier b; b.bar = bar; b.x = xb_xcc_id(); b.st = st;
    if (threadIdx.x == 0) (void)xb_add(&bar[XB_XCNT(b.x)], 1u);
    return b;
}
__device__ __forceinline__ void xcd_barrier_complete(unsigned* bar, unsigned x, unsigned& nloc, unsigned& nx) {
    const unsigned G = gridDim.x * gridDim.y * gridDim.z;
    unsigned sum, cnt, mine, sp = 0u;
    for (;;) {
        sum = 0u; cnt = 0u; mine = 0u;
#pragma unroll
        for (unsigned j = 0; j < 16; ++j) { const unsigned c = xb_ld(&bar[XB_XCNT(j)]); sum += c; cnt += (c > 0u) ? 1u : 0u; mine = (j == x) ? c : mine; }
        if (sum == G) break;
        __builtin_amdgcn_s_sleep(1);
        if ((++sp & 255u) == 0u) { if (xb_ld(&bar[XB_TMO])) break; if (sp > XB_SPIN_CAP) { atomicAdd(&bar[XB_TMO], 1u); break; } }
    }
    nloc = mine > 0u ? mine : 1u; nx = cnt > 0u ? cnt : 1u;
}

__device__ __forceinline__ void xcd_barrier(const XcdBarrier& b) {
    asm volatile("s_waitcnt vmcnt(0)" ::: "memory");
    __syncthreads();
    if (threadIdx.x == 0) {
        unsigned* bar = b.bar;
        __builtin_amdgcn_s_waitcnt(0);
        unsigned nloc = b.st[0], nx = b.st[1]; const unsigned kbar = b.st[2]; b.st[2] = kbar + 1u;
        if (nloc == 0u) { xcd_barrier_complete(bar, b.x, nloc, nx); b.st[0] = nloc; b.st[1] = nx; }
        const unsigned old = xb_add(&bar[XB_XSUB(b.x)], 1u);
        const unsigned gen = old / nloc;
        if (old + 1u == (gen + 1u) * nloc) {
            __builtin_amdgcn_fence(__ATOMIC_RELEASE, "agent");
            asm volatile("s_waitcnt vmcnt(0)" ::: "memory");
            __hip_atomic_fetch_add(&bar[XB_TOP], 1u, __ATOMIC_RELAXED, __HIP_MEMORY_SCOPE_AGENT);
            __builtin_amdgcn_fence(__ATOMIC_ACQUIRE, "agent");
            XB_SPIN(xb_ld(&bar[XB_TOP]) < (kbar + 1u) * nx, bar);
            asm volatile("s_waitcnt vmcnt(0)" ::: "memory");
        } else {
            __builtin_amdgcn_fence(__ATOMIC_ACQUIRE, "agent");
            XB_SPIN(xb_ld(&bar[XB_TOP]) < (kbar + 1u) * nx, bar);
            asm volatile("s_waitcnt vmcnt(0)" ::: "memory");
        }
    }
    __syncthreads();
}

template <int CTRL> __device__ __forceinline__ float dppmov(float v) { return __builtin_bit_cast(float, __builtin_amdgcn_update_dpp(0, __builtin_bit_cast(int, v), CTRL, 0xf, 0xf, true)); }
__device__ __forceinline__ float wave_sum(float v) {
    v += dppmov<0xB1>(v); v += dppmov<0x4E>(v); v += dppmov<0x141>(v); v += dppmov<0x140>(v);
    return (__builtin_bit_cast(float, __builtin_amdgcn_readlane(__builtin_bit_cast(int, v), 0)) + __builtin_bit_cast(float, __builtin_amdgcn_readlane(__builtin_bit_cast(int, v), 16)))
         + (__builtin_bit_cast(float, __builtin_amdgcn_readlane(__builtin_bit_cast(int, v), 32)) + __builtin_bit_cast(float, __builtin_amdgcn_readlane(__builtin_bit_cast(int, v), 48)));
}
__device__ __forceinline__ float bf2f(unsigned short b) { return __builtin_bit_cast(float, (unsigned)b << 16); }
__device__ __forceinline__ float sigmoidf_(float x) { return __builtin_amdgcn_rcpf(1.f + __builtin_amdgcn_exp2f(-1.4426950408889634f * x)); }

namespace mix {
typedef short bf16x8 __attribute__((ext_vector_type(8)));
typedef short s16x4 __attribute__((ext_vector_type(4)));
typedef float f32x16 __attribute__((ext_vector_type(16)));
typedef float f32x2 __attribute__((ext_vector_type(2)));
typedef unsigned u32x2 __attribute__((ext_vector_type(2)));
constexpr float LOG2E = 1.4426950408889634f;
constexpr float QSCALE = 0.125f * LOG2E;
constexpr int ATT_K = 0, ATT_V = 65536;
constexpr int XCH_OFF = RING_BYTES + 1024;
constexpr size_t WS_AGG = 288 * MiB;
constexpr int NUNIT = BATCH * 64;
constexpr int SUB0_OFF = XCH_OFF + 2048;
constexpr int CWT_OFF = XCH_OFF + 4096;
constexpr int SEG_OFF = XCH_OFF + 12288;
static_assert(SEG_OFF + 16384 <= LDS_BYTES, "LDS exchange tables");

__device__ __forceinline__ int crow(int r, int hi) { return (r & 3) + 8 * (r >> 2) + 4 * hi; }
__device__ __forceinline__ float xhalf_max(float v) { auto rr = __builtin_amdgcn_permlane32_swap(__float_as_uint(v), __float_as_uint(v), false, false); return fmaxf(__uint_as_float(rr[0]), __uint_as_float(rr[1])); }
__device__ __forceinline__ float xhalf_sum(float v) { auto rr = __builtin_amdgcn_permlane32_swap(__float_as_uint(v), __float_as_uint(v), false, false); return __uint_as_float(rr[0]) + __uint_as_float(rr[1]); }
__device__ __forceinline__ float xhalf_other(float v) { auto rr = __builtin_amdgcn_permlane32_swap(__float_as_uint(v), __float_as_uint(v), false, false); return (threadIdx.x & 32) ? __uint_as_float(rr[0]) : __uint_as_float(rr[1]); }
__device__ __forceinline__ s16x4 vtr(const LAS unsigned char* p) { typedef short v4i16_t __attribute__((ext_vector_type(4))); return __builtin_bit_cast(s16x4, __builtin_amdgcn_ds_read_tr16_b64_v4i16((LAS v4i16_t*)p)); }
__device__ __forceinline__ unsigned cvtpk(float lo, float hi) { typedef __bf16 bf16x2_t __attribute__((ext_vector_type(2))); f32x2 v = {lo, hi}; bf16x2_t b = __builtin_convertvector(v, bf16x2_t); return __builtin_bit_cast(unsigned, b); }
__device__ __forceinline__ void fmac_s(float& acc, float a, float b) { asm("v_fmac_f32_e32 %0, %1, %2" : "+v"(acc) : "v"(a), "v"(b)); }
__device__ __forceinline__ float bflo(unsigned w) { return __builtin_bit_cast(float, w << 16); }
__device__ __forceinline__ float bfhi(unsigned w) { return __builtin_bit_cast(float, w & 0xffff0000u); }

__device__ __forceinline__ void attn_unit(LAS unsigned char* lds, const bf16* z, bf16* ymix, const float* sinks, int b, int n, int tid) {
    asm volatile("" : "+v"(tid));
    const int lane = tid & 63, wid = __builtin_amdgcn_readfirstlane(tid >> 6), r32 = lane & 31, hi = lane >> 5;
    const size_t row0 = (size_t)b * SEQ + (size_t)n * 128;
    const int hq = wid, hkv = wid >> 2;
    bf16x8 qr[4];
#pragma unroll
    for (int d0 = 0; d0 < 4; ++d0) qr[d0] = *(const GAS bf16x8*)(z + (row0 + r32) * NIN + ZQ + hq * 64 + 16 * d0 + 8 * hi);
#ifndef AREP_STAGE
#define AREP_STAGE 1
#define AREP_LOOP 1
#endif
    for (int arep_ = 0; arep_ < AREP_STAGE; ++arep_) {
    if (arep_) __syncthreads();
#pragma unroll
    for (int half = 0; half < 2; ++half) {
        v4u v[8];
        const bool have = (half == 1) || (n > 0);
#pragma unroll
        for (int i = 0; i < 8; ++i) { const int pi = (half * 8 + i) * 512 + tid, token = pi >> 5, c32 = pi & 31;
            if (have) v[i] = *(const GAS v4u*)(z + (row0 + token - 128) * NIN + ZK + 8 * c32); else v[i] = (v4u){0u, 0u, 0u, 0u}; }
#pragma unroll
        for (int i = 0; i < 8; ++i) { const int pi = (half * 8 + i) * 512 + tid, token = pi >> 5, c32 = pi & 31, kind = c32 >> 3, c = c32 & 7;
            const int dst = (kind < 2) ? (ATT_K + (kind & 1) * 32768 + token * 128 + ((c ^ ((token >> 1) & 7)) << 4))
                                       : (ATT_V + (kind & 1) * 32768 + (c >> 2) * 16384 + token * 64 + (c & 3) * 16);
            *(LAS v4u*)(lds + dst) = v[i]; }
    }
    }
    __syncthreads();
    const float sink2 = sinks[hq] * LOG2E;
    const LAS unsigned char* Kb = lds + ATT_K + hkv * 32768;
    const LAS unsigned char* Vb = lds + ATT_V + hkv * 32768 + ((lane >> 4) & 1) * 32 + (lane & 3) * 8 + (4 * hi + ((lane & 15) >> 2)) * 64;
    int koff[4];
#pragma unroll
    for (int d0 = 0; d0 < 4; ++d0) koff[d0] = r32 * 128 + (((2 * d0 + hi) ^ ((r32 >> 1) & 7)) << 4);
    LAS float* part = (LAS float*)(lds + XCH_OFF);
    const float NEG = -INFINITY;
    f32x16 mask0, mask4;
#pragma unroll
    for (int r = 0; r < 16; ++r) { const int cr = crow(r, hi); mask0[r] = (cr > r32) ? 0.f : NEG; mask4[r] = (cr <= r32) ? 0.f : NEG; }
    bf16x8 ones;
#pragma unroll
    for (int e = 0; e < 8; ++e) ones[e] = (short)0x3F80;
#pragma unroll 1
    for (int i4_ = 0; i4_ < 4 * AREP_LOOP; ++i4_) { const int i = i4_ & 3;
        const size_t qrow = row0 + 32 * i + r32;
        bf16x8 qn[4];
        { const size_t qnrow = row0 + 32 * ((i4_ + 1) & 3) + r32;
#pragma unroll
          for (int d0 = 0; d0 < 4; ++d0) qn[d0] = *(const GAS bf16x8*)(z + qnrow * NIN + ZQ + hq * 64 + 16 * d0 + 8 * hi); }
        const LAS unsigned char* kbi = Kb + 4096 * i;
        const LAS unsigned char* vbi = Vb + 2048 * i;
        f32x16 s[5];
#pragma unroll
        for (int kt = 0; kt < 5; ++kt) { s[kt] = kt == 0 ? mask0 : kt == 4 ? mask4 : (f32x16){};
#pragma unroll
            for (int d0 = 0; d0 < 4; ++d0) { const bf16x8 kf = *(const LAS bf16x8*)(kbi + 4096 * kt + koff[d0]); s[kt] = __builtin_amdgcn_mfma_f32_32x32x16_bf16(kf, qr[d0], s[kt], 0, 0, 0); } }
        if (n == 0) {
#pragma unroll
            for (int kt = 0; kt < 4; ++kt) if (i + kt < 4) {
#pragma unroll
                for (int r = 0; r < 16; ++r) s[kt][r] = NEG; } }
        float m = sink2;
#pragma unroll
        for (int kt = 0; kt < 5; ++kt)
#pragma unroll
            for (int r = 0; r < 16; r += 2) m = fmaxf(fmaxf(m, s[kt][r]), s[kt][r + 1]);
        m = xhalf_max(m);
#pragma unroll
        for (int kt = 0; kt < 5; ++kt)
#pragma unroll
            for (int r = 0; r < 16; ++r) s[kt][r] = __builtin_amdgcn_exp2f(s[kt][r] - m);
        f32x16 o[2], ls; o[0] = (f32x16){}; o[1] = (f32x16){}; ls = (f32x16){};
#pragma unroll
        for (int kt = 0; kt < 5; ++kt)
#pragma unroll
            for (int s2 = 0; s2 < 2; ++s2) {
                v4u pw; pw.x = cvtpk(s[kt][8 * s2 + 0], s[kt][8 * s2 + 1]); pw.y = cvtpk(s[kt][8 * s2 + 2], s[kt][8 * s2 + 3]); pw.z = cvtpk(s[kt][8 * s2 + 4], s[kt][8 * s2 + 5]); pw.w = cvtpk(s[kt][8 * s2 + 6], s[kt][8 * s2 + 7]);
                const bf16x8 pf = __builtin_bit_cast(bf16x8, pw);
#pragma unroll
                for (int blk = 0; blk < 2; ++blk) {
                    const s16x4 lo = vtr(vbi + (blk * 16384 + 2048 * kt + 1024 * s2)), hi4 = vtr(vbi + (blk * 16384 + 2048 * kt + 1024 * s2 + 512));
                    const bf16x8 vf = (bf16x8){lo[0], lo[1], lo[2], lo[3], hi4[0], hi4[1], hi4[2], hi4[3]};
                    o[blk] = __builtin_amdgcn_mfma_f32_32x32x16_bf16(vf, pf, o[blk], 0, 0, 0); }
                ls = __builtin_amdgcn_mfma_f32_32x32x16_bf16(ones, pf, ls, 0, 0, 0);
            }
        const float inv = __builtin_amdgcn_rcpf(ls[0] + __builtin_amdgcn_exp2f(sink2 - m)); float ss = 0.f;
#pragma unroll
        for (int blk = 0; blk < 2; ++blk)
#pragma unroll
            for (int r = 0; r < 16; ++r) ss = fmaf(o[blk][r], o[blk][r], ss);
        ss = xhalf_sum(ss) * (inv * inv);
        LAS float* pp = part + (i4_ & 1) * 256;
        if (hi == 0) pp[wid * 32 + r32] = ss;
        __syncthreads();
        float tot = 0.f;
#pragma unroll
        for (int w = 0; w < 8; ++w) tot += pp[w * 32 + r32];
        const float rs = __builtin_amdgcn_rsqf(tot * (1.0f / 512.0f) + RMS_EPS) * inv;
        bf16* orow = ymix + qrow * D + hq * 64 + 8 * hi;
#pragma unroll
        for (int blk = 0; blk < 2; ++blk)
#pragma unroll
            for (int gp = 0; gp < 2; ++gp) { const int ge = 2 * gp, go = 2 * gp + 1;
                const unsigned ex = cvtpk(o[blk][4 * ge] * rs, o[blk][4 * ge + 1] * rs), ey = cvtpk(o[blk][4 * ge + 2] * rs, o[blk][4 * ge + 3] * rs);
                const unsigned ox = cvtpk(o[blk][4 * go] * rs, o[blk][4 * go + 1] * rs), oy = cvtpk(o[blk][4 * go + 2] * rs, o[blk][4 * go + 3] * rs);
                auto sx = __builtin_amdgcn_permlane32_swap(ex, ox, false, false); auto sy = __builtin_amdgcn_permlane32_swap(ey, oy, false, false);
                v4u w; w.x = sx[0]; w.y = sy[0]; w.z = sx[1]; w.w = sy[1];
                *(GAS v4u*)(orow + 32 * blk + 16 * gp) = w; }
#pragma unroll
        for (int d0 = 0; d0 < 4; ++d0) qr[d0] = qn[d0];
    }
    __syncthreads();
}

__device__ __forceinline__ void conv_unit(LAS unsigned char* lds, const bf16* ub, bf16* ymix, const float* dw_w, const float* dw_b, const float* ln_g, const float* ln_b, int b, int n, int tid) {
    asm volatile("" : "+v"(tid));
    const int lane = tid & 63, wid = __builtin_amdgcn_readfirstlane(tid >> 6);
    LAS float* U = (LAS float*)lds;
    const int cp = tid & 127, tg = tid >> 7;
    f32x2 w[31];
#pragma unroll
    for (int k = 0; k < 31; ++k) w[k] = *(const GAS f32x2*)(dw_w + k * 256 + 2 * cp);
    const f32x2 bias = *(const GAS f32x2*)(dw_b + 2 * cp);
    const f32x4 lg = *(const GAS f32x4*)(ln_g + 4 * lane), lb = *(const GAS f32x4*)(ln_b + 4 * lane);
#pragma unroll 1
    for (int half = 0; half < 2; ++half) {
        const int t0 = n * 128 + half * 64;
        const size_t rowb = (size_t)b * SEQ;
        {
            v4u vv[6];
#pragma unroll
            for (int j = 0; j < 6; ++j) { const int task = tid + 512 * j, r = task >> 5, c8 = task & 31, tt = t0 - 30 + r;
                if (task < 94 * 32 && tt >= 0) vv[j] = *(const GAS v4u*)(ub + (rowb + tt) * 256 + 8 * c8); else vv[j] = (v4u){0u, 0u, 0u, 0u}; }
#pragma unroll
            for (int j = 0; j < 6; ++j) { const int task = tid + 512 * j, r = task >> 5, c8 = task & 31;
                if (task < 94 * 32) { const f32x4 u0 = (f32x4){bflo(vv[j].x), bfhi(vv[j].x), bflo(vv[j].y), bfhi(vv[j].y)}, u1 = (f32x4){bflo(vv[j].z), bfhi(vv[j].z), bflo(vv[j].w), bfhi(vv[j].w)};
                    *(LAS f32x4*)(U + r * 256 + 8 * c8) = u0; *(LAS f32x4*)(U + r * 256 + 8 * c8 + 4) = u1; } }
        }
        __syncthreads();
        float acc0[2][8], acc1[2][8];
#pragma unroll
        for (int g = 0; g < 2; ++g) {
            const LAS float* up = U + (tg * 16 + g * 8) * 256 + 2 * cp;
#pragma unroll
            for (int jj = 0; jj < 8; ++jj) { acc0[g][jj] = bias[0]; acc1[g][jj] = bias[1]; }
#pragma unroll
            for (int rr = 0; rr < 38; ++rr) { const f32x2 u2 = *(const LAS f32x2*)(up + rr * 256);
#pragma unroll
                for (int jj = 0; jj < 8; ++jj) { const int k = rr - jj; if (k >= 0 && k <= 30) { fmac_s(acc0[g][jj], w[k][0], u2[0]); fmac_s(acc1[g][jj], w[k][1], u2[1]); } } }
        }
        __syncthreads();
#pragma unroll
        for (int g = 0; g < 2; ++g)
#pragma unroll
            for (int jj = 0; jj < 8; ++jj) *(LAS f32x2*)(U + (tg * 16 + g * 8 + jj) * 256 + 2 * cp) = (f32x2){acc0[g][jj], acc1[g][jj]};
        __syncthreads();
#pragma unroll
        for (int jj = 0; jj < 8; ++jj) { const int tok = wid * 8 + jj;
            f32x4 x = *(const LAS f32x4*)(U + tok * 256 + 4 * lane);
            const float mu = wave_sum((x[0] + x[1]) + (x[2] + x[3])) * (1.f / 256.f);
            x = x - mu;
            const float var = wave_sum((x[0] * x[0] + x[1] * x[1]) + (x[2] * x[2] + x[3] * x[3])) * (1.f / 256.f);
            const float rstd = __builtin_amdgcn_rsqf(var + LN_EPS);
            f32x4 y = x * rstd * lg + lb;
#pragma unroll
            for (int e = 0; e < 4; ++e) y[e] = y[e] * sigmoidf_(y[e]);
            const float ss = wave_sum((y[0] * y[0] + y[1] * y[1]) + (y[2] * y[2] + y[3] * y[3]));
            const float rs = __builtin_amdgcn_rsqf(ss * (1.f / 256.f) + RMS_EPS);
            u32x2 o; o.x = cvtpk(y[0] * rs, y[1] * rs); o.y = cvtpk(y[2] * rs, y[3] * rs);
            *(GAS u32x2*)(ymix + (rowb + t0 + tok) * D + 512 + 4 * lane) = o; }
        __syncthreads();
    }
}

struct LruState { f32x16 H[2][2]; };
__device__ __forceinline__ bf16x8 ident_frag(int s, int hi, int col) {
    bf16x8 f;
#pragma unroll
    for (int e = 0; e < 8; ++e) f[e] = (16 * s + 8 * hi + e == col) ? (short)0x3F80 : (short)0;
    return f;
}
__device__ __forceinline__ void lru_tables(LAS unsigned char* lds, const float* cw, const float* cb, const float* ba, const float* bx, const float* lam, int tid) {
    LAS float* cwt = (LAS float*)(lds + CWT_OFF);
    for (int e = tid; e < 1024; e += 512) cwt[e] = cw[e];
    if (tid < 256) { cwt[1024 + tid] = cb[tid]; cwt[1280 + tid] = ba[tid]; }
    else { const int c = tid - 256; cwt[1536 + c] = bx[c]; const float lm = -lam[c]; cwt[1792 + c] = fmaxf(lm, 0.f) + log1pf(__expf(-fabsf(lm))); }
}
__device__ __forceinline__ int pidx(int token, int ch) { return token * 256 + (ch ^ ((token & 7) << 2)); }
__device__ __forceinline__ void lru_local(LruState& st, const bf16* z, const bf16* wfrag, float* agg, LAS unsigned char* lds, int b, int n, int tid) {
    asm volatile("" : "+v"(tid));
    const int lane = tid & 63, wid = __builtin_amdgcn_readfirstlane(tid >> 6), r32 = lane & 31, hi = lane >> 5, hd = wid >> 1, th = wid & 1;
    float fin[2][2];
    LAS float* PL = (LAS float*)lds;
    const LAS float* cwt = (const LAS float*)(lds + CWT_OFF);
    const size_t row_w = (size_t)b * SEQ + (size_t)n * 128 + th * 64;
    const int tseq_w = n * 128 + th * 64;
    v4u xv[4][4];
#define LRU_LOAD_ROWS(tm) do { const int tseq_ = tseq_w + 32 * (tm) + r32; _Pragma("unroll") for (int s = 0; s < 4; ++s) { const bf16* zp = z + (row_w + 32 * (tm) + r32) * NIN + ZRX + hd * 64 + 16 * s + 8 * hi; \
        _Pragma("unroll") for (int k = 0; k < 4; ++k) xv[s][k] = *(const GAS v4u*)(zp - (ptrdiff_t)(tseq_ >= 3 - k ? 3 - k : 0) * NIN); } } while (0)
#define LRU_BUILD_XF(tm) do { const int tseq_ = tseq_w + 32 * (tm) + r32, tok_ = th * 64 + 32 * (tm) + r32; _Pragma("unroll") for (int s = 0; s < 4; ++s) { const int ch = hd * 64 + 16 * s + 8 * hi; \
            f32x4 a0 = *(const LAS f32x4*)(cwt + 1024 + ch), a1 = *(const LAS f32x4*)(cwt + 1024 + ch + 4); \
            _Pragma("unroll") for (int k = 0; k < 4; ++k) { const float mk = tseq_ >= 3 - k ? 1.f : 0.f; \
                const f32x4 w0 = *(const LAS f32x4*)(cwt + k * 256 + ch), w1 = *(const LAS f32x4*)(cwt + k * 256 + ch + 4); \
                const v4u x = xv[s][k]; \
                a0[0] += w0[0] * (mk * bflo(x.x)); a0[1] += w0[1] * (mk * bfhi(x.x)); a0[2] += w0[2] * (mk * bflo(x.y)); a0[3] += w0[3] * (mk * bfhi(x.y)); \
                a1[0] += w1[0] * (mk * bflo(x.z)); a1[1] += w1[1] * (mk * bfhi(x.z)); a1[2] += w1[2] * (mk * bflo(x.w)); a1[3] += w1[3] * (mk * bfhi(x.w)); } \
            v4u pw; pw.x = cvtpk(a0[0], a0[1]); pw.y = cvtpk(a0[2], a0[3]); pw.z = cvtpk(a1[0], a1[1]); pw.w = cvtpk(a1[2], a1[3]); \
            xf[tm][s] = __builtin_bit_cast(bf16x8, pw); \
            *(LAS f32x4*)(PL + pidx(tok_, ch)) = a0; *(LAS f32x4*)(PL + pidx(tok_, ch + 4)) = a1; } \
        asm volatile("s_waitcnt lgkmcnt(0)" ::: "memory"); } while (0)
    LRU_LOAD_ROWS(0);
    bf16x8 waf[4], wxf[4];
#pragma unroll
    for (int s = 0; s < 4; ++s) { waf[s] = *(const GAS bf16x8*)(wfrag + ((size_t)((0 * 4 + hd) * 2 + 0) * 4 + s) * 512 + lane * 8); wxf[s] = *(const GAS bf16x8*)(wfrag + ((size_t)((1 * 4 + hd) * 2 + 0) * 4 + s) * 512 + lane * 8); }
    bf16x8 xf[2][4];
    LRU_BUILD_XF(0);
    LRU_LOAD_ROWS(1);
#pragma unroll
    for (int tn = 0; tn < 2; ++tn) {
        const int c = hd * 64 + 32 * tn + r32;
        const float bav = cwt[1280 + c], bxv = cwt[1536 + c], sp = cwt[1792 + c];
        int cx[4];
#pragma unroll
        for (int e = 0; e < 4; ++e) cx[e] = c ^ ((4 * hi + e) << 2);
        bf16x8 waf2[4], wxf2[4];
        float CA = 1.f, CB = 0.f;
#pragma unroll
        for (int tm = 0; tm < 2; ++tm) {
            __builtin_amdgcn_sched_barrier(0);
            if (tn == 0 && tm == 1) { LRU_BUILD_XF(1);
#pragma unroll
                for (int s = 0; s < 4; ++s) { waf2[s] = *(const GAS bf16x8*)(wfrag + ((size_t)((0 * 4 + hd) * 2 + 1) * 4 + s) * 512 + lane * 8); wxf2[s] = *(const GAS bf16x8*)(wfrag + ((size_t)((1 * 4 + hd) * 2 + 1) * 4 + s) * 512 + lane * 8); }
                __builtin_amdgcn_sched_barrier(0); }
            f32x16 ra = (f32x16){}, ia = (f32x16){};
#pragma unroll
            for (int s = 0; s < 4; ++s) { ra = __builtin_amdgcn_mfma_f32_32x32x16_bf16(xf[tm][s], waf[s], ra, 0, 0, 0); ia = __builtin_amdgcn_mfma_f32_32x32x16_bf16(xf[tm][s], wxf[s], ia, 0, 0, 0); }
            LAS float* pl = PL + (th * 64 + 32 * tm + 4 * hi) * 256;
#pragma unroll
            for (int r = 0; r < 16; ++r) { const float rg = sigmoidf_(ra[r] + bav), ig = sigmoidf_(ia[r] + bxv);
                const float a = __builtin_amdgcn_exp2f((-8.f * LOG2E) * rg * sp);
                ra[r] = a;
                ia[r] = __builtin_amdgcn_sqrtf(fmaf(-a, a, 1.f)) * (ig * pl[((r & 3) + 8 * (r >> 2)) * 256 + cx[r & 3]]); }
#pragma unroll
            for (int g = 0; g < 4; ++g)
#pragma unroll
                for (int e = 1; e < 4; ++e) { ia[4 * g + e] = ra[4 * g + e] * ia[4 * g + e - 1] + ia[4 * g + e]; ra[4 * g + e] = ra[4 * g + e] * ra[4 * g + e - 1]; }
#pragma unroll
            for (int g = 0; g < 4; ++g) {
                const float ownA = ra[4 * g + 3], ownB = ia[4 * g + 3];
                const float othA = xhalf_other(ownA), othB = xhalf_other(ownB);
                float EA = 0.f, EB = 0.f;
                { const float A = hi ? othA : ownA, B = hi ? othB : ownB; if (!hi) { EA = CA; EB = CB; } CB = A * CB + B; CA = A * CA; }
                { const float A = hi ? ownA : othA, B = hi ? ownB : othB; if (hi) { EA = CA; EB = CB; } CB = A * CB + B; CA = A * CA; }
#pragma unroll
                for (int e = 0; e < 4; ++e) { ia[4 * g + e] += ra[4 * g + e] * EB; pl[(e + 8 * g) * 256 + cx[e]] = ra[4 * g + e] * EA; }
            }
            st.H[tm][tn] = ia;
        }
        fin[tn][0] = CA; fin[tn][1] = CB;
        if (tn == 0) {
#pragma unroll
            for (int s = 0; s < 4; ++s) { waf[s] = waf2[s]; wxf[s] = wxf2[s]; } }
    }
#undef LRU_LOAD_ROWS
#undef LRU_BUILD_XF
    LAS f32x2* sub0 = (LAS f32x2*)(lds + SUB0_OFF);
    if (th == 0 && hi == 0) {
#pragma unroll
        for (int tn = 0; tn < 2; ++tn) sub0[(hd * 2 + tn) * 32 + r32] = (f32x2){fin[tn][0], fin[tn][1]}; }
    __syncthreads();
    if (th == 1 && hi == 0) {
#pragma unroll
        for (int tn = 0; tn < 2; ++tn) { const f32x2 f0 = sub0[(hd * 2 + tn) * 32 + r32]; const int c = hd * 64 + 32 * tn + r32, unit = b * 64 + n;
            agg[(size_t)unit * 256 + c] = fin[tn][0] * f0[0]; agg[(size_t)(NUNIT + unit) * 256 + c] = fin[tn][0] * f0[1] + fin[tn][1]; } }
}
__device__ __forceinline__ float gelu_tanh(float x) { const float u = 0.7978845608028654f * (x + 0.044715f * x * x * x); const float e = __expf(2.f * u); const float th = 1.f - 2.f * __builtin_amdgcn_rcpf(e + 1.f); return 0.5f * x * (1.f + th); }
__device__ __forceinline__ void lru_final(LruState& st, LAS unsigned char* lds, const bf16* z, bf16* ymix, const float* agg, int b, int n, int tid) {
    asm volatile("" : "+v"(tid));
    const int lane = tid & 63, wid = __builtin_amdgcn_readfirstlane(tid >> 6), r32 = lane & 31, hi = lane >> 5, hd = wid >> 1, th = wid & 1;
    const size_t row_u = (size_t)b * SEQ + (size_t)n * 128, row_w = row_u + th * 64;
    LAS float* Y = (LAS float*)lds;
    LAS f32x2* seg = (LAS f32x2*)(lds + SEG_OFF);
    { f32x4 SA = (f32x4){1.f, 1.f, 1.f, 1.f}, SB = (f32x4){0.f, 0.f, 0.f, 0.f}; f32x4 ta[8], tb[8];
      const float* aA = agg + (size_t)(b * 64) * 256 + 4 * lane; const float* aB = agg + (size_t)(NUNIT + b * 64) * 256 + 4 * lane;
#pragma unroll
      for (int jj = 0; jj < 8; ++jj) { const int j = 8 * wid + jj;
          if (j < n) { ta[jj] = *(const GAS f32x4*)(aA + (size_t)j * 256); tb[jj] = *(const GAS f32x4*)(aB + (size_t)j * 256); } else { ta[jj] = (f32x4){1.f, 1.f, 1.f, 1.f}; tb[jj] = (f32x4){0.f, 0.f, 0.f, 0.f}; } }
#pragma unroll
      for (int jj = 0; jj < 8; ++jj) { SB = ta[jj] * SB + tb[jj]; SA = ta[jj] * SA; }
#pragma unroll
      for (int e = 0; e < 4; ++e) seg[wid * 256 + 4 * lane + e] = (f32x2){SA[e], SB[e]}; }
    bf16x8 gf[2][4];
#pragma unroll
    for (int tm = 0; tm < 2; ++tm)
#pragma unroll
        for (int s = 0; s < 4; ++s) gf[tm][s] = *(const GAS bf16x8*)(z + (row_w + 32 * tm + r32) * NIN + ZRG + hd * 64 + 16 * s + 8 * hi);
    __syncthreads();
#pragma unroll
    for (int tn = 0; tn < 2; ++tn) {
        const int col = 32 * tn + r32, c = hd * 64 + col;
        float carry = 0.f;
#pragma unroll
        for (int w = 0; w < 8; ++w) { const f32x2 sg = seg[w * 256 + c]; carry = sg[0] * carry + sg[1]; }
        if (th == 1) { const f32x2 f0 = ((const LAS f32x2*)(lds + SUB0_OFF))[(hd * 2 + tn) * 32 + r32]; carry = f0[0] * carry + f0[1]; }
#pragma unroll
        for (int tm = 0; tm < 2; ++tm) {
            f32x16 gd = (f32x16){};
#pragma unroll
            for (int s = 0; s < 4; ++s) gd = __builtin_amdgcn_mfma_f32_32x32x16_bf16(gf[tm][s], ident_frag(s, hi, col), gd, 0, 0, 0);
#pragma unroll
            for (int r = 0; r < 16; ++r) { LAS float* yp = Y + pidx(th * 64 + 32 * tm + crow(r, hi), c);
                const float h = st.H[tm][tn][r] + *yp * carry; *yp = h * gd[r]; }
        }
    }
    __syncthreads();
#pragma unroll
    for (int jj = 0; jj < 16; ++jj) { const int tok = wid * 16 + jj;
        const f32x4 y = *(const LAS f32x4*)(Y + pidx(tok, 4 * lane));
        const float ss = wave_sum((y[0] * y[0] + y[1] * y[1]) + (y[2] * y[2] + y[3] * y[3]));
        const float rs = __builtin_amdgcn_rsqf(ss * (1.f / 256.f) + RMS_EPS);
        u32x2 o; o.x = cvtpk(y[0] * rs, y[1] * rs); o.y = cvtpk(y[2] * rs, y[3] * rs);
        *(GAS u32x2*)(ymix + (row_u + tok) * D + 768 + 4 * lane) = o; }
    __syncthreads();
}
}

struct Frame {
    LAS unsigned char* lds;
    volatile LAS unsigned* MISC;
    gu32* ctl;
    int vcu, G;
};
__device__ __forceinline__ int otid() { int t = threadIdx.x; asm volatile("" : "+v"(t)); return t; }
struct Lw { int tid, lane, wave; __device__ __forceinline__ Lw() { tid = otid(); lane = tid & 63; wave = __builtin_amdgcn_readfirstlane(tid >> 6); } };
struct Args { const float* in[21]; float* out; unsigned char* ws; int ph_lo, ph_hi, bar_region, pad; };
typedef const __attribute__((address_space(4))) Args* ArgsP;
#define ARGS_PTR() ({ ArgsP p_ = (ArgsP)__builtin_amdgcn_kernarg_segment_ptr(); asm volatile("" : "+s"(p_)); p_; })
enum { I_X = 0, I_NORM1, I_WIN, I_SINKS, I_CDW, I_CDB, I_CLG, I_CLB, I_LCW, I_LCB, I_LWA, I_LBA, I_LWX, I_LBX, I_LAM, I_MIXN, I_WOUT, I_NORM2, I_WUP, I_WDOWN, I_FNORM };
constexpr int PH_PRO = 0, PH_L0 = 1, PH_PER_LAYER = 6, PH_FINAL = PH_L0 + DEPTH * PH_PER_LAYER, PH_N = PH_FINAL + 1;

template <bool REMAP> __device__ __forceinline__ void transpose_item(const float* W, const float* gain, int K, int N, bf16* WT, LAS float* scr, int item, int lane) {
    const int nblk = N / 32, kb = item / nblk, nb = item % nblk, k0 = 64 * kb, n0 = 32 * nb;
    int ns = n0; if (REMAP && n0 >= 768 && n0 < 1280) { const int t = n0 - 768, w = t & 255; ns = 768 + ((w >> 5) & 1) * 256 + (t >> 8) * 128 + (w >> 6) * 32; }
    f32x4 v[8]; float g[8];
#pragma unroll
    for (int i = 0; i < 8; ++i) { const int row = 8 * i + (lane >> 3); v[i] = *(const GAS f32x4*)(W + (size_t)(k0 + row) * N + ns + 4 * (lane & 7)); g[i] = gain ? gain[k0 + row] : 1.f; }
#pragma unroll
    for (int i = 0; i < 8; ++i) { const int row = 8 * i + (lane >> 3); *(LAS f32x4*)(scr + row * 36 + 4 * (lane & 7)) = v[i] * g[i]; }
    LDS_WAIT(); asm volatile("" ::: "memory");
    const int n = lane & 31, h = lane >> 5;
#pragma unroll
    for (int j = 0; j < 4; ++j) { const int kc = 2 * j + h; const LAS float* s = scr + (8 * kc) * 36 + n;
        v4u o; o.x = pk2(s[0 * 36], s[1 * 36]); o.y = pk2(s[2 * 36], s[3 * 36]); o.z = pk2(s[4 * 36], s[5 * 36]); o.w = pk2(s[6 * 36], s[7 * 36]);
        *(GAS v4u*)(WT + (size_t)(n0 + n) * K + k0 + 8 * kc) = o; }
    LDS_WAIT(); asm volatile("" ::: "memory");
}
constexpr int I_IN = (D / 64) * (NIN / 32), I_OUT = (D / 64) * (D / 32), I_UP = (D / 64) * (FF / 32), I_DN = (FF / 64) * (D / 32);
__device__ __forceinline__ void weight_item(ArgsP ap, int l, int mat, int r, LAS float* scr, int lane) {
    unsigned char* wl = ap->ws + WS_W + (size_t)l * W_LAYER;
    if (mat == 0)      transpose_item<true>(ap->in[I_WIN] + (size_t)l * D * NIN, ap->in[I_NORM1] + l * D, D, NIN, (bf16*)(wl + W_IN), scr, r, lane);
    else if (mat == 1) transpose_item<false>(ap->in[I_WOUT] + (size_t)l * D * D, ap->in[I_MIXN] + l * D, D, D, (bf16*)(wl + W_OUT), scr, r, lane);
    else if (mat == 2) transpose_item<false>(ap->in[I_WUP] + (size_t)l * D * FF, ap->in[I_NORM2] + l * D, D, FF, (bf16*)(wl + W_UP), scr, r, lane);
    else               transpose_item<false>(ap->in[I_WDOWN] + (size_t)l * FF * D, nullptr, FF, D, (bf16*)(wl + W_DOWN), scr, r, lane);
}
__device__ __forceinline__ void slack_weights(Frame& F, ArgsP ap, int l) {
    if (blockIdx.x < 128) return;
    const Lw L;
    LAS float* scr = (LAS float*)(F.lds + RING_OFF + L.wave * 16384);
    const int gw = ((int)blockIdx.x - 128) * NWAVES + L.wave, NGW = 128 * NWAVES;
    const int total = I_OUT + I_UP + I_DN + (l == 0 ? I_IN : 0);
    for (int it = gw; it < total; it += NGW) {
        int r = it;
        if (r < I_OUT) { weight_item(ap, l, 1, r, scr, L.lane); continue; } r -= I_OUT;
        if (r < I_UP) { weight_item(ap, l, 2, r, scr, L.lane); continue; } r -= I_UP;
        if (r < I_DN) { weight_item(ap, l, 3, r, scr, L.lane); continue; } r -= I_DN;
        weight_item(ap, 1, 0, r, scr, L.lane);
    }
}
__device__ __forceinline__ void rows_to_bf16_ss(int lane, const float* x, bf16* hb, float* ssp, int m0) {
    f32x4 v[4][4]; float s[4] = {0.f, 0.f, 0.f, 0.f};
#pragma unroll
    for (int q = 0; q < 4; ++q) { const GAS f32x4* xr = (const GAS f32x4*)(x + (size_t)(m0 + q) * D) + lane;
#pragma unroll
        for (int j = 0; j < 4; ++j) v[q][j] = xr[64 * j]; }
#pragma unroll
    for (int q = 0; q < 4; ++q) {
#pragma unroll
        for (int j = 0; j < 4; ++j) s[q] += (v[q][j].x * v[q][j].x + v[q][j].y * v[q][j].y) + (v[q][j].z * v[q][j].z + v[q][j].w * v[q][j].w);
        s[q] = wave_sum(s[q]);
        GAS unsigned long long* o8 = (GAS unsigned long long*)(hb + (size_t)(m0 + q) * D) + lane;
#pragma unroll
        for (int j = 0; j < 4; ++j) o8[64 * j] = (unsigned long long)pk2(v[q][j].x, v[q][j].y) | ((unsigned long long)pk2(v[q][j].z, v[q][j].w) << 32);
    }
    if (lane < 16) *(GAS f32x4*)(ssp + pg8::ssp_idx(m0, lane)) = lane == 0 ? (f32x4){s[0], s[1], s[2], s[3]} : (f32x4){0.f, 0.f, 0.f, 0.f};
}
__device__ __forceinline__ void p0_prologue(Frame& F, ArgsP ap) {
    const Lw L;
    LAS float* scr = (LAS float*)(F.lds + RING_OFF + L.wave * 16384);
    const int gw = F.vcu * NWAVES + L.wave, NGW = F.G * NWAVES;
    for (int it = gw; it < I_IN; it += NGW) weight_item(ap, 0, 0, it, scr, L.lane);
    for (int it = gw; it < DEPTH * 64; it += NGW) { const int l = it >> 6, gate = (it >> 5) & 1, hd = (it >> 3) & 3, tn = (it >> 2) & 1, s = it & 3;
        const float* W = ap->in[gate ? I_LWX : I_LWA] + (size_t)l * 4 * 64 * 64; float t[8];
#pragma unroll
        for (int e = 0; e < 8; ++e) t[e] = W[(size_t)(hd * 64 + 16 * s + 8 * (L.lane >> 5) + e) * 64 + 32 * tn + (L.lane & 31)];
        v4u o; o.x = pk2(t[0], t[1]); o.y = pk2(t[2], t[3]); o.z = pk2(t[4], t[5]); o.w = pk2(t[6], t[7]);
        *(GAS v4u*)((bf16*)(ap->ws + WS_WFRAG) + (size_t)l * WFRAG_LAYER + (size_t)(it & 63) * 512 + L.lane * 8) = o; }
    bf16* hb = (bf16*)(ap->ws + WS_HB); float* ssp = (float*)(ap->ws + WS_SSP);
    for (int m = 4 * gw; m < M; m += 4 * NGW) rows_to_bf16_ss(L.lane, ap->in[I_X], hb, ssp, m);
}

__global__ void __launch_bounds__(NWAVES * 64, 2) skel_fwd(Args args) {
    extern __shared__ __attribute__((aligned(16))) unsigned char lds[];
    Frame F;
    F.lds = (LAS unsigned char*)lds;
    F.MISC = (volatile LAS unsigned*)(F.lds + MISC_OFF);
    F.G = gridDim.x; { const int bx = blockIdx.x; F.vcu = (F.G % 8 == 0) ? (bx % 8) * (F.G / 8) + bx / 8 : bx; }
    ArgsP ap0 = ARGS_PTR();
    unsigned char* ws = ap0->ws;
    F.ctl = (gu32*)(ws + WS_CTL);
    for (int u = otid(); u < (LDS_BYTES - LDSCTL_OFF) / 4; u += NWAVES * 64) ((LAS unsigned*)(F.lds + LDSCTL_OFF))[u] = 0u;
    __syncthreads();
    XcdBarrier bar = xcd_barrier_post((unsigned*)(F.ctl + CW_BAR) + ap0->bar_region * XCD_BAR_WORDS, F.MISC + 8);
    bf16* hb = (bf16*)(ws + WS_HB); bf16* h1 = (bf16*)(ws + WS_H1); float* ssp = (float*)(ws + WS_SSP); float* ssp2 = (float*)(ws + WS_SSP2); bf16* z = (bf16*)(ws + WS_Z); bf16* ymix = (bf16*)(ws + WS_YMIX); bf16* hh = (bf16*)(ws + WS_HH);

#ifndef MKEEP
#define MKEEP(x) true
#endif
constexpr unsigned INPROJ_PNPERM = 3u | (4u << 3) | (6u << 6) | (0u << 9) | (1u << 12) | (2u << 15) | (5u << 18);
#ifndef PROBE_KLOOP_PHASE
#define PROBE_KLOOP_AGAIN(l, k) do {} while (0)
#else
#define PROBE_KLOOP_AGAIN(l, k) do { if ((l) == 0 && (k) == PROBE_KLOOP_PHASE) { xcd_barrier(bar); pg8::EpiAny E2 = E; E2.mode = 9 + (int)__hip_atomic_load(F.ctl + 8, __ATOMIC_RELAXED, __HIP_MEMORY_SCOPE_AGENT); pg8::gemm_phase<pg8::EpiAny, pg8::StaticOrder, PG8_ALIGN, PG8_SP2>(F.lds + RING_OFF, g, S, E2); } } while (0)
#endif
#ifndef DOWN_REV
#define DOWN_REV 1
#endif
#ifndef PROBE_UP_AGAIN
#define PROBE_UP_AGAIN(l) do {} while (0)
#endif
#ifndef MREP
#define MREP(x) 1
#endif
#ifndef KEEP
#define KEEP(x) true
#endif
    const int lo = ap0->ph_lo, hi = ap0->ph_hi;
#define IN(p) (lo <= (p) && (p) < hi)
#define SEAM(p) do { if (IN(p) && IN((p) + 1)) xcd_barrier(bar); } while (0)
    if (IN(PH_PRO)) { p0_prologue(F, ARGS_PTR()); SEAM(PH_PRO); }
#ifdef RES_PINGPONG
#define RES_W(a, b) (a)
#else
#define RES_W(a, b) (b)
#endif
#define LAYER_BODY(l) do { \
        const int p = PH_L0 + l * PH_PER_LAYER; \
        unsigned char* wl = ws + WS_W + (size_t)l * W_LAYER; \
        if (IN(p) && KEEP(0)) { \
            pg8::Gemm g{hb, (const bf16*)(wl + W_IN), M, NIN, D, 1}; pg8::StaticOrder S; S.init(M, NIN, F.G, (int)blockIdx.x); S.pnperm = INPROJ_PNPERM; \
            const LAS float* rs_tab = (const LAS float*)(F.lds + mix::XCH_OFF); \
            { LAS float* tab = (LAS float*)(F.lds + mix::XCH_OFF); pg8::Unit u_; const int t_ = otid(); const int r_ = t_ >> 1, hf_ = t_ & 1; \
              f32x4 a_[4], b_[4]; bool ok_[4]; \
              _Pragma("unroll") for (int i_ = 0; i_ < 4; ++i_) { ok_[i_] = S.next(i_, u_); a_[i_] = (f32x4){0.f, 0.f, 0.f, 0.f}; b_[i_] = a_[i_]; \
                  if (ok_[i_]) { const float* p_ = ssp + pg8::ssp_idx(u_.pm * 256 + r_, 8 * hf_); _Pragma("unroll") for (int e_ = 0; e_ < 4; ++e_) { a_[i_][e_] = p_[16 * e_]; b_[i_][e_] = p_[16 * (4 + e_)]; } } } \
              _Pragma("unroll") for (int i_ = 0; i_ < 4; ++i_) { float s_ = ((a_[i_][0] + a_[i_][1]) + (a_[i_][2] + a_[i_][3])) + ((b_[i_][0] + b_[i_][1]) + (b_[i_][2] + b_[i_][3])); s_ += dppmov<0xB1>(s_); \
                  if (ok_[i_] && !hf_) tab[i_ * 256 + r_] = __builtin_amdgcn_rsqf(s_ * (1.0f / 1024.0f) + RMS_EPS); } \
              __syncthreads(); } \
            pg8::EpiAny E{0, z, NIN, nullptr, nullptr, 512, mix::QSCALE, rs_tab, nullptr, nullptr, nullptr, (bf16*)(ws + WS_UBUF)}; \
            pg8::gemm_phase<pg8::EpiAny, pg8::StaticOrder, PG8_ALIGN, PG8_SP2>(F.lds + RING_OFF, g, S, E); \
            slack_weights(F, ARGS_PTR(), l); \
            SEAM(p); \
        } \
        if (IN(p + 1)) { \
            const int b = F.vcu >> 6, n = F.vcu & 63; ArgsP ap = ARGS_PTR(); \
            float* agg = (float*)(ws + mix::WS_AGG); \
            mix::lru_tables(F.lds, ap->in[I_LCW] + l * 4 * 256, ap->in[I_LCB] + l * 256, ap->in[I_LBA] + l * 256, ap->in[I_LBX] + l * 256, ap->in[I_LAM] + l * 256, otid()); \
            for (int rep_ = 0; rep_ < MREP(0); ++rep_) mix::attn_unit(F.lds, z, ymix, ap->in[I_SINKS] + l * 8, b, n, otid()); \
            for (int rep_ = 0; rep_ < MREP(1); ++rep_) mix::conv_unit(F.lds, (const bf16*)(ws + WS_UBUF), ymix, ap->in[I_CDW] + l * 31 * 256, ap->in[I_CDB] + l * 256, ap->in[I_CLG] + l * 256, ap->in[I_CLB] + l * 256, b, n, otid()); \
            mix::LruState st; \
            for (int rep_ = 0; rep_ < MREP(2); ++rep_) mix::lru_local(st, z, (const bf16*)(ws + WS_WFRAG) + (size_t)l * WFRAG_LAYER, agg, F.lds, b, n, otid()); \
            xcd_barrier(bar); \
            if (MKEEP(3)) mix::lru_final(st, F.lds, z, ymix, agg, b, n, otid()); \
            SEAM(p + 1); \
        } \
        if (IN(p + 3) && KEEP(3)) { \
            pg8::Gemm g{ymix, (const bf16*)(wl + W_OUT), M, D, D, 1}; pg8::StaticOrder S; S.init(M, D, F.G, (int)blockIdx.x); \
            pg8::EpiAny E{2, RES_W(h1, hb), D, nullptr, ssp2, 0, 1.f, nullptr, nullptr, nullptr, nullptr, nullptr, hb}; \
            pg8::gemm_phase<pg8::EpiAny, pg8::StaticOrder, PG8_ALIGN, PG8_SP2>(F.lds + RING_OFF, g, S, E); \
            PROBE_KLOOP_AGAIN(l, 3); \
            SEAM(p + 3); \
        } \
        if (IN(p + 4) && KEEP(4)) { \
            pg8::Gemm g{RES_W(h1, hb), (const bf16*)(wl + W_UP), M, FF, D, 1}; pg8::StaticOrder S; S.init(M, FF, F.G, (int)blockIdx.x); \
            pg8::EpiAny E{1, hh, FF, nullptr, nullptr, 0, 1.f, nullptr, nullptr, nullptr, nullptr, nullptr}; \
            pg8::gemm_phase<pg8::EpiAny, pg8::StaticOrder, PG8_ALIGN, PG8_SP2>(F.lds + RING_OFF, g, S, E); \
            PROBE_UP_AGAIN(l); \
            SEAM(p + 4); \
        } \
        if (IN(p + 5) && KEEP(5)) { \
            pg8::Gemm g{hh, (const bf16*)(wl + W_DOWN), M, D, FF, 1}; pg8::StaticOrder S; S.init(M, D, F.G, (int)blockIdx.x); S.rev16 = DOWN_REV; \
            ArgsP ap = ARGS_PTR(); \
            pg8::EpiAny E{l == DEPTH - 1 ? 4 : 3, hb, D, ssp2, ssp, 0, 1.f, nullptr, ap->out, ap->in[I_FNORM], (unsigned*)(F.ctl + CW_FIN), nullptr, RES_W(h1, hb)}; \
            pg8::gemm_phase<pg8::EpiAny, pg8::StaticOrder, PG8_ALIGN, PG8_SP2>(F.lds + RING_OFF, g, S, E); \
            PROBE_KLOOP_AGAIN(l, 5); \
            if (l < DEPTH - 1) SEAM(p + 5); \
        } \
     \
    } while (0)
    LAYER_BODY(0);
    LAYER_BODY(1);
#undef LAYER_BODY
    static_assert(DEPTH == 2, "two layer bodies are expanded by hand");
#undef IN
#undef SEAM
}


#ifndef MK_N_LAUNCHES
#define MK_N_LAUNCHES 1
#endif
extern "C" void kernel_launch(void* const* d_in, const int* in_sizes, int n_in, void* d_out, int out_size, void* d_ws, size_t ws_size, hipStream_t stream) {
    static int grid = 0;
    if (grid == 0) {
        if (n_in != 21 || in_sizes[0] != M * D || out_size != M * D || ws_size < WS_END) {
            fprintf(stderr, "kernel_launch: unexpected shapes n_in %d in0 %d out %d ws %zu\n", n_in, n_in > 0 ? in_sizes[0] : -1, out_size, ws_size); grid = -1; return; }
        int dev = 0, cus = 0;
        if (hipGetDevice(&dev) != hipSuccess || hipDeviceGetAttribute(&cus, hipDeviceAttributeMultiprocessorCount, dev) != hipSuccess) { grid = -1; return; }
        if (hipFuncSetAttribute((const void*)skel_fwd, hipFuncAttributeMaxDynamicSharedMemorySize, LDS_BYTES) != hipSuccess) { fprintf(stderr, "kernel_launch: hipFuncSetAttribute failed\n"); grid = -1; return; }
        grid = cus;
        if (grid != 256) { fprintf(stderr, "kernel_launch: built for 256 CUs, found %d\n", cus); grid = -1; return; }
    }
    if (grid < 0) return;
    (void)hipMemsetAsync((char*)d_ws + WS_CTL, 0, CTL_ZERO_BYTES, stream);
    Args a{};
    for (int i = 0; i < 21; ++i) a.in[i] = (const float*)d_in[i];
    a.out = (float*)d_out; a.ws = (unsigned char*)d_ws;
    int region = 0;
#define SKEL(lo, hi) do { a.ph_lo = (lo); a.ph_hi = (hi); a.bar_region = region++; hipLaunchKernelGGL(skel_fwd, dim3(grid), dim3(NWAVES * 64), LDS_BYTES, stream, a); } while (0)
#if defined(PROBE_REPEAT)
    SKEL(PH_PRO, PROBE_REPEAT + 1); SKEL(PROBE_REPEAT, PROBE_REPEAT + 1); SKEL(PROBE_REPEAT + 1, PH_N);
#elif MK_N_LAUNCHES == 1
    SKEL(PH_PRO, PH_N);
#else
    SKEL(PH_PRO, PH_PRO + 1);
    for (int l = 0; l < DEPTH; ++l) { const int p = PH_L0 + l * PH_PER_LAYER; SKEL(p, p + 1); SKEL(p + 1, p + 2); SKEL(p + 3, p + 4); SKEL(p + 4, p + 5); SKEL(p + 5, p + 6); }
    SKEL(PH_FINAL, PH_FINAL + 1);
#endif
#undef SKEL
}
```

```cpp
#include <hip/hip_runtime.h>
#include <cstdio>
#include <cstdint>
namespace pg8 {
#define PG8_LAS __attribute__((address_space(3)))
typedef unsigned short bf16_t;
typedef short bf16x8 __attribute__((ext_vector_type(8)));
typedef float f32x4 __attribute__((ext_vector_type(4)));
typedef unsigned u32x4 __attribute__((ext_vector_type(4)));
constexpr int BM = 256, BK = 64, HALF = 128, HTB = HALF * BK * 2  , STAGE_BYTES = 8 * HTB, NXCD = 8;
#ifndef PG8_WGM
#define PG8_WGM 4
#endif
constexpr int WGM = PG8_WGM;

__host__ __device__ __forceinline__ int lds_byte(int r, int c) { const int st = (r >> 4) * 2 + (c >> 5), rr = r & 15, cc = c & 31, ob = rr * 64 + cc * 2; return st * 1024 + (ob ^ (((ob >> 9) & 1) << 5)); }
__host__ __device__ __forceinline__ void stage_rc(int b, int& R, int& C) { const int st = b / 1024, sb = b % 1024, swz = sb ^ (((sb >> 9) & 1) << 5); R = (st >> 1) * 16 + swz / 64; C = (st & 1) * 32 + (swz % 64) / 2; }
__host__ __device__ __forceinline__ int perm32(int rho) { const int n = rho >> 4, i = rho & 15; return 8 * (i >> 2) + 4 * n + (i & 3); }

struct Unit { int pm, pn, slot; };
struct Gemm { const bf16_t* A; const bf16_t* Bt; int M, N, K; int adj; };

struct StaticOrder {
    int nM, nN, nwg, G, c; int rev16; unsigned pnperm;
    __host__ __device__ __forceinline__ void init(int M, int N, int G_, int c_) { nM = M / BM; nN = N / BM; nwg = nM * nN; G = G_; c = c_; pnperm = 0u; rev16 = 0; }
    __host__ __device__ __forceinline__ bool next(int i, Unit& u) const {
        const long L = (long)i * G + c; if (L >= nwg) return false;
        int wgid = (int)L; { const int q = nwg / NXCD, r = nwg % NXCD, xcd = wgid % NXCD, off = wgid / NXCD; wgid = (xcd < r ? xcd * (q + 1) : r * (q + 1) + (xcd - r) * q) + off; }
        const int nig = WGM * nN, gid = wgid / nig, fm = gid * WGM, gsz = (nM - fm) < WGM ? (nM - fm) : WGM;
        u.pm = fm + ((wgid % nig) % gsz); u.pn = (wgid % nig) / gsz; if (pnperm) u.pn = (int)((pnperm >> (3 * u.pn)) & 7u); if (rev16) u.pm = (u.pm & ~15) | (15 - (u.pm & 15)); u.slot = i; return true;
    }
    __device__ __forceinline__ void a_ready(const Unit&) const {}
    __device__ __forceinline__ void done(const Unit&) const {}
};

__device__ __forceinline__ unsigned cvt_pk_bf16(float lo, float hi) { typedef float f2_ __attribute__((ext_vector_type(2))); typedef __bf16 b2_ __attribute__((ext_vector_type(2))); f2_ v = {lo, hi}; b2_ b = __builtin_convertvector(v, b2_); return __builtin_bit_cast(unsigned, b); }

constexpr float EPI_RMS_EPS = 1e-6f;
__device__ __forceinline__ float rows4_sum(float v) {
    auto a = __builtin_amdgcn_permlane32_swap(__float_as_uint(v), __float_as_uint(v), false, false); v = __uint_as_float(a[0]) + __uint_as_float(a[1]);
    auto b = __builtin_amdgcn_permlane16_swap(__float_as_uint(v), __float_as_uint(v), false, false); return __uint_as_float(b[0]) + __uint_as_float(b[1]);
}
__device__ __forceinline__ float epi_sigmoid(float x) { return __builtin_amdgcn_rcpf(1.f + __builtin_amdgcn_exp2f(-1.4426950408889634f * x)); }
__device__ __forceinline__ float epi_gelu_tanh(float x) { const float u = 0.7978845608028654f * (x + 0.044715f * x * x * x); const float ex = __builtin_amdgcn_exp2f(2.f * 1.4426950408889634f * u); return 0.5f * x * (2.f - 2.f * __builtin_amdgcn_rcpf(ex + 1.f)); }
#ifndef HH_PLAIN
#define HH_STORE(w, p) __builtin_nontemporal_store(w, p)
#else
#define HH_STORE(w, p) (*(p) = (w))
#endif
__device__ __forceinline__ constexpr unsigned ssp_idx(int row, int part) { return (unsigned)(((row >> 4) * 16 + part) * 16 + (row & 15)); }
__device__ __forceinline__ unsigned ror8(unsigned v) { return (unsigned)__builtin_amdgcn_update_dpp((int)v, (int)v, 0x128, 0xf, 0xf, false); }
__device__ __forceinline__ u32x4 ror8(u32x4 v) { u32x4 r; r.x = ror8(v.x); r.y = ror8(v.y); r.z = ror8(v.z); r.w = ror8(v.w); return r; }
__device__ __forceinline__ u32x4 sel4(bool c, u32x4 a, u32x4 b) { u32x4 r; r.x = c ? a.x : b.x; r.y = c ? a.y : b.y; r.z = c ? a.z : b.z; r.w = c ? a.w : b.w; return r; }
struct EpiAny {
    static constexpr bool PERM = true, AFTER_DRAIN = false;
    int mode; bf16_t* O; int ldc; const float* ssp_r; float* ssp_w; int qcols; float qscale; const PG8_LAS float* rs_tab; float* fout; const float* fgain; unsigned* fcnt; bf16_t* ubuf; const bf16_t* R;

    __device__ __forceinline__ void final_rows(const f32x4 (&acc)[2][2][4][2], const Unit& u, int wr, int wc, int fr, int fq) const {
        typedef float f32x2 __attribute__((ext_vector_type(2)));
        const int row0 = u.pm * BM + wr * 64 + fr, col0 = u.pn * BM + wc * 64 + 8 * fq;
        const bool hi = (fr & 8) != 0;
        f32x4 h[2][2][4][2];
        { f32x4 pp[2][4]; int rowp_ = row0; asm volatile("" : "+v"(rowp_));
#pragma unroll
            for (int ai = 0; ai < 2; ++ai)
#pragma unroll
                for (int m = 0; m < 4; ++m) { _Pragma("unroll") for (int e = 0; e < 4; ++e) pp[ai][m][e] = ssp_r[ssp_idx(rowp_ + ai * HALF + m * 16, 4 * fq + e)]; }
#pragma unroll
            for (int ai = 0; ai < 2; ++ai)
#pragma unroll
                for (int m = 0; m < 4; ++m) { const f32x4 p = pp[ai][m]; float s = (p[0] + p[1]) + (p[2] + p[3]); s = rows4_sum(s); const float r2 = __builtin_amdgcn_rcpf(s * (1.0f / 1024.0f) + EPI_RMS_EPS);
#pragma unroll
                    for (int bj = 0; bj < 2; ++bj) { h[ai][bj][m][0] = acc[ai][bj][m][0] * r2; h[ai][bj][m][1] = acc[ai][bj][m][1] * r2; } }
            asm volatile("" ::: "memory"); }
        float sqv[2][4];
        { u32x4 rb[2][4][2]; int rowl_ = row0 - (hi ? 8 : 0), coll_ = col0 + (hi ? 32 : 0); asm volatile("" : "+v"(rowl_), "+v"(coll_));
#pragma unroll
            for (int ai = 0; ai < 2; ++ai)
#pragma unroll
                for (int m = 0; m < 4; ++m) {
                    rb[ai][m][0] = *(const u32x4*)(R + (size_t)(unsigned)((rowl_ + ai * HALF + m * 16) * ldc + coll_));
                    rb[ai][m][1] = *(const u32x4*)(R + (size_t)(unsigned)((rowl_ + ai * HALF + m * 16 + 8) * ldc + (coll_ ^ 32))); }
#pragma unroll
            for (int ai = 0; ai < 2; ++ai)
#pragma unroll
                for (int m = 0; m < 4; ++m) { f32x2 sq2 = {0.f, 0.f};
                    const u32x4 rx = sel4(hi, rb[ai][m][1], rb[ai][m][0]), ry = ror8(sel4(hi, rb[ai][m][0], rb[ai][m][1]));
#pragma unroll
                    for (int bj = 0; bj < 2; ++bj) { const u32x4 r = bj ? ry : rx; f32x4 a0 = h[ai][bj][m][0], a1 = h[ai][bj][m][1];
                        a0[0] += __builtin_bit_cast(float, r.x << 16); a0[1] += __builtin_bit_cast(float, r.x & 0xffff0000u); a0[2] += __builtin_bit_cast(float, r.y << 16); a0[3] += __builtin_bit_cast(float, r.y & 0xffff0000u);
                        a1[0] += __builtin_bit_cast(float, r.z << 16); a1[1] += __builtin_bit_cast(float, r.z & 0xffff0000u); a1[2] += __builtin_bit_cast(float, r.w << 16); a1[3] += __builtin_bit_cast(float, r.w & 0xffff0000u);
                        h[ai][bj][m][0] = a0; h[ai][bj][m][1] = a1;
                        sq2 += (f32x2){a0[0], a0[1]} * (f32x2){a0[0], a0[1]} + (f32x2){a0[2], a0[3]} * (f32x2){a0[2], a0[3]}; sq2 += (f32x2){a1[0], a1[1]} * (f32x2){a1[0], a1[1]} + (f32x2){a1[2], a1[3]} * (f32x2){a1[2], a1[3]}; }
                    sqv[ai][m] = rows4_sum(sq2[0] + sq2[1]); } }
        { int rows_ = row0; asm volatile("" : "+v"(rows_));
#pragma unroll
            for (int ai = 0; ai < 2; ++ai)
#pragma unroll
                for (int m = 0; m < 4; ++m)
                    if (fq == 0) __hip_atomic_store(ssp_w + ssp_idx(rows_ + ai * HALF + m * 16, u.pn * 4 + wc), sqv[ai][m], __ATOMIC_RELAXED, __HIP_MEMORY_SCOPE_AGENT); }
        asm volatile("s_waitcnt vmcnt(0)" ::: "memory");
        unsigned* cnt = fcnt + 64 * (2 * u.pm + wr);
        if ((threadIdx.x & 63) == 0) __hip_atomic_fetch_add(cnt, 1u, __ATOMIC_RELAXED, __HIP_MEMORY_SCOPE_AGENT);
        { unsigned sp_ = 0; while ((unsigned)__builtin_amdgcn_readfirstlane(__hip_atomic_load(cnt, __ATOMIC_RELAXED, __HIP_MEMORY_SCOPE_AGENT)) < 16u) { __builtin_amdgcn_s_sleep(1); if (++sp_ > (1u << 20)) break; } }
        float rsv[2][4];
        { float pt[2][4][4]; int rowq_ = row0; asm volatile("" : "+v"(rowq_));
#pragma unroll
            for (int ai = 0; ai < 2; ++ai)
#pragma unroll
                for (int m = 0; m < 4; ++m)
#pragma unroll
                    for (int e = 0; e < 4; ++e) pt[ai][m][e] = __hip_atomic_load(ssp_w + ssp_idx(rowq_ + ai * HALF + m * 16, 4 * fq + e), __ATOMIC_RELAXED, __HIP_MEMORY_SCOPE_AGENT);
#pragma unroll
            for (int ai = 0; ai < 2; ++ai)
#pragma unroll
                for (int m = 0; m < 4; ++m) { float s = (pt[ai][m][0] + pt[ai][m][1]) + (pt[ai][m][2] + pt[ai][m][3]); s = rows4_sum(s); rsv[ai][m] = __builtin_amdgcn_rsqf(s * (1.0f / 1024.0f) + EPI_RMS_EPS); } }
        f32x4 g[2][2];
#pragma unroll
        for (int bj = 0; bj < 2; ++bj) { g[bj][0] = *(const f32x4*)(fgain + col0 + bj * 32); g[bj][1] = *(const f32x4*)(fgain + col0 + bj * 32 + 4); }
        asm volatile("" ::: "memory");
        int rowo_ = row0; asm volatile("" : "+v"(rowo_));
#pragma unroll
        for (int ai = 0; ai < 2; ++ai)
#pragma unroll
            for (int m = 0; m < 4; ++m)
#pragma unroll
                for (int bj = 0; bj < 2; ++bj) {
                    const f32x4 P = h[ai][bj][m][0] * rsv[ai][m] * g[bj][0], Q = h[ai][bj][m][1] * rsv[ai][m] * g[bj][1];
                    u32x4 pu, qu; pu.x = __float_as_uint(P[0]); pu.y = __float_as_uint(P[1]); pu.z = __float_as_uint(P[2]); pu.w = __float_as_uint(P[3]);
                    qu.x = __float_as_uint(Q[0]); qu.y = __float_as_uint(Q[1]); qu.z = __float_as_uint(Q[2]); qu.w = __float_as_uint(Q[3]);
                    const u32x4 qr = ror8(qu);
                    float* op = fout + (size_t)(unsigned)((rowo_ + ai * HALF + m * 16 - (hi ? 8 : 0)) * ldc + col0 + bj * 32);
                    *(u32x4*)(op + (hi ? 4 : 0)) = sel4(hi, qr, pu);
                    *(u32x4*)(op + 8 * ldc + (hi ? 0 : 4)) = sel4(hi, pu, qr); }
    }
    __device__ __forceinline__ void operator()(const f32x4 (&acc)[2][2][4][2], const Unit& u, int wr, int wc, int fr_, int fq_) const {
        int fr = fr_, fq = fq_; asm volatile("" : "+v"(fr), "+v"(fq));
        const int row0 = u.pm * BM + wr * 64 + fr, col0 = u.pn * BM + wc * 32 + 8 * fq;
        if (mode > 4) return;
        if (mode == 4) { final_rows(acc, u, wr, wc, fr, fq); return; }
        if (mode == 1) {
            typedef float f32x2 __attribute__((ext_vector_type(2)));
            const bool hi1 = (fr & 8) != 0; const int rowa_ = row0 - (hi1 ? 8 : 0), cola_ = u.pn * BM + wc * 64 + 8 * fq + (hi1 ? 32 : 0);
#pragma unroll
            for (int ai = 0; ai < 2; ++ai)
#pragma unroll
                for (int m = 0; m < 4; ++m) { u32x4 wx, wy;
#pragma unroll
                    for (int bj = 0; bj < 2; ++bj) { const f32x4 a0 = acc[ai][bj][m][0], a1 = acc[ai][bj][m][1];
                        f32x2 p0 = __builtin_elementwise_max((f32x2){a0[0], a0[1]}, (f32x2){0.f, 0.f}), p1 = __builtin_elementwise_max((f32x2){a0[2], a0[3]}, (f32x2){0.f, 0.f});
                        f32x2 p2 = __builtin_elementwise_max((f32x2){a1[0], a1[1]}, (f32x2){0.f, 0.f}), p3 = __builtin_elementwise_max((f32x2){a1[2], a1[3]}, (f32x2){0.f, 0.f});
                        p0 = p0 * p0; p1 = p1 * p1; p2 = p2 * p2; p3 = p3 * p3;
                        u32x4 w; w.x = cvt_pk_bf16(p0[0], p0[1]); w.y = cvt_pk_bf16(p1[0], p1[1]); w.z = cvt_pk_bf16(p2[0], p2[1]); w.w = cvt_pk_bf16(p3[0], p3[1]);
                        if (bj) wy = w; else wx = w; }
                    const u32x4 wyr = ror8(wy); bf16_t* pa = O + (size_t)(unsigned)((rowa_ + ai * HALF + m * 16) * ldc + cola_);
                    HH_STORE(sel4(hi1, wyr, wx), (u32x4*)pa);
                    HH_STORE(sel4(hi1, wx, wyr), (u32x4*)(O + (size_t)(unsigned)((rowa_ + ai * HALF + m * 16 + 8) * ldc + (cola_ ^ 32)))); }
            return;
        }
        if (mode < 2) {
            const float sc = (u.pn * BM < qcols) ? qscale : 1.f;
            const int kind = (u.pn == 3 || u.pn == 4) ? 1 : (u.pn == 6) ? 2 : 0;
            const bool hi0 = (fr & 8) != 0; const int cola0_ = u.pn * BM + wc * 64 + 8 * fq + (hi0 ? 32 : 0);
#pragma unroll
            for (int ai = 0; ai < 2; ++ai)
#pragma unroll
                for (int m = 0; m < 4; ++m) { const int row = row0 + ai * HALF + m * 16;
                    const float rs = rs_tab[u.slot * BM + wr * 64 + fr + ai * HALF + m * 16] * sc;
                    if (kind == 1) {
                        f32x4 v0 = acc[ai][0][m][0] * rs, v1 = acc[ai][0][m][1] * rs; const f32x4 g0 = acc[ai][1][m][0] * rs, g1 = acc[ai][1][m][1] * rs;
#pragma unroll
                        for (int e = 0; e < 4; ++e) { v0[e] *= epi_sigmoid(g0[e]); v1[e] *= epi_sigmoid(g1[e]); }
                        u32x4 w; w.x = cvt_pk_bf16(v0[0], v0[1]); w.y = cvt_pk_bf16(v0[2], v0[3]); w.z = cvt_pk_bf16(v1[0], v1[1]); w.w = cvt_pk_bf16(v1[2], v1[3]);
                        *(u32x4*)(ubuf + (size_t)row * 256 + (u.pn - 3) * HALF + wc * 32 + 8 * fq) = w;
                    } else {
                    u32x4 wx, wy;
#pragma unroll
                    for (int bj = 0; bj < 2; ++bj) { f32x4 v0 = acc[ai][bj][m][0] * rs, v1 = acc[ai][bj][m][1] * rs;
                        if (kind == 2) {
#pragma unroll
                            for (int e = 0; e < 4; ++e) { v0[e] = epi_gelu_tanh(v0[e]); v1[e] = epi_gelu_tanh(v1[e]); } }
                        u32x4 w; w.x = cvt_pk_bf16(v0[0], v0[1]); w.y = cvt_pk_bf16(v0[2], v0[3]); w.z = cvt_pk_bf16(v1[0], v1[1]); w.w = cvt_pk_bf16(v1[2], v1[3]);
                        if (bj) wy = w; else wx = w; }
                    const u32x4 wyr = ror8(wy);
                    *(u32x4*)(O + (size_t)(unsigned)((row - (hi0 ? 8 : 0)) * ldc + cola0_)) = sel4(hi0, wyr, wx);
                    *(u32x4*)(O + (size_t)(unsigned)((row - (hi0 ? 8 : 0) + 8) * ldc + (cola0_ ^ 32))) = sel4(hi0, wx, wyr); } }
        } else {
            typedef float f32x2 __attribute__((ext_vector_type(2)));
            f32x4 sa[2][2][4][2];
            if (mode == 3) {
                f32x4 pp[2][4]; int rowp_ = row0; asm volatile("" : "+v"(rowp_));
#pragma unroll
                for (int ai = 0; ai < 2; ++ai)
#pragma unroll
                    for (int m = 0; m < 4; ++m) { _Pragma("unroll") for (int e = 0; e < 4; ++e) pp[ai][m][e] = ssp_r[ssp_idx(rowp_ + ai * HALF + m * 16, 4 * fq + e)]; }
#pragma unroll
                for (int ai = 0; ai < 2; ++ai)
#pragma unroll
                    for (int m = 0; m < 4; ++m) { const f32x4 p = pp[ai][m]; float s = (p[0] + p[1]) + (p[2] + p[3]); s = rows4_sum(s); const float r2 = __builtin_amdgcn_rcpf(s * (1.0f / 1024.0f) + EPI_RMS_EPS);
#pragma unroll
                        for (int bj = 0; bj < 2; ++bj) { sa[ai][bj][m][0] = acc[ai][bj][m][0] * r2; sa[ai][bj][m][1] = acc[ai][bj][m][1] * r2; } }
                asm volatile("" ::: "memory");
            } else {
#pragma unroll
                for (int ai = 0; ai < 2; ++ai)
#pragma unroll
                    for (int m = 0; m < 4; ++m)
#pragma unroll
                        for (int bj = 0; bj < 2; ++bj) { sa[ai][bj][m][0] = acc[ai][bj][m][0]; sa[ai][bj][m][1] = acc[ai][bj][m][1]; }
            }
            const bool hi = (fr & 8) != 0;
            int rowl_ = row0 - (hi ? 8 : 0), coll_ = u.pn * BM + wc * 64 + 8 * fq + (hi ? 32 : 0); asm volatile("" : "+v"(rowl_), "+v"(coll_));
            u32x4 rb[2][4][2];
#pragma unroll
            for (int ai = 0; ai < 2; ++ai)
#pragma unroll
                for (int m = 0; m < 4; ++m) {
                    rb[ai][m][0] = *(const u32x4*)(R + (size_t)(unsigned)((rowl_ + ai * HALF + m * 16) * ldc + coll_));
                    rb[ai][m][1] = *(const u32x4*)(R + (size_t)(unsigned)((rowl_ + ai * HALF + m * 16 + 8) * ldc + (coll_ ^ 32))); }
#pragma unroll
            for (int ai = 0; ai < 2; ++ai)
#pragma unroll
                for (int m = 0; m < 4; ++m) { int row = row0 + ai * HALF + m * 16; asm volatile("" : "+v"(row));
                    f32x2 sq2 = {0.f, 0.f};
                    const u32x4 rx = sel4(hi, rb[ai][m][1], rb[ai][m][0]), ry = ror8(sel4(hi, rb[ai][m][0], rb[ai][m][1]));
                    u32x4 wx, wy;
#pragma unroll
                    for (int bj = 0; bj < 2; ++bj) {
                        const u32x4 r = bj ? ry : rx; const f32x4 a0 = sa[ai][bj][m][0], a1 = sa[ai][bj][m][1];
                        const f32x2 v0 = (f32x2){a0[0], a0[1]} + (f32x2){__builtin_bit_cast(float, r.x << 16), __builtin_bit_cast(float, r.x & 0xffff0000u)};
                        const f32x2 v1 = (f32x2){a0[2], a0[3]} + (f32x2){__builtin_bit_cast(float, r.y << 16), __builtin_bit_cast(float, r.y & 0xffff0000u)};
                        const f32x2 v2 = (f32x2){a1[0], a1[1]} + (f32x2){__builtin_bit_cast(float, r.z << 16), __builtin_bit_cast(float, r.z & 0xffff0000u)};
                        const f32x2 v3 = (f32x2){a1[2], a1[3]} + (f32x2){__builtin_bit_cast(float, r.w << 16), __builtin_bit_cast(float, r.w & 0xffff0000u)};
                        sq2 += v0 * v0 + v1 * v1; sq2 += v2 * v2 + v3 * v3;
                        u32x4 w; w.x = cvt_pk_bf16(v0[0], v0[1]); w.y = cvt_pk_bf16(v1[0], v1[1]); w.z = cvt_pk_bf16(v2[0], v2[1]); w.w = cvt_pk_bf16(v3[0], v3[1]);
                        if (bj) wy = w; else wx = w; }
                    const u32x4 wyr = ror8(wy);
                    const unsigned offa = (unsigned)((row - (hi ? 8 : 0)) * ldc + coll_);
                    *(u32x4*)(O + (size_t)offa) = sel4(hi, wyr, wx);
                    *(u32x4*)(O + (size_t)(unsigned)((row - (hi ? 8 : 0) + 8) * ldc + (coll_ ^ 32))) = sel4(hi, wx, wyr);
                    float sq = sq2[0] + sq2[1];
                    sq = rows4_sum(sq);
                    if (fq == 0) ssp_w[ssp_idx(row, u.pn * 4 + wc)] = sq; }
        }
    }
};
template <class Epi, class Sched, bool ALIGN_EPI = false, bool SP2 = false>
__device__ __forceinline__ void gemm_phase(PG8_LAS unsigned char* lds, const Gemm g, const Sched& S, const Epi& E) {
    int tid_ = threadIdx.x; asm volatile("" : "+v"(tid_));
    const int tid = tid_, wid = __builtin_amdgcn_readfirstlane(tid >> 6), lane = tid & 63, wr = wid >> 2, wc = wid & 3, fr = lane & 15, fq = lane >> 4;
    const int K = g.K, nt = K / BK;
    unsigned voffA[2], voffB[2];
#pragma unroll
    for (int i = 0; i < 2; ++i) { int R, C; stage_rc(tid * 16 + i * 8192, R, C); const int Rb = Epi::PERM ? ((g.adj ? (R >> 5) * 64 : (R & ~31)) + perm32(R & 31)) : R;
        voffA[i] = (unsigned)(R * K + C) * 2u; voffB[i] = (unsigned)(Rb * K + C) * 2u; }
    const size_t kstep = (size_t)(BK * 2);
    const size_t hstep = (size_t)HALF * K * 2;
    const size_t tstep = 2 * hstep;
    const size_t hstepB = g.adj ? (size_t)32 * K * 2 : hstep;
    const unsigned ldsw = (unsigned)wid * 1024u;
    const int aoff = lds_byte(wr * 64 + fr, fq * 8), boff = lds_byte(wc * 32 + fr, fq * 8);
#define PG8_SA(b, h) (((b) * 2 + (h)) * HTB)
#define PG8_SB(b, h) ((4 + (b) * 2 + (h)) * HTB)
#define PG8_STAGE(bufoff, gbase, voff) do { _Pragma("unroll") for (int _i = 0; _i < 2; ++_i) \
        __builtin_amdgcn_global_load_lds((const unsigned*)((const char*)(gbase) + (voff)[_i]), (PG8_LAS unsigned*)(lds + (bufoff) + ldsw + _i * 8192), 16, 0, 0); } while (0)
#define PG8_LDA(dst, b, h) do { _Pragma("unroll") for (int m = 0; m < 4; ++m) _Pragma("unroll") for (int k = 0; k < 2; ++k) dst[m][k] = *(const PG8_LAS bf16x8*)(lds + PG8_SA(b, h) + aoff + m * 2048 + k * 1024); } while (0)
#define PG8_LDB(dst, b, h) do { _Pragma("unroll") for (int n = 0; n < 2; ++n) _Pragma("unroll") for (int k = 0; k < 2; ++k) dst[n][k] = *(const PG8_LAS bf16x8*)(lds + PG8_SB(b, h) + boff + n * 2048 + k * 1024); } while (0)
#define PG8_MMA(ai, bj, At, Bt) do { __builtin_amdgcn_s_setprio(1); _Pragma("unroll") for (int m = 0; m < 4; ++m) _Pragma("unroll") for (int n = 0; n < 2; ++n) _Pragma("unroll") for (int k = 0; k < 2; ++k) \
        acc[ai][bj][m][n] = __builtin_amdgcn_mfma_f32_16x16x32_bf16(Bt[n][k], At[m][k], acc[ai][bj][m][n], 0, 0, 0); __builtin_amdgcn_s_setprio(0); } while (0)
#define PG8_WAIT_V(n) asm volatile("s_waitcnt vmcnt(" #n ")" ::: "memory")
#define PG8_WAIT_L(n) asm volatile("s_waitcnt lgkmcnt(" #n ")" ::: "memory")
#define PG8_BAR __builtin_amdgcn_s_barrier()
#define PG8_SCHED __builtin_amdgcn_sched_barrier(0)
    Unit cur, nxt; int ui = 0;
    if (!S.next(0, cur)) return;
    f32x4 acc[2][2][4][2];
#pragma unroll
    for (int a = 0; a < 2; ++a)
#pragma unroll
        for (int b = 0; b < 2; ++b)
#pragma unroll
            for (int m = 0; m < 4; ++m)
#pragma unroll
                for (int n = 0; n < 2; ++n) acc[a][b][m][n] = (f32x4){0.f, 0.f, 0.f, 0.f};
    bf16x8 At[4][2], B0[2][2], B1[2][2];
    const char* cA = (const char*)g.A + (size_t)cur.pm * tstep; const char* cB = (const char*)g.Bt + (size_t)cur.pn * tstep;
    S.a_ready(cur);
    if constexpr (SP2) {
        PG8_STAGE(PG8_SB(0, 0), cB, voffB); PG8_STAGE(PG8_SB(0, 1), cB + hstepB, voffB); PG8_STAGE(PG8_SA(0, 0), cA, voffA); PG8_STAGE(PG8_SA(0, 1), cA + hstep, voffA);
        if (wr == 1) PG8_BAR;
        PG8_WAIT_V(2); PG8_BAR;
        PG8_STAGE(PG8_SB(1, 0), cB + kstep, voffB); PG8_STAGE(PG8_SA(1, 0), cA + kstep, voffA); PG8_STAGE(PG8_SB(1, 1), cB + hstepB + kstep, voffB);
        PG8_WAIT_V(6); PG8_BAR;
    } else {
        PG8_STAGE(PG8_SB(0, 0), cB, voffB); PG8_STAGE(PG8_SA(0, 0), cA, voffA); PG8_STAGE(PG8_SB(0, 1), cB + hstepB, voffB); PG8_STAGE(PG8_SA(0, 1), cA + hstep, voffA);
        if (wr == 1) PG8_BAR;
        PG8_WAIT_V(4); PG8_BAR;
        PG8_STAGE(PG8_SB(1, 0), cB + kstep, voffB); PG8_STAGE(PG8_SA(1, 0), cA + kstep, voffA); PG8_STAGE(PG8_SB(1, 1), cB + hstepB + kstep, voffB);
        PG8_WAIT_V(6); PG8_BAR;
    }
    for (;;) {
        const bool has_next = S.next(ui + 1, nxt);
        const char* nA = has_next ? (const char*)g.A + (size_t)nxt.pm * tstep : cA; const char* nB = has_next ? (const char*)g.Bt + (size_t)nxt.pn * tstep : cB;
        for (int t = 0; t < nt; t += 2) {
            const bool last = (t == nt - 2);
            const char* a1 = cA + (size_t)(t + 1) * kstep;
            const char* a2 = last ? nA : cA + (size_t)(t + 2) * kstep; const char* b2 = last ? nB : cB + (size_t)(t + 2) * kstep;
            const char* a3 = a2 + kstep; const char* b3 = b2 + kstep;
            if (last && has_next) S.a_ready(nxt);
            if constexpr (SP2) {
            PG8_LDB(B0, 0, 0); PG8_LDB(B1, 0, 1); PG8_SCHED; PG8_LDA(At, 0, 0); PG8_STAGE(PG8_SA(1, 1), a1 + hstep, voffA);
            PG8_WAIT_V(8); PG8_WAIT_L(0); PG8_BAR; PG8_MMA(0, 0, At, B0); PG8_MMA(0, 1, At, B1); PG8_BAR; PG8_SCHED;
            PG8_LDA(At, 0, 1); PG8_STAGE(PG8_SB(0, 0), b2, voffB); PG8_STAGE(PG8_SB(0, 1), b2 + hstepB, voffB); PG8_STAGE(PG8_SA(0, 0), a2, voffA);
            PG8_WAIT_V(8); PG8_WAIT_L(0); PG8_BAR; PG8_MMA(1, 0, At, B0); PG8_MMA(1, 1, At, B1); PG8_BAR; PG8_SCHED;
            PG8_LDB(B0, 1, 0); PG8_LDB(B1, 1, 1); PG8_SCHED; PG8_LDA(At, 1, 0); PG8_STAGE(PG8_SA(0, 1), a2 + hstep, voffA);
            PG8_WAIT_V(8); PG8_WAIT_L(0); PG8_BAR; PG8_MMA(0, 0, At, B0); PG8_MMA(0, 1, At, B1); PG8_BAR; PG8_SCHED;
            PG8_LDA(At, 1, 1); PG8_STAGE(PG8_SB(1, 0), b3, voffB); PG8_STAGE(PG8_SB(1, 1), b3 + hstepB, voffB); PG8_STAGE(PG8_SA(1, 0), a3, voffA);
            PG8_WAIT_V(8); PG8_WAIT_L(0); PG8_BAR; PG8_MMA(1, 0, At, B0); PG8_MMA(1, 1, At, B1); PG8_BAR; PG8_SCHED;
            } else {
            PG8_LDB(B0, 0, 0); PG8_SCHED; PG8_LDA(At, 0, 0); PG8_STAGE(PG8_SA(1, 1), a1 + hstep, voffA);
            PG8_WAIT_L(8); PG8_BAR; PG8_WAIT_L(0); PG8_MMA(0, 0, At, B0); PG8_BAR; PG8_SCHED;
            PG8_LDB(B1, 0, 1); PG8_STAGE(PG8_SB(0, 0), b2, voffB);
            PG8_BAR; PG8_WAIT_L(0); PG8_MMA(0, 1, At, B1); PG8_BAR;
            PG8_LDA(At, 0, 1); PG8_STAGE(PG8_SA(0, 0), a2, voffA);
            PG8_BAR; PG8_WAIT_L(0); PG8_MMA(1, 0, At, B0); PG8_BAR; PG8_SCHED;
            PG8_STAGE(PG8_SB(0, 1), b2 + hstepB, voffB);
            PG8_WAIT_V(6); PG8_BAR; PG8_MMA(1, 1, At, B1); PG8_BAR;
            PG8_LDB(B0, 1, 0); PG8_SCHED; PG8_LDA(At, 1, 0); PG8_STAGE(PG8_SA(0, 1), a2 + hstep, voffA);
            PG8_WAIT_L(8); PG8_BAR; PG8_WAIT_L(0); PG8_MMA(0, 0, At, B0); PG8_BAR; PG8_SCHED;
            PG8_LDB(B1, 1, 1); PG8_STAGE(PG8_SB(1, 0), b3, voffB);
            PG8_BAR; PG8_WAIT_L(0); PG8_MMA(0, 1, At, B1); PG8_BAR;
            PG8_LDA(At, 1, 1); PG8_STAGE(PG8_SA(1, 0), a3, voffA);
            PG8_BAR; PG8_WAIT_L(0); PG8_MMA(1, 0, At, B0); PG8_BAR; PG8_SCHED;
            PG8_STAGE(PG8_SB(1, 1), b3 + hstepB, voffB);
            PG8_WAIT_V(6); PG8_BAR; PG8_MMA(1, 1, At, B1); PG8_BAR;
            }
        }
        if constexpr (ALIGN_EPI) { if (wr == 0) PG8_BAR; }
        if constexpr (!Epi::AFTER_DRAIN) { E(acc, cur, wr, wc, fr, fq); S.done(cur); }
        if (!has_next) break;
#pragma unroll
        for (int a = 0; a < 2; ++a)
#pragma unroll
            for (int b = 0; b < 2; ++b)
#pragma unroll
                for (int m = 0; m < 4; ++m)
#pragma unroll
                    for (int n = 0; n < 2; ++n) acc[a][b][m][n] = (f32x4){0.f, 0.f, 0.f, 0.f};
        cur = nxt; cA = nA; cB = nB; ++ui;
        if constexpr (ALIGN_EPI) { if (wr == 1) PG8_BAR; }
    }
    PG8_WAIT_V(0);
    if constexpr (!ALIGN_EPI) { if (wr == 0) PG8_BAR; }
    PG8_BAR;
    if constexpr (Epi::AFTER_DRAIN) { E.fused(acc, cur, wr, wc, fr, fq, lds, wid, lane); S.done(cur); }
#undef PG8_SA
#undef PG8_SB
#undef PG8_STAGE
#undef PG8_LDA
#undef PG8_LDB
#undef PG8_MMA
#undef PG8_WAIT_V
#undef PG8_WAIT_L
#undef PG8_BAR
#undef PG8_SCHED
}
}

#ifndef PG8_SP2
#define PG8_SP2 true
#endif
#ifndef PG8_ALIGN
#define PG8_ALIGN true
#endif
constexpr int NWAVES = 8;
constexpr int D = 1024, BATCH = 4, SEQ = 8192, DEPTH = 2;
constexpr int M = BATCH * SEQ;
constexpr int NIN = 1792, FF = 4096;
constexpr int ZQ = 0, ZK = 512, ZV = 640, ZCV = 768, ZCG = 1024, ZRX = 1280, ZRG = 1536;
constexpr float RMS_EPS = 1e-6f, LN_EPS = 1e-5f;
constexpr size_t MiB = 1u << 20;
constexpr size_t WS_CTL = 0, CTL_ZERO_BYTES = 160 * 1024;
constexpr size_t WS_WFRAG = 1 * MiB; constexpr int WFRAG_LAYER = 64 * 512;
constexpr size_t WS_W = 2 * MiB, W_LAYER = 22 * MiB, W_IN = 0, W_OUT = 4 * MiB, W_UP = 6 * MiB, W_DOWN = 14 * MiB;
constexpr size_t WS_SSP = 46 * MiB;
constexpr size_t WS_HB = 48 * MiB;
constexpr size_t WS_Z = 112 * MiB;
constexpr size_t WS_YMIX = 224 * MiB;
constexpr size_t WS_HH = 112 * MiB;


constexpr size_t WS_SSP2 = 368 * MiB;
constexpr size_t WS_UBUF = 370 * MiB;
constexpr size_t WS_H1 = 386 * MiB;
constexpr size_t WS_END = 450 * MiB;
constexpr int CW_FIN = 18432;
constexpr int CW_BAR = 4096;
constexpr int RING_OFF = 0, RING_BYTES = 131072;
constexpr int LDSCTL_OFF = RING_BYTES, MISC_OFF = LDSCTL_OFF + 320;
static_assert((CW_FIN + 256 * 64) * 4 <= (int)CTL_ZERO_BYTES && (CW_BAR + 4 * 3456) <= CW_FIN, "control words inside the memset region");
constexpr int LDS_BYTES = 163840;
#define GAS __attribute__((address_space(1)))
#define LAS __attribute__((address_space(3)))
typedef unsigned short bf16;
typedef unsigned v4u __attribute__((ext_vector_type(4)));
typedef float f32x4 __attribute__((ext_vector_type(4)));
typedef short bf16x8 __attribute__((ext_vector_type(8)));
typedef GAS unsigned gu32;
typedef GAS unsigned long long gu64;
#define RLX_AGENT __ATOMIC_RELAXED, __HIP_MEMORY_SCOPE_AGENT
#define LDS_WAIT() asm volatile("s_waitcnt lgkmcnt(0)" ::: "memory")
#define VM_WAIT() asm volatile("s_waitcnt vmcnt(0)" ::: "memory")
__device__ __forceinline__ unsigned long long rt() { return __builtin_amdgcn_s_memrealtime(); }
__device__ __forceinline__ unsigned f2bf(float f) { unsigned u = __builtin_bit_cast(unsigned, f); return (u + 0x7fffu + ((u >> 16) & 1u)) >> 16; }
__device__ __forceinline__ unsigned pk2(float lo, float hi) { return f2bf(lo) | (f2bf(hi) << 16); }
#define XB_TMO      128
#define XB_XCNT(j)  (256  + 64 * (j))
#define XB_XSUB(j)  (1280 + 64 * (j))
#define XB_XGEN(j)  (2304 + 64 * (j))
#define XB_TOP      3328
#define XB_TOPGEN   3392
#define XCD_BAR_WORDS 3456
#define XB_SPIN_CAP (1u << 18)

__device__ __forceinline__ unsigned xb_ld(unsigned* p)              { return __hip_atomic_load(p, __ATOMIC_RELAXED, __HIP_MEMORY_SCOPE_AGENT); }
__device__ __forceinline__ unsigned xb_add(unsigned* p, unsigned v) { return __hip_atomic_fetch_add(p, v, __ATOMIC_RELAXED, __HIP_MEMORY_SCOPE_AGENT); }
__device__ __forceinline__ unsigned xb_xcc_id() { return (unsigned)__builtin_amdgcn_s_getreg((3 << 11) | 20) & 0xFu; }
#define XB_SPIN(cond, bar) do { unsigned _sp = 0; while (cond) { __builtin_amdgcn_s_sleep(1); \
    if ((++_sp & 255u) == 0u) { if (xb_ld(&(bar)[XB_TMO])) break; if (_sp > XB_SPIN_CAP) { atomicAdd(&(bar)[XB_TMO], 1u); break; } } } } while (0)

struct XcdBarrier {
    unsigned* bar; unsigned x;
    volatile LAS unsigned* st;
};

__device__ __forceinline__ XcdBarrier xcd_barrier_post(unsigned* bar, volatile LAS unsigned* st) {
    XcdBarrier b; b.bar = bar; b.x = xb_xcc_id(); b.st = st;
    if (threadIdx.x == 0) (void)xb_add(&bar[XB_XCNT(b.x)], 1u);
    return b;
}
__device__ __forceinline__ void xcd_barrier_complete(unsigned* bar, unsigned x, unsigned& nloc, unsigned& nx) {
    const unsigned G = gridDim.x * gridDim.y * gridDim.z;
    unsigned sum, cnt, mine, sp = 0u;
    for (;;) {
        sum = 0u; cnt = 0u; mine = 0u;
#pragma unroll
        for (unsigned j = 0; j < 16; ++j) { const unsigned c = xb_ld(&bar[XB_XCNT(j)]); sum += c; cnt += (c > 0u) ? 1u : 0u; mine = (j == x) ? c : mine; }
        if (sum == G) break;
        __builtin_amdgcn_s_sleep(1);
        if ((++sp & 255u) == 0u) { if (xb_ld(&bar[XB_TMO])) break; if (sp > XB_SPIN_CAP) { atomicAdd(&bar[XB_TMO], 1u); break; } }
    }
    nloc = mine > 0u ? mine : 1u; nx = cnt > 0u ? cnt : 1u;
}

__device__ __forceinline__ void xcd_barrier(const XcdBarrier& b) {
    asm volatile("s_waitcnt vmcnt(0)" ::: "memory");
    __syncthreads();
    if (threadIdx.x == 0) {
        unsigned* bar = b.bar;
        __builtin_amdgcn_s_waitcnt(0);
        unsigned nloc = b.st[0], nx = b.st[1]; const unsigned kbar = b.st[2]; b.st[2] = kbar + 1u;
        if (nloc == 0u) { xcd_barrier_complete(bar, b.x, nloc, nx); b.st[0] = nloc; b.st[1] = nx; }
        const unsigned old = xb_add(&bar[XB_XSUB(b.x)], 1u);
        const unsigned gen = old / nloc;
        if (old + 1u == (gen + 1u) * nloc) {
            __builtin_amdgcn_fence(__ATOMIC_RELEASE, "agent");
            asm volatile("s_waitcnt vmcnt(0)" ::: "memory");
            __hip_atomic_fetch_add(&bar[XB_TOP], 1u, __ATOMIC_RELAXED, __HIP_MEMORY_SCOPE_AGENT);
            __builtin_amdgcn_fence(__ATOMIC_ACQUIRE, "agent");
            XB_SPIN(xb_ld(&bar[XB_TOP]) < (kbar + 1u) * nx, bar);
            asm volatile("s_waitcnt vmcnt(0)" ::: "memory");
        } else {
            __builtin_amdgcn_fence(__ATOMIC_ACQUIRE, "agent");
            XB_SPIN(xb_ld(&bar[XB_TOP]) < (kbar + 1u) * nx, bar);
            asm volatile("s_waitcnt vmcnt(0)" ::: "memory");
        }
    }
    __syncthreads();
}

template <int CTRL> __device__ __forceinline__ float dppmov(float v) { return __builtin_bit_cast(float, __builtin_amdgcn_update_dpp(0, __builtin_bit_cast(int, v), CTRL, 0xf, 0xf, true)); }
__device__ __forceinline__ float wave_sum(float v) {
    v += dppmov<0xB1>(v); v += dppmov<0x4E>(v); v += dppmov<0x141>(v); v += dppmov<0x140>(v);
    return (__builtin_bit_cast(float, __builtin_amdgcn_readlane(__builtin_bit_cast(int, v), 0)) + __builtin_bit_cast(float, __builtin_amdgcn_readlane(__builtin_bit_cast(int, v), 16)))
         + (__builtin_bit_cast(float, __builtin_amdgcn_readlane(__builtin_bit_cast(int, v), 32)) + __builtin_bit_cast(float, __builtin_amdgcn_readlane(__builtin_bit_cast(int, v), 48)));
}
__device__ __forceinline__ float bf2f(unsigned short b) { return __builtin_bit_cast(float, (unsigned)b << 16); }
__device__ __forceinline__ float sigmoidf_(float x) { return __builtin_amdgcn_rcpf(1.f + __builtin_amdgcn_exp2f(-1.4426950408889634f * x)); }

namespace mix {
typedef short bf16x8 __attribute__((ext_vector_type(8)));
typedef short s16x4 __attribute__((ext_vector_type(4)));
typedef float f32x16 __attribute__((ext_vector_type(16)));
typedef float f32x2 __attribute__((ext_vector_type(2)));
typedef unsigned u32x2 __attribute__((ext_vector_type(2)));
constexpr float LOG2E = 1.4426950408889634f;
constexpr float QSCALE = 0.125f * LOG2E;
constexpr int ATT_K = 0, ATT_V = 65536;
constexpr int XCH_OFF = RING_BYTES + 1024;
constexpr size_t WS_AGG = 288 * MiB;
constexpr int NUNIT = BATCH * 64;
constexpr int SUB0_OFF = XCH_OFF + 2048;
constexpr int CWT_OFF = XCH_OFF + 4096;
constexpr int SEG_OFF = XCH_OFF + 12288;
static_assert(SEG_OFF + 16384 <= LDS_BYTES, "LDS exchange tables");

__device__ __forceinline__ int crow(int r, int hi) { return (r & 3) + 8 * (r >> 2) + 4 * hi; }
__device__ __forceinline__ float xhalf_max(float v) { auto rr = __builtin_amdgcn_permlane32_swap(__float_as_uint(v), __float_as_uint(v), false, false); return fmaxf(__uint_as_float(rr[0]), __uint_as_float(rr[1])); }
__device__ __forceinline__ float xhalf_sum(float v) { auto rr = __builtin_amdgcn_permlane32_swap(__float_as_uint(v), __float_as_uint(v), false, false); return __uint_as_float(rr[0]) + __uint_as_float(rr[1]); }
__device__ __forceinline__ float xhalf_other(float v) { auto rr = __builtin_amdgcn_permlane32_swap(__float_as_uint(v), __float_as_uint(v), false, false); return (threadIdx.x & 32) ? __uint_as_float(rr[0]) : __uint_as_float(rr[1]); }
__device__ __forceinline__ s16x4 vtr(const LAS unsigned char* p) { typedef short v4i16_t __attribute__((ext_vector_type(4))); return __builtin_bit_cast(s16x4, __builtin_amdgcn_ds_read_tr16_b64_v4i16((LAS v4i16_t*)p)); }
__device__ __forceinline__ unsigned cvtpk(float lo, float hi) { typedef __bf16 bf16x2_t __attribute__((ext_vector_type(2))); f32x2 v = {lo, hi}; bf16x2_t b = __builtin_convertvector(v, bf16x2_t); return __builtin_bit_cast(unsigned, b); }
__device__ __forceinline__ void fmac_s(float& acc, float a, float b) { asm("v_fmac_f32_e32 %0, %1, %2" : "+v"(acc) : "v"(a), "v"(b)); }
__device__ __forceinline__ float bflo(unsigned w) { return __builtin_bit_cast(float, w << 16); }
__device__ __forceinline__ float bfhi(unsigned w) { return __builtin_bit_cast(float, w & 0xffff0000u); }

__device__ __forceinline__ void attn_unit(LAS unsigned char* lds, const bf16* z, bf16* ymix, const float* sinks, int b, int n, int tid) {
    asm volatile("" : "+v"(tid));
    const int lane = tid & 63, wid = __builtin_amdgcn_readfirstlane(tid >> 6), r32 = lane & 31, hi = lane >> 5;
    const size_t row0 = (size_t)b * SEQ + (size_t)n * 128;
    const int hq = wid, hkv = wid >> 2;
    bf16x8 qr[4];
#pragma unroll
    for (int d0 = 0; d0 < 4; ++d0) qr[d0] = *(const GAS bf16x8*)(z + (row0 + r32) * NIN + ZQ + hq * 64 + 16 * d0 + 8 * hi);
#ifndef AREP_STAGE
#define AREP_STAGE 1
#define AREP_LOOP 1
#endif
    for (int arep_ = 0; arep_ < AREP_STAGE; ++arep_) {
    if (arep_) __syncthreads();
#pragma unroll
    for (int half = 0; half < 2; ++half) {
        v4u v[8];
        const bool have = (half == 1) || (n > 0);
#pragma unroll
        for (int i = 0; i < 8; ++i) { const int pi = (half * 8 + i) * 512 + tid, token = pi >> 5, c32 = pi & 31;
            if (have) v[i] = *(const GAS v4u*)(z + (row0 + token - 128) * NIN + ZK + 8 * c32); else v[i] = (v4u){0u, 0u, 0u, 0u}; }
#pragma unroll
        for (int i = 0; i < 8; ++i) { const int pi = (half * 8 + i) * 512 + tid, token = pi >> 5, c32 = pi & 31, kind = c32 >> 3, c = c32 & 7;
            const int dst = (kind < 2) ? (ATT_K + (kind & 1) * 32768 + token * 128 + ((c ^ ((token >> 1) & 7)) << 4))
                                       : (ATT_V + (kind & 1) * 32768 + (c >> 2) * 16384 + token * 64 + (c & 3) * 16);
            *(LAS v4u*)(lds + dst) = v[i]; }
    }
    }
    __syncthreads();
    const float sink2 = sinks[hq] * LOG2E;
    const LAS unsigned char* Kb = lds + ATT_K + hkv * 32768;
    const LAS unsigned char* Vb = lds + ATT_V + hkv * 32768 + ((lane >> 4) & 1) * 32 + (lane & 3) * 8 + (4 * hi + ((lane & 15) >> 2)) * 64;
    int koff[4];
#pragma unroll
    for (int d0 = 0; d0 < 4; ++d0) koff[d0] = r32 * 128 + (((2 * d0 + hi) ^ ((r32 >> 1) & 7)) << 4);
    LAS float* part = (LAS float*)(lds + XCH_OFF);
    const float NEG = -INFINITY;
    f32x16 mask0, mask4;
#pragma unroll
    for (int r = 0; r < 16; ++r) { const int cr = crow(r, hi); mask0[r] = (cr > r32) ? 0.f : NEG; mask4[r] = (cr <= r32) ? 0.f : NEG; }
    bf16x8 ones;
#pragma unroll
    for (int e = 0; e < 8; ++e) ones[e] = (short)0x3F80;
#pragma unroll 1
    for (int i4_ = 0; i4_ < 4 * AREP_LOOP; ++i4_) { const int i = i4_ & 3;
        const size_t qrow = row0 + 32 * i + r32;
        bf16x8 qn[4];
        { const size_t qnrow = row0 + 32 * ((i4_ + 1) & 3) + r32;
#pragma unroll
          for (int d0 = 0; d0 < 4; ++d0) qn[d0] = *(const GAS bf16x8*)(z + qnrow * NIN + ZQ + hq * 64 + 16 * d0 + 8 * hi); }
        const LAS unsigned char* kbi = Kb + 4096 * i;
        const LAS unsigned char* vbi = Vb + 2048 * i;
        f32x16 s[5];
#pragma unroll
        for (int kt = 0; kt < 5; ++kt) { s[kt] = kt == 0 ? mask0 : kt == 4 ? mask4 : (f32x16){};
#pragma unroll
            for (int d0 = 0; d0 < 4; ++d0) { const bf16x8 kf = *(const LAS bf16x8*)(kbi + 4096 * kt + koff[d0]); s[kt] = __builtin_amdgcn_mfma_f32_32x32x16_bf16(kf, qr[d0], s[kt], 0, 0, 0); } }
        if (n == 0) {
#pragma unroll
            for (int kt = 0; kt < 4; ++kt) if (i + kt < 4) {
#pragma unroll
                for (int r = 0; r < 16; ++r) s[kt][r] = NEG; } }
        float m = sink2;
#pragma unroll
        for (int kt = 0; kt < 5; ++kt)
#pragma unroll
            for (int r = 0; r < 16; r += 2) m = fmaxf(fmaxf(m, s[kt][r]), s[kt][r + 1]);
        m = xhalf_max(m);
#pragma unroll
        for (int kt = 0; kt < 5; ++kt)
#pragma unroll
            for (int r = 0; r < 16; ++r) s[kt][r] = __builtin_amdgcn_exp2f(s[kt][r] - m);
        f32x16 o[2], ls; o[0] = (f32x16){}; o[1] = (f32x16){}; ls = (f32x16){};
#pragma unroll
        for (int kt = 0; kt < 5; ++kt)
#pragma unroll
            for (int s2 = 0; s2 < 2; ++s2) {
                v4u pw; pw.x = cvtpk(s[kt][8 * s2 + 0], s[kt][8 * s2 + 1]); pw.y = cvtpk(s[kt][8 * s2 + 2], s[kt][8 * s2 + 3]); pw.z = cvtpk(s[kt][8 * s2 + 4], s[kt][8 * s2 + 5]); pw.w = cvtpk(s[kt][8 * s2 + 6], s[kt][8 * s2 + 7]);
                const bf16x8 pf = __builtin_bit_cast(bf16x8, pw);
#pragma unroll
                for (int blk = 0; blk < 2; ++blk) {
                    const s16x4 lo = vtr(vbi + (blk * 16384 + 2048 * kt + 1024 * s2)), hi4 = vtr(vbi + (blk * 16384 + 2048 * kt + 1024 * s2 + 512));
                    const bf16x8 vf = (bf16x8){lo[0], lo[1], lo[2], lo[3], hi4[0], hi4[1], hi4[2], hi4[3]};
                    o[blk] = __builtin_amdgcn_mfma_f32_32x32x16_bf16(vf, pf, o[blk], 0, 0, 0); }
                ls = __builtin_amdgcn_mfma_f32_32x32x16_bf16(ones, pf, ls, 0, 0, 0);
            }
        const float inv = __builtin_amdgcn_rcpf(ls[0] + __builtin_amdgcn_exp2f(sink2 - m)); float ss = 0.f;
#pragma unroll
        for (int blk = 0; blk < 2; ++blk)
#pragma unroll
            for (int r = 0; r < 16; ++r) ss = fmaf(o[blk][r], o[blk][r], ss);
        ss = xhalf_sum(ss) * (inv * inv);
        LAS float* pp = part + (i4_ & 1) * 256;
        if (hi == 0) pp[wid * 32 + r32] = ss;
        __syncthreads();
        float tot = 0.f;
#pragma unroll
        for (int w = 0; w < 8; ++w) tot += pp[w * 32 + r32];
        const float rs = __builtin_amdgcn_rsqf(tot * (1.0f / 512.0f) + RMS_EPS) * inv;
        bf16* orow = ymix + qrow * D + hq * 64 + 8 * hi;
#pragma unroll
        for (int blk = 0; blk < 2; ++blk)
#pragma unroll
            for (int gp = 0; gp < 2; ++gp) { const int ge = 2 * gp, go = 2 * gp + 1;
                const unsigned ex = cvtpk(o[blk][4 * ge] * rs, o[blk][4 * ge + 1] * rs), ey = cvtpk(o[blk][4 * ge + 2] * rs, o[blk][4 * ge + 3] * rs);
                const unsigned ox = cvtpk(o[blk][4 * go] * rs, o[blk][4 * go + 1] * rs), oy = cvtpk(o[blk][4 * go + 2] * rs, o[blk][4 * go + 3] * rs);
                auto sx = __builtin_amdgcn_permlane32_swap(ex, ox, false, false); auto sy = __builtin_amdgcn_permlane32_swap(ey, oy, false, false);
                v4u w; w.x = sx[0]; w.y = sy[0]; w.z = sx[1]; w.w = sy[1];
                *(GAS v4u*)(orow + 32 * blk + 16 * gp) = w; }
#pragma unroll
        for (int d0 = 0; d0 < 4; ++d0) qr[d0] = qn[d0];
    }
    __syncthreads();
}

__device__ __forceinline__ void conv_unit(LAS unsigned char* lds, const bf16* ub, bf16* ymix, const float* dw_w, const float* dw_b, const float* ln_g, const float* ln_b, int b, int n, int tid) {
    asm volatile("" : "+v"(tid));
    const int lane = tid & 63, wid = __builtin_amdgcn_readfirstlane(tid >> 6);
    LAS float* U = (LAS float*)lds;
    const int cp = tid & 127, tg = tid >> 7;
    f32x2 w[31];
#pragma unroll
    for (int k = 0; k < 31; ++k) w[k] = *(const GAS f32x2*)(dw_w + k * 256 + 2 * cp);
    const f32x2 bias = *(const GAS f32x2*)(dw_b + 2 * cp);
    const f32x4 lg = *(const GAS f32x4*)(ln_g + 4 * lane), lb = *(const GAS f32x4*)(ln_b + 4 * lane);
#pragma unroll 1
    for (int half = 0; half < 2; ++half) {
        const int t0 = n * 128 + half * 64;
        const size_t rowb = (size_t)b * SEQ;
        {
            v4u vv[6];
#pragma unroll
            for (int j = 0; j < 6; ++j) { const int task = tid + 512 * j, r = task >> 5, c8 = task & 31, tt = t0 - 30 + r;
                if (task < 94 * 32 && tt >= 0) vv[j] = *(const GAS v4u*)(ub + (rowb + tt) * 256 + 8 * c8); else vv[j] = (v4u){0u, 0u, 0u, 0u}; }
#pragma unroll
            for (int j = 0; j < 6; ++j) { const int task = tid + 512 * j, r = task >> 5, c8 = task & 31;
                if (task < 94 * 32) { const f32x4 u0 = (f32x4){bflo(vv[j].x), bfhi(vv[j].x), bflo(vv[j].y), bfhi(vv[j].y)}, u1 = (f32x4){bflo(vv[j].z), bfhi(vv[j].z), bflo(vv[j].w), bfhi(vv[j].w)};
                    *(LAS f32x4*)(U + r * 256 + 8 * c8) = u0; *(LAS f32x4*)(U + r * 256 + 8 * c8 + 4) = u1; } }
        }
        __syncthreads();
        float acc0[2][8], acc1[2][8];
#pragma unroll
        for (int g = 0; g < 2; ++g) {
            const LAS float* up = U + (tg * 16 + g * 8) * 256 + 2 * cp;
#pragma unroll
            for (int jj = 0; jj < 8; ++jj) { acc0[g][jj] = bias[0]; acc1[g][jj] = bias[1]; }
#pragma unroll
            for (int rr = 0; rr < 38; ++rr) { const f32x2 u2 = *(const LAS f32x2*)(up + rr * 256);
#pragma unroll
                for (int jj = 0; jj < 8; ++jj) { const int k = rr - jj; if (k >= 0 && k <= 30) { fmac_s(acc0[g][jj], w[k][0], u2[0]); fmac_s(acc1[g][jj], w[k][1], u2[1]); } } }
        }
        __syncthreads();
#pragma unroll
        for (int g = 0; g < 2; ++g)
#pragma unroll
            for (int jj = 0; jj < 8; ++jj) *(LAS f32x2*)(U + (tg * 16 + g * 8 + jj) * 256 + 2 * cp) = (f32x2){acc0[g][jj], acc1[g][jj]};
        __syncthreads();
#pragma unroll
        for (int jj = 0; jj < 8; ++jj) { const int tok = wid * 8 + jj;
            f32x4 x = *(const LAS f32x4*)(U + tok * 256 + 4 * lane);
            const float mu = wave_sum((x[0] + x[1]) + (x[2] + x[3])) * (1.f / 256.f);
            x = x - mu;
            const float var = wave_sum((x[0] * x[0] + x[1] * x[1]) + (x[2] * x[2] + x[3] * x[3])) * (1.f / 256.f);
            const float rstd = __builtin_amdgcn_rsqf(var + LN_EPS);
            f32x4 y = x * rstd * lg + lb;
#pragma unroll
            for (int e = 0; e < 4; ++e) y[e] = y[e] * sigmoidf_(y[e]);
            const float ss = wave_sum((y[0] * y[0] + y[1] * y[1]) + (y[2] * y[2] + y[3] * y[3]));
            const float rs = __builtin_amdgcn_rsqf(ss * (1.f / 256.f) + RMS_EPS);
            u32x2 o; o.x = cvtpk(y[0] * rs, y[1] * rs); o.y = cvtpk(y[2] * rs, y[3] * rs);
            *(GAS u32x2*)(ymix + (rowb + t0 + tok) * D + 512 + 4 * lane) = o; }
        __syncthreads();
    }
}

struct LruState { f32x16 H[2][2]; };
__device__ __forceinline__ bf16x8 ident_frag(int s, int hi, int col) {
    bf16x8 f;
#pragma unroll
    for (int e = 0; e < 8; ++e) f[e] = (16 * s + 8 * hi + e == col) ? (short)0x3F80 : (short)0;
    return f;
}
__device__ __forceinline__ void lru_tables(LAS unsigned char* lds, const float* cw, const float* cb, const float* ba, const float* bx, const float* lam, int tid) {
    LAS float* cwt = (LAS float*)(lds + CWT_OFF);
    for (int e = tid; e < 1024; e += 512) cwt[e] = cw[e];
    if (tid < 256) { cwt[1024 + tid] = cb[tid]; cwt[1280 + tid] = ba[tid]; }
    else { const int c = tid - 256; cwt[1536 + c] = bx[c]; const float lm = -lam[c]; cwt[1792 + c] = fmaxf(lm, 0.f) + log1pf(__expf(-fabsf(lm))); }
}
__device__ __forceinline__ int pidx(int token, int ch) { return token * 256 + (ch ^ ((token & 7) << 2)); }
__device__ __forceinline__ void lru_local(LruState& st, const bf16* z, const bf16* wfrag, float* agg, LAS unsigned char* lds, int b, int n, int tid) {
    asm volatile("" : "+v"(tid));
    const int lane = tid & 63, wid = __builtin_amdgcn_readfirstlane(tid >> 6), r32 = lane & 31, hi = lane >> 5, hd = wid >> 1, th = wid & 1;
    float fin[2][2];
    LAS float* PL = (LAS float*)lds;
    const LAS float* cwt = (const LAS float*)(lds + CWT_OFF);
    const size_t row_w = (size_t)b * SEQ + (size_t)n * 128 + th * 64;
    const int tseq_w = n * 128 + th * 64;
    v4u xv[4][4];
#define LRU_LOAD_ROWS(tm) do { const int tseq_ = tseq_w + 32 * (tm) + r32; _Pragma("unroll") for (int s = 0; s < 4; ++s) { const bf16* zp = z + (row_w + 32 * (tm) + r32) * NIN + ZRX + hd * 64 + 16 * s + 8 * hi; \
        _Pragma("unroll") for (int k = 0; k < 4; ++k) xv[s][k] = *(const GAS v4u*)(zp - (ptrdiff_t)(tseq_ >= 3 - k ? 3 - k : 0) * NIN); } } while (0)
#define LRU_BUILD_XF(tm) do { const int tseq_ = tseq_w + 32 * (tm) + r32, tok_ = th * 64 + 32 * (tm) + r32; _Pragma("unroll") for (int s = 0; s < 4; ++s) { const int ch = hd * 64 + 16 * s + 8 * hi; \
            f32x4 a0 = *(const LAS f32x4*)(cwt + 1024 + ch), a1 = *(const LAS f32x4*)(cwt + 1024 + ch + 4); \
            _Pragma("unroll") for (int k = 0; k < 4; ++k) { const float mk = tseq_ >= 3 - k ? 1.f : 0.f; \
                const f32x4 w0 = *(const LAS f32x4*)(cwt + k * 256 + ch), w1 = *(const LAS f32x4*)(cwt + k * 256 + ch + 4); \
                const v4u x = xv[s][k]; \
                a0[0] += w0[0] * (mk * bflo(x.x)); a0[1] += w0[1] * (mk * bfhi(x.x)); a0[2] += w0[2] * (mk * bflo(x.y)); a0[3] += w0[3] * (mk * bfhi(x.y)); \
                a1[0] += w1[0] * (mk * bflo(x.z)); a1[1] += w1[1] * (mk * bfhi(x.z)); a1[2] += w1[2] * (mk * bflo(x.w)); a1[3] += w1[3] * (mk * bfhi(x.w)); } \
            v4u pw; pw.x = cvtpk(a0[0], a0[1]); pw.y = cvtpk(a0[2], a0[3]); pw.z = cvtpk(a1[0], a1[1]); pw.w = cvtpk(a1[2], a1[3]); \
            xf[tm][s] = __builtin_bit_cast(bf16x8, pw); \
            *(LAS f32x4*)(PL + pidx(tok_, ch)) = a0; *(LAS f32x4*)(PL + pidx(tok_, ch + 4)) = a1; } \
        asm volatile("s_waitcnt lgkmcnt(0)" ::: "memory"); } while (0)
    LRU_LOAD_ROWS(0);
    bf16x8 waf[4], wxf[4];
#pragma unroll
    for (int s = 0; s < 4; ++s) { waf[s] = *(const GAS bf16x8*)(wfrag + ((size_t)((0 * 4 + hd) * 2 + 0) * 4 + s) * 512 + lane * 8); wxf[s] = *(const GAS bf16x8*)(wfrag + ((size_t)((1 * 4 + hd) * 2 + 0) * 4 + s) * 512 + lane * 8); }
    bf16x8 xf[2][4];
    LRU_BUILD_XF(0);
    LRU_LOAD_ROWS(1);
#pragma unroll
    for (int tn = 0; tn < 2; ++tn) {
        const int c = hd * 64 + 32 * tn + r32;
        const float bav = cwt[1280 + c], bxv = cwt[1536 + c], sp = cwt[1792 + c];
        int cx[4];
#pragma unroll
        for (int e = 0; e < 4; ++e) cx[e] = c ^ ((4 * hi + e) << 2);
        bf16x8 waf2[4], wxf2[4];
        float CA = 1.f, CB = 0.f;
#pragma unroll
        for (int tm = 0; tm < 2; ++tm) {
            __builtin_amdgcn_sched_barrier(0);
            if (tn == 0 && tm == 1) { LRU_BUILD_XF(1);
#pragma unroll
                for (int s = 0; s < 4; ++s) { waf2[s] = *(const GAS bf16x8*)(wfrag + ((size_t)((0 * 4 + hd) * 2 + 1) * 4 + s) * 512 + lane * 8); wxf2[s] = *(const GAS bf16x8*)(wfrag + ((size_t)((1 * 4 + hd) * 2 + 1) * 4 + s) * 512 + lane * 8); }
                __builtin_amdgcn_sched_barrier(0); }
            f32x16 ra = (f32x16){}, ia = (f32x16){};
#pragma unroll
            for (int s = 0; s < 4; ++s) { ra = __builtin_amdgcn_mfma_f32_32x32x16_bf16(xf[tm][s], waf[s], ra, 0, 0, 0); ia = __builtin_amdgcn_mfma_f32_32x32x16_bf16(xf[tm][s], wxf[s], ia, 0, 0, 0); }
            LAS float* pl = PL + (th * 64 + 32 * tm + 4 * hi) * 256;
#pragma unroll
            for (int r = 0; r < 16; ++r) { const float rg = sigmoidf_(ra[r] + bav), ig = sigmoidf_(ia[r] + bxv);
                const float a = __builtin_amdgcn_exp2f((-8.f * LOG2E) * rg * sp);
                ra[r] = a;
                ia[r] = __builtin_amdgcn_sqrtf(fmaf(-a, a, 1.f)) * (ig * pl[((r & 3) + 8 * (r >> 2)) * 256 + cx[r & 3]]); }
#pragma unroll
            for (int g = 0; g < 4; ++g)
#pragma unroll
                for (int e = 1; e < 4; ++e) { ia[4 * g + e] = ra[4 * g + e] * ia[4 * g + e - 1] + ia[4 * g + e]; ra[4 * g + e] = ra[4 * g + e] * ra[4 * g + e - 1]; }
#pragma unroll
            for (int g = 0; g < 4; ++g) {
                const float ownA = ra[4 * g + 3], ownB = ia[4 * g + 3];
                const float othA = xhalf_other(ownA), othB = xhalf_other(ownB);
                float EA = 0.f, EB = 0.f;
                { const float A = hi ? othA : ownA, B = hi ? othB : ownB; if (!hi) { EA = CA; EB = CB; } CB = A * CB + B; CA = A * CA; }
                { const float A = hi ? ownA : othA, B = hi ? ownB : othB; if (hi) { EA = CA; EB = CB; } CB = A * CB + B; CA = A * CA; }
#pragma unroll
                for (int e = 0; e < 4; ++e) { ia[4 * g + e] += ra[4 * g + e] * EB; pl[(e + 8 * g) * 256 + cx[e]] = ra[4 * g + e] * EA; }
            }
            st.H[tm][tn] = ia;
        }
        fin[tn][0] = CA; fin[tn][1] = CB;
        if (tn == 0) {
#pragma unroll
            for (int s = 0; s < 4; ++s) { waf[s] = waf2[s]; wxf[s] = wxf2[s]; } }
    }
#undef LRU_LOAD_ROWS
#undef LRU_BUILD_XF
    LAS f32x2* sub0 = (LAS f32x2*)(lds + SUB0_OFF);
    if (th == 0 && hi == 0) {
#pragma unroll
        for (int tn = 0; tn < 2; ++tn) sub0[(hd * 2 + tn) * 32 + r32] = (f32x2){fin[tn][0], fin[tn][1]}; }
    __syncthreads();
    if (th == 1 && hi == 0) {
#pragma unroll
        for (int tn = 0; tn < 2; ++tn) { const f32x2 f0 = sub0[(hd * 2 + tn) * 32 + r32]; const int c = hd * 64 + 32 * tn + r32, unit = b * 64 + n;
            agg[(size_t)unit * 256 + c] = fin[tn][0] * f0[0]; agg[(size_t)(NUNIT + unit) * 256 + c] = fin[tn][0] * f0[1] + fin[tn][1]; } }
}
__device__ __forceinline__ float gelu_tanh(float x) { const float u = 0.7978845608028654f * (x + 0.044715f * x * x * x); const float e = __expf(2.f * u); const float th = 1.f - 2.f * __builtin_amdgcn_rcpf(e + 1.f); return 0.5f * x * (1.f + th); }
__device__ __forceinline__ void lru_final(LruState& st, LAS unsigned char* lds, const bf16* z, bf16* ymix, const float* agg, int b, int n, int tid) {
    asm volatile("" : "+v"(tid));
    const int lane = tid & 63, wid = __builtin_amdgcn_readfirstlane(tid >> 6), r32 = lane & 31, hi = lane >> 5, hd = wid >> 1, th = wid & 1;
    const size_t row_u = (size_t)b * SEQ + (size_t)n * 128, row_w = row_u + th * 64;
    LAS float* Y = (LAS float*)lds;
    LAS f32x2* seg = (LAS f32x2*)(lds + SEG_OFF);
    { f32x4 SA = (f32x4){1.f, 1.f, 1.f, 1.f}, SB = (f32x4){0.f, 0.f, 0.f, 0.f}; f32x4 ta[8], tb[8];
      const float* aA = agg + (size_t)(b * 64) * 256 + 4 * lane; const float* aB = agg + (size_t)(NUNIT + b * 64) * 256 + 4 * lane;
#pragma unroll
      for (int jj = 0; jj < 8; ++jj) { const int j = 8 * wid + jj;
          if (j < n) { ta[jj] = *(const GAS f32x4*)(aA + (size_t)j * 256); tb[jj] = *(const GAS f32x4*)(aB + (size_t)j * 256); } else { ta[jj] = (f32x4){1.f, 1.f, 1.f, 1.f}; tb[jj] = (f32x4){0.f, 0.f, 0.f, 0.f}; } }
#pragma unroll
      for (int jj = 0; jj < 8; ++jj) { SB = ta[jj] * SB + tb[jj]; SA = ta[jj] * SA; }
#pragma unroll
      for (int e = 0; e < 4; ++e) seg[wid * 256 + 4 * lane + e] = (f32x2){SA[e], SB[e]}; }
    bf16x8 gf[2][4];
#pragma unroll
    for (int tm = 0; tm < 2; ++tm)
#pragma unroll
        for (int s = 0; s < 4; ++s) gf[tm][s] = *(const GAS bf16x8*)(z + (row_w + 32 * tm + r32) * NIN + ZRG + hd * 64 + 16 * s + 8 * hi);
    __syncthreads();
#pragma unroll
    for (int tn = 0; tn < 2; ++tn) {
        const int col = 32 * tn + r32, c = hd * 64 + col;
        float carry = 0.f;
#pragma unroll
        for (int w = 0; w < 8; ++w) { const f32x2 sg = seg[w * 256 + c]; carry = sg[0] * carry + sg[1]; }
        if (th == 1) { const f32x2 f0 = ((const LAS f32x2*)(lds + SUB0_OFF))[(hd * 2 + tn) * 32 + r32]; carry = f0[0] * carry + f0[1]; }
#pragma unroll
        for (int tm = 0; tm < 2; ++tm) {
            f32x16 gd = (f32x16){};
#pragma unroll
            for (int s = 0; s < 4; ++s) gd = __builtin_amdgcn_mfma_f32_32x32x16_bf16(gf[tm][s], ident_frag(s, hi, col), gd, 0, 0, 0);
#pragma unroll
            for (int r = 0; r < 16; ++r) { LAS float* yp = Y + pidx(th * 64 + 32 * tm + crow(r, hi), c);
                const float h = st.H[tm][tn][r] + *yp * carry; *yp = h * gd[r]; }
        }
    }
    __syncthreads();
#pragma unroll
    for (int jj = 0; jj < 16; ++jj) { const int tok = wid * 16 + jj;
        const f32x4 y = *(const LAS f32x4*)(Y + pidx(tok, 4 * lane));
        const float ss = wave_sum((y[0] * y[0] + y[1] * y[1]) + (y[2] * y[2] + y[3] * y[3]));
        const float rs = __builtin_amdgcn_rsqf(ss * (1.f / 256.f) + RMS_EPS);
        u32x2 o; o.x = cvtpk(y[0] * rs, y[1] * rs); o.y = cvtpk(y[2] * rs, y[3] * rs);
        *(GAS u32x2*)(ymix + (row_u + tok) * D + 768 + 4 * lane) = o; }
    __syncthreads();
}
}

struct Frame {
    LAS unsigned char* lds;
    volatile LAS unsigned* MISC;
    gu32* ctl;
    int vcu, G;
};
__device__ __forceinline__ int otid() { int t = threadIdx.x; asm volatile("" : "+v"(t)); return t; }
struct Lw { int tid, lane, wave; __device__ __forceinline__ Lw() { tid = otid(); lane = tid & 63; wave = __builtin_amdgcn_readfirstlane(tid >> 6); } };
struct Args { const float* in[21]; float* out; unsigned char* ws; int ph_lo, ph_hi, bar_region, pad; };
typedef const __attribute__((address_space(4))) Args* ArgsP;
#define ARGS_PTR() ({ ArgsP p_ = (ArgsP)__builtin_amdgcn_kernarg_segment_ptr(); asm volatile("" : "+s"(p_)); p_; })
enum { I_X = 0, I_NORM1, I_WIN, I_SINKS, I_CDW, I_CDB, I_CLG, I_CLB, I_LCW, I_LCB, I_LWA, I_LBA, I_LWX, I_LBX, I_LAM, I_MIXN, I_WOUT, I_NORM2, I_WUP, I_WDOWN, I_FNORM };
constexpr int PH_PRO = 0, PH_L0 = 1, PH_PER_LAYER = 6, PH_FINAL = PH_L0 + DEPTH * PH_PER_LAYER, PH_N = PH_FINAL + 1;

template <bool REMAP> __device__ __forceinline__ void transpose_item(const float* W, const float* gain, int K, int N, bf16* WT, LAS float* scr, int item, int lane) {
    const int nblk = N / 32, kb = item / nblk, nb = item % nblk, k0 = 64 * kb, n0 = 32 * nb;
    int ns = n0; if (REMAP && n0 >= 768 && n0 < 1280) { const int t = n0 - 768, w = t & 255; ns = 768 + ((w >> 5) & 1) * 256 + (t >> 8) * 128 + (w >> 6) * 32; }
    f32x4 v[8]; float g[8];
#pragma unroll
    for (int i = 0; i < 8; ++i) { const int row = 8 * i + (lane >> 3); v[i] = *(const GAS f32x4*)(W + (size_t)(k0 + row) * N + ns + 4 * (lane & 7)); g[i] = gain ? gain[k0 + row] : 1.f; }
#pragma unroll
    for (int i = 0; i < 8; ++i) { const int row = 8 * i + (lane >> 3); *(LAS f32x4*)(scr + row * 36 + 4 * (lane & 7)) = v[i] * g[i]; }
    LDS_WAIT(); asm volatile("" ::: "memory");
    const int n = lane & 31, h = lane >> 5;
#pragma unroll
    for (int j = 0; j < 4; ++j) { const int kc = 2 * j + h; const LAS float* s = scr + (8 * kc) * 36 + n;
        v4u o; o.x = pk2(s[0 * 36], s[1 * 36]); o.y = pk2(s[2 * 36], s[3 * 36]); o.z = pk2(s[4 * 36], s[5 * 36]); o.w = pk2(s[6 * 36], s[7 * 36]);
        *(GAS v4u*)(WT + (size_t)(n0 + n) * K + k0 + 8 * kc) = o; }
    LDS_WAIT(); asm volatile("" ::: "memory");
}
constexpr int I_IN = (D / 64) * (NIN / 32), I_OUT = (D / 64) * (D / 32), I_UP = (D / 64) * (FF / 32), I_DN = (FF / 64) * (D / 32);
__device__ __forceinline__ void weight_item(ArgsP ap, int l, int mat, int r, LAS float* scr, int lane) {
    unsigned char* wl = ap->ws + WS_W + (size_t)l * W_LAYER;
    if (mat == 0)      transpose_item<true>(ap->in[I_WIN] + (size_t)l * D * NIN, ap->in[I_NORM1] + l * D, D, NIN, (bf16*)(wl + W_IN), scr, r, lane);
    else if (mat == 1) transpose_item<false>(ap->in[I_WOUT] + (size_t)l * D * D, ap->in[I_MIXN] + l * D, D, D, (bf16*)(wl + W_OUT), scr, r, lane);
    else if (mat == 2) transpose_item<false>(ap->in[I_WUP] + (size_t)l * D * FF, ap->in[I_NORM2] + l * D, D, FF, (bf16*)(wl + W_UP), scr, r, lane);
    else               transpose_item<false>(ap->in[I_WDOWN] + (size_t)l * FF * D, nullptr, FF, D, (bf16*)(wl + W_DOWN), scr, r, lane);
}
__device__ __forceinline__ void slack_weights(Frame& F, ArgsP ap, int l) {
    if (blockIdx.x < 128) return;
    const Lw L;
    LAS float* scr = (LAS float*)(F.lds + RING_OFF + L.wave * 16384);
    const int gw = ((int)blockIdx.x - 128) * NWAVES + L.wave, NGW = 128 * NWAVES;
    const int total = I_OUT + I_UP + I_DN + (l == 0 ? I_IN : 0);
    for (int it = gw; it < total; it += NGW) {
        int r = it;
        if (r < I_OUT) { weight_item(ap, l, 1, r, scr, L.lane); continue; } r -= I_OUT;
        if (r < I_UP) { weight_item(ap, l, 2, r, scr, L.lane); continue; } r -= I_UP;
        if (r < I_DN) { weight_item(ap, l, 3, r, scr, L.lane); continue; } r -= I_DN;
        weight_item(ap, 1, 0, r, scr, L.lane);
    }
}
__device__ __forceinline__ void rows_to_bf16_ss(int lane, const float* x, bf16* hb, float* ssp, int m0) {
    f32x4 v[4][4]; float s[4] = {0.f, 0.f, 0.f, 0.f};
#pragma unroll
    for (int q = 0; q < 4; ++q) { const GAS f32x4* xr = (const GAS f32x4*)(x + (size_t)(m0 + q) * D) + lane;
#pragma unroll
        for (int j = 0; j < 4; ++j) v[q][j] = xr[64 * j]; }
#pragma unroll
    for (int q = 0; q < 4; ++q) {
#pragma unroll
        for (int j = 0; j < 4; ++j) s[q] += (v[q][j].x * v[q][j].x + v[q][j].y * v[q][j].y) + (v[q][j].z * v[q][j].z + v[q][j].w * v[q][j].w);
        s[q] = wave_sum(s[q]);
        GAS unsigned long long* o8 = (GAS unsigned long long*)(hb + (size_t)(m0 + q) * D) + lane;
#pragma unroll
        for (int j = 0; j < 4; ++j) o8[64 * j] = (unsigned long long)pk2(v[q][j].x, v[q][j].y) | ((unsigned long long)pk2(v[q][j].z, v[q][j].w) << 32);
    }
    if (lane < 16) *(GAS f32x4*)(ssp + pg8::ssp_idx(m0, lane)) = lane == 0 ? (f32x4){s[0], s[1], s[2], s[3]} : (f32x4){0.f, 0.f, 0.f, 0.f};
}
__device__ __forceinline__ void p0_prologue(Frame& F, ArgsP ap) {
    const Lw L;
    LAS float* scr = (LAS float*)(F.lds + RING_OFF + L.wave * 16384);
    const int gw = F.vcu * NWAVES + L.wave, NGW = F.G * NWAVES;
    for (int it = gw; it < I_IN; it += NGW) weight_item(ap, 0, 0, it, scr, L.lane);
    for (int it = gw; it < DEPTH * 64; it += NGW) { const int l = it >> 6, gate = (it >> 5) & 1, hd = (it >> 3) & 3, tn = (it >> 2) & 1, s = it & 3;
        const float* W = ap->in[gate ? I_LWX : I_LWA] + (size_t)l * 4 * 64 * 64; float t[8];
#pragma unroll
        for (int e = 0; e < 8; ++e) t[e] = W[(size_t)(hd * 64 + 16 * s + 8 * (L.lane >> 5) + e) * 64 + 32 * tn + (L.lane & 31)];
        v4u o; o.x = pk2(t[0], t[1]); o.y = pk2(t[2], t[3]); o.z = pk2(t[4], t[5]); o.w = pk2(t[6], t[7]);
        *(GAS v4u*)((bf16*)(ap->ws + WS_WFRAG) + (size_t)l * WFRAG_LAYER + (size_t)(it & 63) * 512 + L.lane * 8) = o; }
    bf16* hb = (bf16*)(ap->ws + WS_HB); float* ssp = (float*)(ap->ws + WS_SSP);
    for (int m = 4 * gw; m < M; m += 4 * NGW) rows_to_bf16_ss(L.lane, ap->in[I_X], hb, ssp, m);
}

__global__ void __launch_bounds__(NWAVES * 64, 2) skel_fwd(Args args) {
    extern __shared__ __attribute__((aligned(16))) unsigned char lds[];
    Frame F;
    F.lds = (LAS unsigned char*)lds;
    F.MISC = (volatile LAS unsigned*)(F.lds + MISC_OFF);
    F.G = gridDim.x; { const int bx = blockIdx.x; F.vcu = (F.G % 8 == 0) ? (bx % 8) * (F.G / 8) + bx / 8 : bx; }
    ArgsP ap0 = ARGS_PTR();
    unsigned char* ws = ap0->ws;
    F.ctl = (gu32*)(ws + WS_CTL);
    for (int u = otid(); u < (LDS_BYTES - LDSCTL_OFF) / 4; u += NWAVES * 64) ((LAS unsigned*)(F.lds + LDSCTL_OFF))[u] = 0u;
    __syncthreads();
    XcdBarrier bar = xcd_barrier_post((unsigned*)(F.ctl + CW_BAR) + ap0->bar_region * XCD_BAR_WORDS, F.MISC + 8);
    bf16* hb = (bf16*)(ws + WS_HB); bf16* h1 = (bf16*)(ws + WS_H1); float* ssp = (float*)(ws + WS_SSP); float* ssp2 = (float*)(ws + WS_SSP2); bf16* z = (bf16*)(ws + WS_Z); bf16* ymix = (bf16*)(ws + WS_YMIX); bf16* hh = (bf16*)(ws + WS_HH);

#ifndef MKEEP
#define MKEEP(x) true
#endif
constexpr unsigned INPROJ_PNPERM = 3u | (4u << 3) | (6u << 6) | (0u << 9) | (1u << 12) | (2u << 15) | (5u << 18);
#ifndef PROBE_KLOOP_PHASE
#define PROBE_KLOOP_AGAIN(l, k) do {} while (0)
#else
#define PROBE_KLOOP_AGAIN(l, k) do { if ((l) == 0 && (k) == PROBE_KLOOP_PHASE) { xcd_barrier(bar); pg8::EpiAny E2 = E; E2.mode = 9 + (int)__hip_atomic_load(F.ctl + 8, __ATOMIC_RELAXED, __HIP_MEMORY_SCOPE_AGENT); pg8::gemm_phase<pg8::EpiAny, pg8::StaticOrder, PG8_ALIGN, PG8_SP2>(F.lds + RING_OFF, g, S, E2); } } while (0)
#endif
#ifndef DOWN_REV
#define DOWN_REV 1
#endif
#ifndef PROBE_UP_AGAIN
#define PROBE_UP_AGAIN(l) do {} while (0)
#endif
#ifndef MREP
#define MREP(x) 1
#endif
#ifndef KEEP
#define KEEP(x) true
#endif
    const int lo = ap0->ph_lo, hi = ap0->ph_hi;
#define IN(p) (lo <= (p) && (p) < hi)
#define SEAM(p) do { if (IN(p) && IN((p) + 1)) xcd_barrier(bar); } while (0)
    if (IN(PH_PRO)) { p0_prologue(F, ARGS_PTR()); SEAM(PH_PRO); }
#ifdef RES_PINGPONG
#define RES_W(a, b) (a)
#else
#define RES_W(a, b) (b)
#endif
#define LAYER_BODY(l) do { \
        const int p = PH_L0 + l * PH_PER_LAYER; \
        unsigned char* wl = ws + WS_W + (size_t)l * W_LAYER; \
        if (IN(p) && KEEP(0)) { \
            pg8::Gemm g{hb, (const bf16*)(wl + W_IN), M, NIN, D, 1}; pg8::StaticOrder S; S.init(M, NIN, F.G, (int)blockIdx.x); S.pnperm = INPROJ_PNPERM; \
            const LAS float* rs_tab = (const LAS float*)(F.lds + mix::XCH_OFF); \
            { LAS float* tab = (LAS float*)(F.lds + mix::XCH_OFF); pg8::Unit u_; const int t_ = otid(); const int r_ = t_ >> 1, hf_ = t_ & 1; \
              f32x4 a_[4], b_[4]; bool ok_[4]; \
              _Pragma("unroll") for (int i_ = 0; i_ < 4; ++i_) { ok_[i_] = S.next(i_, u_); a_[i_] = (f32x4){0.f, 0.f, 0.f, 0.f}; b_[i_] = a_[i_]; \
                  if (ok_[i_]) { const float* p_ = ssp + pg8::ssp_idx(u_.pm * 256 + r_, 8 * hf_); _Pragma("unroll") for (int e_ = 0; e_ < 4; ++e_) { a_[i_][e_] = p_[16 * e_]; b_[i_][e_] = p_[16 * (4 + e_)]; } } } \
              _Pragma("unroll") for (int i_ = 0; i_ < 4; ++i_) { float s_ = ((a_[i_][0] + a_[i_][1]) + (a_[i_][2] + a_[i_][3])) + ((b_[i_][0] + b_[i_][1]) + (b_[i_][2] + b_[i_][3])); s_ += dppmov<0xB1>(s_); \
                  if (ok_[i_] && !hf_) tab[i_ * 256 + r_] = __builtin_amdgcn_rsqf(s_ * (1.0f / 1024.0f) + RMS_EPS); } \
              __syncthreads(); } \
            pg8::EpiAny E{0, z, NIN, nullptr, nullptr, 512, mix::QSCALE, rs_tab, nullptr, nullptr, nullptr, (bf16*)(ws + WS_UBUF)}; \
            pg8::gemm_phase<pg8::EpiAny, pg8::StaticOrder, PG8_ALIGN, PG8_SP2>(F.lds + RING_OFF, g, S, E); \
            slack_weights(F, ARGS_PTR(), l); \
            SEAM(p); \
        } \
        if (IN(p + 1)) { \
            const int b = F.vcu >> 6, n = F.vcu & 63; ArgsP ap = ARGS_PTR(); \
            float* agg = (float*)(ws + mix::WS_AGG); \
            mix::lru_tables(F.lds, ap->in[I_LCW] + l * 4 * 256, ap->in[I_LCB] + l * 256, ap->in[I_LBA] + l * 256, ap->in[I_LBX] + l * 256, ap->in[I_LAM] + l * 256, otid()); \
            for (int rep_ = 0; rep_ < MREP(0); ++rep_) mix::attn_unit(F.lds, z, ymix, ap->in[I_SINKS] + l * 8, b, n, otid()); \
            for (int rep_ = 0; rep_ < MREP(1); ++rep_) mix::conv_unit(F.lds, (const bf16*)(ws + WS_UBUF), ymix, ap->in[I_CDW] + l * 31 * 256, ap->in[I_CDB] + l * 256, ap->in[I_CLG] + l * 256, ap->in[I_CLB] + l * 256, b, n, otid()); \
            mix::LruState st; \
            for (int rep_ = 0; rep_ < MREP(2); ++rep_) mix::lru_local(st, z, (const bf16*)(ws + WS_WFRAG) + (size_t)l * WFRAG_LAYER, agg, F.lds, b, n, otid()); \
            xcd_barrier(bar); \
            if (MKEEP(3)) mix::lru_final(st, F.lds, z, ymix, agg, b, n, otid()); \
            SEAM(p + 1); \
        } \
        if (IN(p + 3) && KEEP(3)) { \
            pg8::Gemm g{ymix, (const bf16*)(wl + W_OUT), M, D, D, 1}; pg8::StaticOrder S; S.init(M, D, F.G, (int)blockIdx.x); \
            pg8::EpiAny E{2, RES_W(h1, hb), D, nullptr, ssp2, 0, 1.f, nullptr, nullptr, nullptr, nullptr, nullptr, hb}; \
            pg8::gemm_phase<pg8::EpiAny, pg8::StaticOrder, PG8_ALIGN, PG8_SP2>(F.lds + RING_OFF, g, S, E); \
            PROBE_KLOOP_AGAIN(l, 3); \
            SEAM(p + 3); \
        } \
        if (IN(p + 4) && KEEP(4)) { \
            pg8::Gemm g{RES_W(h1, hb), (const bf16*)(wl + W_UP), M, FF, D, 1}; pg8::StaticOrder S; S.init(M, FF, F.G, (int)blockIdx.x); \
            pg8::EpiAny E{1, hh, FF, nullptr, nullptr, 0, 1.f, nullptr, nullptr, nullptr, nullptr, nullptr}; \
            pg8::gemm_phase<pg8::EpiAny, pg8::StaticOrder, PG8_ALIGN, PG8_SP2>(F.lds + RING_OFF, g, S, E); \
            PROBE_UP_AGAIN(l); \
            SEAM(p + 4); \
        } \
        if (IN(p + 5) && KEEP(5)) { \
            pg8::Gemm g{hh, (const bf16*)(wl + W_DOWN), M, D, FF, 1}; pg8::StaticOrder S; S.init(M, D, F.G, (int)blockIdx.x); S.rev16 = DOWN_REV; \
            ArgsP ap = ARGS_PTR(); \
            pg8::EpiAny E{l == DEPTH - 1 ? 4 : 3, hb, D, ssp2, ssp, 0, 1.f, nullptr, ap->out, ap->in[I_FNORM], (unsigned*)(F.ctl + CW_FIN), nullptr, RES_W(h1, hb)}; \
            pg8::gemm_phase<pg8::EpiAny, pg8::StaticOrder, PG8_ALIGN, PG8_SP2>(F.lds + RING_OFF, g, S, E); \
            PROBE_KLOOP_AGAIN(l, 5); \
            if (l < DEPTH - 1) SEAM(p + 5); \
        } \
     \
    } while (0)
    LAYER_BODY(0);
    LAYER_BODY(1);
#undef LAYER_BODY
    static_assert(DEPTH == 2, "two layer bodies are expanded by hand");
#undef IN
#undef SEAM
}


#ifndef MK_N_LAUNCHES
#define MK_N_LAUNCHES 1
#endif
extern "C" void kernel_launch(void* const* d_in, const int* in_sizes, int n_in, void* d_out, int out_size, void* d_ws, size_t ws_size, hipStream_t stream) {
    static int grid = 0;
    if (grid == 0) {
        if (n_in != 21 || in_sizes[0] != M * D || out_size != M * D || ws_size < WS_END) {
            fprintf(stderr, "kernel_launch: unexpected shapes n_in %d in0 %d out %d ws %zu\n", n_in, n_in > 0 ? in_sizes[0] : -1, out_size, ws_size); grid = -1; return; }
        int dev = 0, cus = 0;
        if (hipGetDevice(&dev) != hipSuccess || hipDeviceGetAttribute(&cus, hipDeviceAttributeMultiprocessorCount, dev) != hipSuccess) { grid = -1; return; }
        if (hipFuncSetAttribute((const void*)skel_fwd, hipFuncAttributeMaxDynamicSharedMemorySize, LDS_BYTES) != hipSuccess) { fprintf(stderr, "kernel_launch: hipFuncSetAttribute failed\n"); grid = -1; return; }
        grid = cus;
        if (grid != 256) { fprintf(stderr, "kernel_launch: built for 256 CUs, found %d\n", cus); grid = -1; return; }
    }
    if (grid < 0) return;
    (void)hipMemsetAsync((char*)d_ws + WS_CTL, 0, CTL_ZERO_BYTES, stream);
    Args a{};
    for (int i = 0; i < 21; ++i) a.in[i] = (const float*)d_in[i];
    a.out = (float*)d_out; a.ws = (unsigned char*)d_ws;
    int region = 0;
#define SKEL(lo, hi) do { a.ph_lo = (lo); a.ph_hi = (hi); a.bar_region = region++; hipLaunchKernelGGL(skel_fwd, dim3(grid), dim3(NWAVES * 64), LDS_BYTES, stream, a); } while (0)
#if defined(PROBE_REPEAT)
    SKEL(PH_PRO, PROBE_REPEAT + 1); SKEL(PROBE_REPEAT, PROBE_REPEAT + 1); SKEL(PROBE_REPEAT + 1, PH_N);
#elif MK_N_LAUNCHES == 1
    SKEL(PH_PRO, PH_N);
#else
    SKEL(PH_PRO, PH_PRO + 1);
    for (int l = 0; l < DEPTH; ++l) { const int p = PH_L0 + l * PH_PER_LAYER; SKEL(p, p + 1); SKEL(p + 1, p + 2); SKEL(p + 3, p + 4); SKEL(p + 4, p + 5); SKEL(p + 5, p + 6); }
    SKEL(PH_FINAL, PH_FINAL + 1);
#endif
#undef SKEL
}
```

```cpp
#include <hip/hip_runtime.h>
#include <cstdio>
#include <cstdint>
namespace pg8 {
#define PG8_LAS __attribute__((address_space(3)))
typedef unsigned short bf16_t;
typedef short bf16x8 __attribute__((ext_vector_type(8)));
typedef float f32x4 __attribute__((ext_vector_type(4)));
typedef unsigned u32x4 __attribute__((ext_vector_type(4)));
constexpr int BM = 256, BK = 64, HALF = 128, HTB = HALF * BK * 2  , STAGE_BYTES = 8 * HTB, NXCD = 8;
#ifndef PG8_WGM
#define PG8_WGM 4
#endif
constexpr int WGM = PG8_WGM;

__host__ __device__ __forceinline__ int lds_byte(int r, int c) { const int st = (r >> 4) * 2 + (c >> 5), rr = r & 15, cc = c & 31, ob = rr * 64 + cc * 2; return st * 1024 + (ob ^ (((ob >> 9) & 1) << 5)); }
__host__ __device__ __forceinline__ void stage_rc(int b, int& R, int& C) { const int st = b / 1024, sb = b % 1024, swz = sb ^ (((sb >> 9) & 1) << 5); R = (st >> 1) * 16 + swz / 64; C = (st & 1) * 32 + (swz % 64) / 2; }
__host__ __device__ __forceinline__ int perm32(int rho) { const int n = rho >> 4, i = rho & 15; return 8 * (i >> 2) + 4 * n + (i & 3); }

struct Unit { int pm, pn, slot; };
struct Gemm { const bf16_t* A; const bf16_t* Bt; int M, N, K; int adj; int lda; };

struct StaticOrder {
    int nM, nN, nwg, G, c; int rev16; unsigned pnperm;
    __host__ __device__ __forceinline__ void init(int M, int N, int G_, int c_) { nM = M / BM; nN = N / BM; nwg = nM * nN; G = G_; c = c_; pnperm = 0u; rev16 = 0; }
    __host__ __device__ __forceinline__ bool next(int i, Unit& u) const {
        const long L = (long)i * G + c; if (L >= nwg) return false;
        int wgid = (int)L; { const int q = nwg / NXCD, r = nwg % NXCD, xcd = wgid % NXCD, off = wgid / NXCD; wgid = (xcd < r ? xcd * (q + 1) : r * (q + 1) + (xcd - r) * q) + off; }
        const int nig = WGM * nN, gid = wgid / nig, fm = gid * WGM, gsz = (nM - fm) < WGM ? (nM - fm) : WGM;
        u.pm = fm + ((wgid % nig) % gsz); u.pn = (wgid % nig) / gsz; if (pnperm) u.pn = (int)((pnperm >> (3 * u.pn)) & 7u); if (rev16) u.pm = (u.pm & ~15) | (15 - (u.pm & 15)); u.slot = i; return true;
    }
    __device__ __forceinline__ void a_ready(const Unit&) const {}
    __device__ __forceinline__ void done(const Unit&) const {}
};

__device__ __forceinline__ unsigned cvt_pk_bf16(float lo, float hi) { typedef float f2_ __attribute__((ext_vector_type(2))); typedef __bf16 b2_ __attribute__((ext_vector_type(2))); f2_ v = {lo, hi}; b2_ b = __builtin_convertvector(v, b2_); return __builtin_bit_cast(unsigned, b); }

constexpr float EPI_RMS_EPS = 1e-6f;
__device__ __forceinline__ float rows4_sum(float v) {
    auto a = __builtin_amdgcn_permlane32_swap(__float_as_uint(v), __float_as_uint(v), false, false); v = __uint_as_float(a[0]) + __uint_as_float(a[1]);
    auto b = __builtin_amdgcn_permlane16_swap(__float_as_uint(v), __float_as_uint(v), false, false); return __uint_as_float(b[0]) + __uint_as_float(b[1]);
}
__device__ __forceinline__ float epi_sigmoid(float x) { return __builtin_amdgcn_rcpf(1.f + __builtin_amdgcn_exp2f(-1.4426950408889634f * x)); }
__device__ __forceinline__ float epi_gelu_tanh(float x) { const float u = 0.7978845608028654f * (x + 0.044715f * x * x * x); const float ex = __builtin_amdgcn_exp2f(2.f * 1.4426950408889634f * u); return 0.5f * x * (2.f - 2.f * __builtin_amdgcn_rcpf(ex + 1.f)); }
#ifndef HH_PLAIN
#define HH_STORE(w, p) __builtin_nontemporal_store(w, p)
#else
#define HH_STORE(w, p) (*(p) = (w))
#endif
__device__ __forceinline__ constexpr unsigned ssp_idx(int row, int part) { return (unsigned)(((row >> 4) * 16 + part) * 16 + (row & 15)); }
__device__ __forceinline__ unsigned ror8(unsigned v) { return (unsigned)__builtin_amdgcn_update_dpp((int)v, (int)v, 0x128, 0xf, 0xf, false); }
__device__ __forceinline__ u32x4 ror8(u32x4 v) { u32x4 r; r.x = ror8(v.x); r.y = ror8(v.y); r.z = ror8(v.z); r.w = ror8(v.w); return r; }
__device__ __forceinline__ u32x4 sel4(bool c, u32x4 a, u32x4 b) { u32x4 r; r.x = c ? a.x : b.x; r.y = c ? a.y : b.y; r.z = c ? a.z : b.z; r.w = c ? a.w : b.w; return r; }
struct EpiAny {
    static constexpr bool PERM = true, AFTER_DRAIN = false;
    int mode; bf16_t* O; int ldc; const float* ssp_r; float* ssp_w; int qcols; float qscale; const PG8_LAS float* rs_tab; float* fout; const float* fgain; unsigned* fcnt; bf16_t* ubuf; const bf16_t* R;

    __device__ __forceinline__ void final_rows(const f32x4 (&acc)[2][2][4][2], const Unit& u, int wr, int wc, int fr, int fq) const {
        typedef float f32x2 __attribute__((ext_vector_type(2)));
        const int row0 = u.pm * BM + wr * 64 + fr, col0 = u.pn * BM + wc * 64 + 8 * fq;
        const bool hi = (fr & 8) != 0;
        f32x4 h[2][2][4][2];
        { f32x4 pp[2][4]; int rowp_ = row0; asm volatile("" : "+v"(rowp_));
#pragma unroll
            for (int ai = 0; ai < 2; ++ai)
#pragma unroll
                for (int m = 0; m < 4; ++m) { _Pragma("unroll") for (int e = 0; e < 4; ++e) pp[ai][m][e] = ssp_r[ssp_idx(rowp_ + ai * HALF + m * 16, 4 * fq + e)]; }
#pragma unroll
            for (int ai = 0; ai < 2; ++ai)
#pragma unroll
                for (int m = 0; m < 4; ++m) { const f32x4 p = pp[ai][m]; float s = (p[0] + p[1]) + (p[2] + p[3]); s = rows4_sum(s); const float r2 = __builtin_amdgcn_rcpf(s * (1.0f / 1024.0f) + EPI_RMS_EPS);
#pragma unroll
                    for (int bj = 0; bj < 2; ++bj) { h[ai][bj][m][0] = acc[ai][bj][m][0] * r2; h[ai][bj][m][1] = acc[ai][bj][m][1] * r2; } }
            asm volatile("" ::: "memory"); }
        float sqv[2][4];
        { u32x4 rb[2][4][2]; int rowl_ = row0 - (hi ? 8 : 0), coll_ = col0 + (hi ? 32 : 0); asm volatile("" : "+v"(rowl_), "+v"(coll_));
#pragma unroll
            for (int ai = 0; ai < 2; ++ai)
#pragma unroll
                for (int m = 0; m < 4; ++m) {
                    rb[ai][m][0] = *(const u32x4*)(R + (size_t)(unsigned)((rowl_ + ai * HALF + m * 16) * ldc + coll_));
                    rb[ai][m][1] = *(const u32x4*)(R + (size_t)(unsigned)((rowl_ + ai * HALF + m * 16 + 8) * ldc + (coll_ ^ 32))); }
#pragma unroll
            for (int ai = 0; ai < 2; ++ai)
#pragma unroll
                for (int m = 0; m < 4; ++m) { f32x2 sq2 = {0.f, 0.f};
                    const u32x4 rx = sel4(hi, rb[ai][m][1], rb[ai][m][0]), ry = ror8(sel4(hi, rb[ai][m][0], rb[ai][m][1]));
#pragma unroll
                    for (int bj = 0; bj < 2; ++bj) { const u32x4 r = bj ? ry : rx; f32x4 a0 = h[ai][bj][m][0], a1 = h[ai][bj][m][1];
                        a0[0] += __builtin_bit_cast(float, r.x << 16); a0[1] += __builtin_bit_cast(float, r.x & 0xffff0000u); a0[2] += __builtin_bit_cast(float, r.y << 16); a0[3] += __builtin_bit_cast(float, r.y & 0xffff0000u);
                        a1[0] += __builtin_bit_cast(float, r.z << 16); a1[1] += __builtin_bit_cast(float, r.z & 0xffff0000u); a1[2] += __builtin_bit_cast(float, r.w << 16); a1[3] += __builtin_bit_cast(float, r.w & 0xffff0000u);
                        h[ai][bj][m][0] = a0; h[ai][bj][m][1] = a1;
                        sq2 += (f32x2){a0[0], a0[1]} * (f32x2){a0[0], a0[1]} + (f32x2){a0[2], a0[3]} * (f32x2){a0[2], a0[3]}; sq2 += (f32x2){a1[0], a1[1]} * (f32x2){a1[0], a1[1]} + (f32x2){a1[2], a1[3]} * (f32x2){a1[2], a1[3]}; }
                    sqv[ai][m] = rows4_sum(sq2[0] + sq2[1]); } }
        { int rows_ = row0; asm volatile("" : "+v"(rows_));
#pragma unroll
            for (int ai = 0; ai < 2; ++ai)
#pragma unroll
                for (int m = 0; m < 4; ++m)
                    if (fq == 0) __hip_atomic_store(ssp_w + ssp_idx(rows_ + ai * HALF + m * 16, u.pn * 4 + wc), sqv[ai][m], __ATOMIC_RELAXED, __HIP_MEMORY_SCOPE_AGENT); }
        asm volatile("s_waitcnt vmcnt(0)" ::: "memory");
        unsigned* cnt = fcnt + 64 * (2 * u.pm + wr);
        if ((threadIdx.x & 63) == 0) __hip_atomic_fetch_add(cnt, 1u, __ATOMIC_RELAXED, __HIP_MEMORY_SCOPE_AGENT);
        { unsigned sp_ = 0; while ((unsigned)__builtin_amdgcn_readfirstlane(__hip_atomic_load(cnt, __ATOMIC_RELAXED, __HIP_MEMORY_SCOPE_AGENT)) < 16u) { __builtin_amdgcn_s_sleep(1); if (++sp_ > (1u << 20)) break; } }
        float rsv[2][4];
        { float pt[2][4][4]; int rowq_ = row0; asm volatile("" : "+v"(rowq_));
#pragma unroll
            for (int ai = 0; ai < 2; ++ai)
#pragma unroll
                for (int m = 0; m < 4; ++m)
#pragma unroll
                    for (int e = 0; e < 4; ++e) pt[ai][m][e] = __hip_atomic_load(ssp_w + ssp_idx(rowq_ + ai * HALF + m * 16, 4 * fq + e), __ATOMIC_RELAXED, __HIP_MEMORY_SCOPE_AGENT);
#pragma unroll
            for (int ai = 0; ai < 2; ++ai)
#pragma unroll
                for (int m = 0; m < 4; ++m) { float s = (pt[ai][m][0] + pt[ai][m][1]) + (pt[ai][m][2] + pt[ai][m][3]); s = rows4_sum(s); rsv[ai][m] = __builtin_amdgcn_rsqf(s * (1.0f / 1024.0f) + EPI_RMS_EPS); } }
        f32x4 g[2][2];
#pragma unroll
        for (int bj = 0; bj < 2; ++bj) { g[bj][0] = *(const f32x4*)(fgain + col0 + bj * 32); g[bj][1] = *(const f32x4*)(fgain + col0 + bj * 32 + 4); }
        asm volatile("" ::: "memory");
        int rowo_ = row0; asm volatile("" : "+v"(rowo_));
#pragma unroll
        for (int ai = 0; ai < 2; ++ai)
#pragma unroll
            for (int m = 0; m < 4; ++m)
#pragma unroll
                for (int bj = 0; bj < 2; ++bj) {
                    const f32x4 P = h[ai][bj][m][0] * rsv[ai][m] * g[bj][0], Q = h[ai][bj][m][1] * rsv[ai][m] * g[bj][1];
                    u32x4 pu, qu; pu.x = __float_as_uint(P[0]); pu.y = __float_as_uint(P[1]); pu.z = __float_as_uint(P[2]); pu.w = __float_as_uint(P[3]);
                    qu.x = __float_as_uint(Q[0]); qu.y = __float_as_uint(Q[1]); qu.z = __float_as_uint(Q[2]); qu.w = __float_as_uint(Q[3]);
                    const u32x4 qr = ror8(qu);
                    float* op = fout + (size_t)(unsigned)((rowo_ + ai * HALF + m * 16 - (hi ? 8 : 0)) * qcols + col0 + bj * 32);
                    *(u32x4*)(op + (hi ? 4 : 0)) = sel4(hi, qr, pu);
                    *(u32x4*)(op + 8 * qcols + (hi ? 0 : 4)) = sel4(hi, pu, qr); }
    }
    __device__ __forceinline__ void operator()(const f32x4 (&acc)[2][2][4][2], const Unit& u, int wr, int wc, int fr_, int fq_) const {
        int fr = fr_, fq = fq_; asm volatile("" : "+v"(fr), "+v"(fq));
        const int row0 = u.pm * BM + wr * 64 + fr, col0 = u.pn * BM + wc * 32 + 8 * fq;
        if (mode > 4) return;
        if (mode == 4) { final_rows(acc, u, wr, wc, fr, fq); return; }
        if (mode == 1) {
            typedef float f32x2 __attribute__((ext_vector_type(2)));
            const bool hi1 = (fr & 8) != 0; const int rowa_ = row0 - (hi1 ? 8 : 0), cola_ = u.pn * BM + wc * 64 + 8 * fq + (hi1 ? 32 : 0);
#pragma unroll
            for (int ai = 0; ai < 2; ++ai)
#pragma unroll
                for (int m = 0; m < 4; ++m) { u32x4 wx, wy;
#pragma unroll
                    for (int bj = 0; bj < 2; ++bj) { const f32x4 a0 = acc[ai][bj][m][0], a1 = acc[ai][bj][m][1];
                        f32x2 p0 = __builtin_elementwise_max((f32x2){a0[0], a0[1]}, (f32x2){0.f, 0.f}), p1 = __builtin_elementwise_max((f32x2){a0[2], a0[3]}, (f32x2){0.f, 0.f});
                        f32x2 p2 = __builtin_elementwise_max((f32x2){a1[0], a1[1]}, (f32x2){0.f, 0.f}), p3 = __builtin_elementwise_max((f32x2){a1[2], a1[3]}, (f32x2){0.f, 0.f});
                        p0 = p0 * p0; p1 = p1 * p1; p2 = p2 * p2; p3 = p3 * p3;
                        u32x4 w; w.x = cvt_pk_bf16(p0[0], p0[1]); w.y = cvt_pk_bf16(p1[0], p1[1]); w.z = cvt_pk_bf16(p2[0], p2[1]); w.w = cvt_pk_bf16(p3[0], p3[1]);
                        if (bj) wy = w; else wx = w; }
                    const u32x4 wyr = ror8(wy); bf16_t* pa = O + (size_t)(unsigned)((rowa_ + ai * HALF + m * 16) * ldc + cola_);
                    HH_STORE(sel4(hi1, wyr, wx), (u32x4*)pa);
                    HH_STORE(sel4(hi1, wx, wyr), (u32x4*)(O + (size_t)(unsigned)((rowa_ + ai * HALF + m * 16 + 8) * ldc + (cola_ ^ 32)))); }
            return;
        }
        if (mode < 2) {
            const float sc = (u.pn * BM < qcols) ? qscale : 1.f;
            const int kind = (u.pn == 3 || u.pn == 4) ? 1 : (u.pn == 6) ? 2 : 0;
            const bool hi0 = (fr & 8) != 0; const int cola0_ = u.pn * BM + wc * 64 + 8 * fq + (hi0 ? 32 : 0);
#pragma unroll
            for (int ai = 0; ai < 2; ++ai)
#pragma unroll
                for (int m = 0; m < 4; ++m) { const int row = row0 + ai * HALF + m * 16;
                    const float rs = rs_tab[u.slot * BM + wr * 64 + fr + ai * HALF + m * 16] * sc;
                    if (kind == 1) {
                        f32x4 v0 = acc[ai][0][m][0] * rs, v1 = acc[ai][0][m][1] * rs; const f32x4 g0 = acc[ai][1][m][0] * rs, g1 = acc[ai][1][m][1] * rs;
#pragma unroll
                        for (int e = 0; e < 4; ++e) { v0[e] *= epi_sigmoid(g0[e]); v1[e] *= epi_sigmoid(g1[e]); }
                        u32x4 w; w.x = cvt_pk_bf16(v0[0], v0[1]); w.y = cvt_pk_bf16(v0[2], v0[3]); w.z = cvt_pk_bf16(v1[0], v1[1]); w.w = cvt_pk_bf16(v1[2], v1[3]);
                        *(u32x4*)(ubuf + (size_t)row * 256 + (u.pn - 3) * HALF + wc * 32 + 8 * fq) = w;
                    } else {
                    u32x4 wx, wy;
#pragma unroll
                    for (int bj = 0; bj < 2; ++bj) { f32x4 v0 = acc[ai][bj][m][0] * rs, v1 = acc[ai][bj][m][1] * rs;
                        if (kind == 2) {
#pragma unroll
                            for (int e = 0; e < 4; ++e) { v0[e] = epi_gelu_tanh(v0[e]); v1[e] = epi_gelu_tanh(v1[e]); } }
                        u32x4 w; w.x = cvt_pk_bf16(v0[0], v0[1]); w.y = cvt_pk_bf16(v0[2], v0[3]); w.z = cvt_pk_bf16(v1[0], v1[1]); w.w = cvt_pk_bf16(v1[2], v1[3]);
                        if (bj) wy = w; else wx = w; }
                    const u32x4 wyr = ror8(wy);
                    *(u32x4*)(O + (size_t)(unsigned)((row - (hi0 ? 8 : 0)) * ldc + cola0_)) = sel4(hi0, wyr, wx);
                    *(u32x4*)(O + (size_t)(unsigned)((row - (hi0 ? 8 : 0) + 8) * ldc + (cola0_ ^ 32))) = sel4(hi0, wx, wyr); } }
        } else {
            typedef float f32x2 __attribute__((ext_vector_type(2)));
            f32x4 sa[2][2][4][2];
            if (mode == 3) {
                f32x4 pp[2][4]; int rowp_ = row0; asm volatile("" : "+v"(rowp_));
#pragma unroll
                for (int ai = 0; ai < 2; ++ai)
#pragma unroll
                    for (int m = 0; m < 4; ++m) { _Pragma("unroll") for (int e = 0; e < 4; ++e) pp[ai][m][e] = ssp_r[ssp_idx(rowp_ + ai * HALF + m * 16, 4 * fq + e)]; }
#pragma unroll
                for (int ai = 0; ai < 2; ++ai)
#pragma unroll
                    for (int m = 0; m < 4; ++m) { const f32x4 p = pp[ai][m]; float s = (p[0] + p[1]) + (p[2] + p[3]); s = rows4_sum(s); const float r2 = __builtin_amdgcn_rcpf(s * (1.0f / 1024.0f) + EPI_RMS_EPS);
#pragma unroll
                        for (int bj = 0; bj < 2; ++bj) { sa[ai][bj][m][0] = acc[ai][bj][m][0] * r2; sa[ai][bj][m][1] = acc[ai][bj][m][1] * r2; } }
                asm volatile("" ::: "memory");
            } else {
#pragma unroll
                for (int ai = 0; ai < 2; ++ai)
#pragma unroll
                    for (int m = 0; m < 4; ++m)
#pragma unroll
                        for (int bj = 0; bj < 2; ++bj) { sa[ai][bj][m][0] = acc[ai][bj][m][0]; sa[ai][bj][m][1] = acc[ai][bj][m][1]; }
            }
            const bool hi = (fr & 8) != 0;
            int rowl_ = row0 - (hi ? 8 : 0), coll_ = u.pn * BM + wc * 64 + 8 * fq + (hi ? 32 : 0); asm volatile("" : "+v"(rowl_), "+v"(coll_));
            u32x4 rb[2][4][2];
#pragma unroll
            for (int ai = 0; ai < 2; ++ai)
#pragma unroll
                for (int m = 0; m < 4; ++m) {
                    rb[ai][m][0] = *(const u32x4*)(R + (size_t)(unsigned)((rowl_ + ai * HALF + m * 16) * ldc + coll_));
                    rb[ai][m][1] = *(const u32x4*)(R + (size_t)(unsigned)((rowl_ + ai * HALF + m * 16 + 8) * ldc + (coll_ ^ 32))); }
#pragma unroll
            for (int ai = 0; ai < 2; ++ai)
#pragma unroll
                for (int m = 0; m < 4; ++m) { int row = row0 + ai * HALF + m * 16; asm volatile("" : "+v"(row));
                    f32x2 sq2 = {0.f, 0.f};
                    const u32x4 rx = sel4(hi, rb[ai][m][1], rb[ai][m][0]), ry = ror8(sel4(hi, rb[ai][m][0], rb[ai][m][1]));
                    u32x4 wx, wy;
#pragma unroll
                    for (int bj = 0; bj < 2; ++bj) {
                        const u32x4 r = bj ? ry : rx; const f32x4 a0 = sa[ai][bj][m][0], a1 = sa[ai][bj][m][1];
                        const f32x2 v0 = (f32x2){a0[0], a0[1]} + (f32x2){__builtin_bit_cast(float, r.x << 16), __builtin_bit_cast(float, r.x & 0xffff0000u)};
                        const f32x2 v1 = (f32x2){a0[2], a0[3]} + (f32x2){__builtin_bit_cast(float, r.y << 16), __builtin_bit_cast(float, r.y & 0xffff0000u)};
                        const f32x2 v2 = (f32x2){a1[0], a1[1]} + (f32x2){__builtin_bit_cast(float, r.z << 16), __builtin_bit_cast(float, r.z & 0xffff0000u)};
                        const f32x2 v3 = (f32x2){a1[2], a1[3]} + (f32x2){__builtin_bit_cast(float, r.w << 16), __builtin_bit_cast(float, r.w & 0xffff0000u)};
                        sq2 += v0 * v0 + v1 * v1; sq2 += v2 * v2 + v3 * v3;
                        u32x4 w; w.x = cvt_pk_bf16(v0[0], v0[1]); w.y = cvt_pk_bf16(v1[0], v1[1]); w.z = cvt_pk_bf16(v2[0], v2[1]); w.w = cvt_pk_bf16(v3[0], v3[1]);
                        if (bj) wy = w; else wx = w; }
                    const u32x4 wyr = ror8(wy);
                    const unsigned offa = (unsigned)((row - (hi ? 8 : 0)) * ldc + coll_);
                    *(u32x4*)(O + (size_t)offa) = sel4(hi, wyr, wx);
                    *(u32x4*)(O + (size_t)(unsigned)((row - (hi ? 8 : 0) + 8) * ldc + (coll_ ^ 32))) = sel4(hi, wx, wyr);
                    float sq = sq2[0] + sq2[1];
                    sq = rows4_sum(sq);
                    if (fq == 0) ssp_w[ssp_idx(row, u.pn * 4 + wc)] = sq; }
        }
    }
};
template <class Epi, class Sched, bool ALIGN_EPI = false, bool SP2 = false>
__device__ __forceinline__ void gemm_phase(PG8_LAS unsigned char* lds, const Gemm g, const Sched& S, const Epi& E) {
    int tid_ = threadIdx.x; asm volatile("" : "+v"(tid_));
    const int tid = tid_, wid = __builtin_amdgcn_readfirstlane(tid >> 6), lane = tid & 63, wr = wid >> 2, wc = wid & 3, fr = lane & 15, fq = lane >> 4;
    const int K = g.K, nt = K / BK;
    const int lda = g.lda ? g.lda : K;
    unsigned voffA[2], voffB[2];
#pragma unroll
    for (int i = 0; i < 2; ++i) { int R, C; stage_rc(tid * 16 + i * 8192, R, C); const int Rb = Epi::PERM ? ((g.adj ? (R >> 5) * 64 : (R & ~31)) + perm32(R & 31)) : R;
        voffA[i] = (unsigned)(R * lda + C) * 2u; voffB[i] = (unsigned)(Rb * K + C) * 2u; }
    const size_t kstep = (size_t)(BK * 2);
    const size_t hstepK = (size_t)HALF * K * 2, tstepB = 2 * hstepK;
    const size_t hstep = (size_t)HALF * lda * 2, tstep = 2 * hstep;
    const size_t hstepB = g.adj ? (size_t)32 * K * 2 : hstepK;
    const unsigned ldsw = (unsigned)wid * 1024u;
    const int aoff = lds_byte(wr * 64 + fr, fq * 8), boff = lds_byte(wc * 32 + fr, fq * 8);
#define PG8_SA(b, h) (((b) * 2 + (h)) * HTB)
#define PG8_SB(b, h) ((4 + (b) * 2 + (h)) * HTB)
#define PG8_STAGE(bufoff, gbase, voff) do { _Pragma("unroll") for (int _i = 0; _i < 2; ++_i) \
        __builtin_amdgcn_global_load_lds((const unsigned*)((const char*)(gbase) + (voff)[_i]), (PG8_LAS unsigned*)(lds + (bufoff) + ldsw + _i * 8192), 16, 0, 0); } while (0)
#define PG8_LDA(dst, b, h) do { _Pragma("unroll") for (int m = 0; m < 4; ++m) _Pragma("unroll") for (int k = 0; k < 2; ++k) dst[m][k] = *(const PG8_LAS bf16x8*)(lds + PG8_SA(b, h) + aoff + m * 2048 + k * 1024); } while (0)
#define PG8_LDB(dst, b, h) do { _Pragma("unroll") for (int n = 0; n < 2; ++n) _Pragma("unroll") for (int k = 0; k < 2; ++k) dst[n][k] = *(const PG8_LAS bf16x8*)(lds + PG8_SB(b, h) + boff + n * 2048 + k * 1024); } while (0)
#define PG8_MMA(ai, bj, At, Bt) do { __builtin_amdgcn_s_setprio(1); _Pragma("unroll") for (int m = 0; m < 4; ++m) _Pragma("unroll") for (int n = 0; n < 2; ++n) _Pragma("unroll") for (int k = 0; k < 2; ++k) \
        acc[ai][bj][m][n] = __builtin_amdgcn_mfma_f32_16x16x32_bf16(Bt[n][k], At[m][k], acc[ai][bj][m][n], 0, 0, 0); __builtin_amdgcn_s_setprio(0); } while (0)
#define PG8_WAIT_V(n) asm volatile("s_waitcnt vmcnt(" #n ")" ::: "memory")
#define PG8_WAIT_L(n) asm volatile("s_waitcnt lgkmcnt(" #n ")" ::: "memory")
#define PG8_BAR __builtin_amdgcn_s_barrier()
#define PG8_SCHED __builtin_amdgcn_sched_barrier(0)
    Unit cur, nxt; int ui = 0;
    if (!S.next(0, cur)) return;
    f32x4 acc[2][2][4][2];
#pragma unroll
    for (int a = 0; a < 2; ++a)
#pragma unroll
        for (int b = 0; b < 2; ++b)
#pragma unroll
            for (int m = 0; m < 4; ++m)
#pragma unroll
                for (int n = 0; n < 2; ++n) acc[a][b][m][n] = (f32x4){0.f, 0.f, 0.f, 0.f};
    bf16x8 At[4][2], B0[2][2], B1[2][2];
    const char* cA = (const char*)g.A + (size_t)cur.pm * tstep; const char* cB = (const char*)g.Bt + (size_t)cur.pn * tstepB;
    S.a_ready(cur);
    if constexpr (SP2) {
        PG8_STAGE(PG8_SB(0, 0), cB, voffB); PG8_STAGE(PG8_SB(0, 1), cB + hstepB, voffB); PG8_STAGE(PG8_SA(0, 0), cA, voffA); PG8_STAGE(PG8_SA(0, 1), cA + hstep, voffA);
        if (wr == 1) PG8_BAR;
        PG8_WAIT_V(2); PG8_BAR;
        PG8_STAGE(PG8_SB(1, 0), cB + kstep, voffB); PG8_STAGE(PG8_SA(1, 0), cA + kstep, voffA); PG8_STAGE(PG8_SB(1, 1), cB + hstepB + kstep, voffB);
        PG8_WAIT_V(6); PG8_BAR;
    } else {
        PG8_STAGE(PG8_SB(0, 0), cB, voffB); PG8_STAGE(PG8_SA(0, 0), cA, voffA); PG8_STAGE(PG8_SB(0, 1), cB + hstepB, voffB); PG8_STAGE(PG8_SA(0, 1), cA + hstep, voffA);
        if (wr == 1) PG8_BAR;
        PG8_WAIT_V(4); PG8_BAR;
        PG8_STAGE(PG8_SB(1, 0), cB + kstep, voffB); PG8_STAGE(PG8_SA(1, 0), cA + kstep, voffA); PG8_STAGE(PG8_SB(1, 1), cB + hstepB + kstep, voffB);
        PG8_WAIT_V(6); PG8_BAR;
    }
    for (;;) {
        const bool has_next = S.next(ui + 1, nxt);
        const char* nA = has_next ? (const char*)g.A + (size_t)nxt.pm * tstep : cA; const char* nB = has_next ? (const char*)g.Bt + (size_t)nxt.pn * tstepB : cB;
        for (int t = 0; t < nt; t += 2) {
            const bool last = (t == nt - 2);
            const char* a1 = cA + (size_t)(t + 1) * kstep;
            const char* a2 = last ? nA : cA + (size_t)(t + 2) * kstep; const char* b2 = last ? nB : cB + (size_t)(t + 2) * kstep;
            const char* a3 = a2 + kstep; const char* b3 = b2 + kstep;
            if (last && has_next) S.a_ready(nxt);
            if constexpr (SP2) {
            PG8_LDB(B0, 0, 0); PG8_LDB(B1, 0, 1); PG8_SCHED; PG8_LDA(At, 0, 0); PG8_STAGE(PG8_SA(1, 1), a1 + hstep, voffA);
            PG8_WAIT_V(8); PG8_WAIT_L(0); PG8_BAR; PG8_MMA(0, 0, At, B0); PG8_MMA(0, 1, At, B1); PG8_BAR; PG8_SCHED;
            PG8_LDA(At, 0, 1); PG8_STAGE(PG8_SB(0, 0), b2, voffB); PG8_STAGE(PG8_SB(0, 1), b2 + hstepB, voffB); PG8_STAGE(PG8_SA(0, 0), a2, voffA);
            PG8_WAIT_V(8); PG8_WAIT_L(0); PG8_BAR; PG8_MMA(1, 0, At, B0); PG8_MMA(1, 1, At, B1); PG8_BAR; PG8_SCHED;
            PG8_LDB(B0, 1, 0); PG8_LDB(B1, 1, 1); PG8_SCHED; PG8_LDA(At, 1, 0); PG8_STAGE(PG8_SA(0, 1), a2 + hstep, voffA);
            PG8_WAIT_V(8); PG8_WAIT_L(0); PG8_BAR; PG8_MMA(0, 0, At, B0); PG8_MMA(0, 1, At, B1); PG8_BAR; PG8_SCHED;
            PG8_LDA(At, 1, 1); PG8_STAGE(PG8_SB(1, 0), b3, voffB); PG8_STAGE(PG8_SB(1, 1), b3 + hstepB, voffB); PG8_STAGE(PG8_SA(1, 0), a3, voffA);
            PG8_WAIT_V(8); PG8_WAIT_L(0); PG8_BAR; PG8_MMA(1, 0, At, B0); PG8_MMA(1, 1, At, B1); PG8_BAR; PG8_SCHED;
            } else {
            PG8_LDB(B0, 0, 0); PG8_SCHED; PG8_LDA(At, 0, 0); PG8_STAGE(PG8_SA(1, 1), a1 + hstep, voffA);
            PG8_WAIT_L(8); PG8_BAR; PG8_WAIT_L(0); PG8_MMA(0, 0, At, B0); PG8_BAR; PG8_SCHED;
            PG8_LDB(B1, 0, 1); PG8_STAGE(PG8_SB(0, 0), b2, voffB);
            PG8_BAR; PG8_WAIT_L(0); PG8_MMA(0, 1, At, B1); PG8_BAR;
            PG8_LDA(At, 0, 1); PG8_STAGE(PG8_SA(0, 0), a2, voffA);
            PG8_BAR; PG8_WAIT_L(0); PG8_MMA(1, 0, At, B0); PG8_BAR; PG8_SCHED;
            PG8_STAGE(PG8_SB(0, 1), b2 + hstepB, voffB);
            PG8_WAIT_V(6); PG8_BAR; PG8_MMA(1, 1, At, B1); PG8_BAR;
            PG8_LDB(B0, 1, 0); PG8_SCHED; PG8_LDA(At, 1, 0); PG8_STAGE(PG8_SA(0, 1), a2 + hstep, voffA);
            PG8_WAIT_L(8); PG8_BAR; PG8_WAIT_L(0); PG8_MMA(0, 0, At, B0); PG8_BAR; PG8_SCHED;
            PG8_LDB(B1, 1, 1); PG8_STAGE(PG8_SB(1, 0), b3, voffB);
            PG8_BAR; PG8_WAIT_L(0); PG8_MMA(0, 1, At, B1); PG8_BAR;
            PG8_LDA(At, 1, 1); PG8_STAGE(PG8_SA(1, 0), a3, voffA);
            PG8_BAR; PG8_WAIT_L(0); PG8_MMA(1, 0, At, B0); PG8_BAR; PG8_SCHED;
            PG8_STAGE(PG8_SB(1, 1), b3 + hstepB, voffB);
            PG8_WAIT_V(6); PG8_BAR; PG8_MMA(1, 1, At, B1); PG8_BAR;
            }
        }
        if constexpr (ALIGN_EPI) { if (wr == 0) PG8_BAR; }
        if constexpr (!Epi::AFTER_DRAIN) { E(acc, cur, wr, wc, fr, fq); S.done(cur); }
        if (!has_next) break;
#pragma unroll
        for (int a = 0; a < 2; ++a)
#pragma unroll
            for (int b = 0; b < 2; ++b)
#pragma unroll
                for (int m = 0; m < 4; ++m)
#pragma unroll
                    for (int n = 0; n < 2; ++n) acc[a][b][m][n] = (f32x4){0.f, 0.f, 0.f, 0.f};
        cur = nxt; cA = nA; cB = nB; ++ui;
        if constexpr (ALIGN_EPI) { if (wr == 1) PG8_BAR; }
    }
    PG8_WAIT_V(0);
    if constexpr (!ALIGN_EPI) { if (wr == 0) PG8_BAR; }
    PG8_BAR;
    if constexpr (Epi::AFTER_DRAIN) { E.fused(acc, cur, wr, wc, fr, fq, lds, wid, lane); S.done(cur); }
#undef PG8_SA
#undef PG8_SB
#undef PG8_STAGE
#undef PG8_LDA
#undef PG8_LDB
#undef PG8_MMA
#undef PG8_WAIT_V
#undef PG8_WAIT_L
#undef PG8_BAR
#undef PG8_SCHED
}
}

#ifndef PG8_SP2
#define PG8_SP2 true
#endif
#ifndef PG8_ALIGN
#define PG8_ALIGN true
#endif
constexpr int NWAVES = 8;
constexpr int D = 1024, BATCH = 4, SEQ = 8192, DEPTH = 2;
constexpr int M = BATCH * SEQ;
constexpr int NIN = 1792, FF = 4096;
constexpr int ZQ = 0, ZK = 512, ZV = 640, ZCV = 768, ZCG = 1024, ZRX = 1280, ZRG = 1536;
constexpr float RMS_EPS = 1e-6f, LN_EPS = 1e-5f;
constexpr size_t MiB = 1u << 20;
constexpr size_t WS_CTL = 0, CTL_ZERO_BYTES = 160 * 1024;
constexpr size_t WS_WFRAG = 1 * MiB; constexpr int WFRAG_LAYER = 64 * 512;
constexpr size_t WS_W = 2 * MiB, W_LAYER = 22 * MiB, W_IN = 0, W_OUT = 4 * MiB, W_UP = 6 * MiB, W_DOWN = 14 * MiB;
constexpr size_t WS_SSP = 46 * MiB;
constexpr int HB_LD = D + 64;
constexpr size_t WS_HB = 386 * MiB;
constexpr size_t WS_Z = 112 * MiB;
constexpr size_t WS_YMIX = 224 * MiB;
constexpr size_t WS_HH = 112 * MiB;


constexpr size_t WS_SSP2 = 368 * MiB;
constexpr size_t WS_UBUF = 370 * MiB;
constexpr size_t WS_END = 458 * MiB;
constexpr int CW_FIN = 18432;
constexpr int CW_BAR = 4096;
constexpr int RING_OFF = 0, RING_BYTES = 131072;
constexpr int LDSCTL_OFF = RING_BYTES, MISC_OFF = LDSCTL_OFF + 320;
static_assert((CW_FIN + 256 * 64) * 4 <= (int)CTL_ZERO_BYTES && (CW_BAR + 4 * 3456) <= CW_FIN, "control words inside the memset region");
constexpr int LDS_BYTES = 163840;
#define GAS __attribute__((address_space(1)))
#define LAS __attribute__((address_space(3)))
typedef unsigned short bf16;
typedef unsigned v4u __attribute__((ext_vector_type(4)));
typedef float f32x4 __attribute__((ext_vector_type(4)));
typedef short bf16x8 __attribute__((ext_vector_type(8)));
typedef GAS unsigned gu32;
typedef GAS unsigned long long gu64;
#define RLX_AGENT __ATOMIC_RELAXED, __HIP_MEMORY_SCOPE_AGENT
#define LDS_WAIT() asm volatile("s_waitcnt lgkmcnt(0)" ::: "memory")
#define VM_WAIT() asm volatile("s_waitcnt vmcnt(0)" ::: "memory")
__device__ __forceinline__ unsigned long long rt() { return __builtin_amdgcn_s_memrealtime(); }
__device__ __forceinline__ unsigned f2bf(float f) { unsigned u = __builtin_bit_cast(unsigned, f); return (u + 0x7fffu + ((u >> 16) & 1u)) >> 16; }
__device__ __forceinline__ unsigned pk2(float lo, float hi) { return f2bf(lo) | (f2bf(hi) << 16); }
#define XB_TMO      128
#define XB_XCNT(j)  (256  + 64 * (j))
#define XB_XSUB(j)  (1280 + 64 * (j))
#define XB_XGEN(j)  (2304 + 64 * (j))
#define XB_TOP      3328
#define XB_TOPGEN   3392
#define XCD_BAR_WORDS 3456
#define XB_SPIN_CAP (1u << 18)

__device__ __forceinline__ unsigned xb_ld(unsigned* p)              { return __hip_atomic_load(p, __ATOMIC_RELAXED, __HIP_MEMORY_SCOPE_AGENT); }
__device__ __forceinline__ unsigned xb_add(unsigned* p, unsigned v) { return __hip_atomic_fetch_add(p, v, __ATOMIC_RELAXED, __HIP_MEMORY_SCOPE_AGENT); }
__device__ __forceinline__ unsigned xb_xcc_id() { return (unsigned)__builtin_amdgcn_s_getreg((3 << 11) | 20) & 0xFu; }
#define XB_SPIN(cond, bar) do { unsigned _sp = 0; while (cond) { __builtin_amdgcn_s_sleep(1); \
    if ((++_sp & 255u) == 0u) { if (xb_ld(&(bar)[XB_TMO])) break; if (_sp > XB_SPIN_CAP) { atomicAdd(&(bar)[XB_TMO], 1u); break; } } } } while (0)

struct XcdBarrier {
    unsigned* bar; unsigned x;
    volatile LAS unsigned* st;
};

__device__ __forceinline__ XcdBarrier xcd_barrier_post(unsigned* bar, volatile LAS unsigned* st) {
    XcdBarrier b; b.bar = bar; b.x = xb_xcc_id(); b.st = st;
    if (threadIdx.x == 0) (void)xb_add(&bar[XB_XCNT(b.x)], 1u);
    return b;
}
__device__ __forceinline__ void xcd_barrier_complete(unsigned* bar, unsigned x, unsigned& nloc, unsigned& nx) {
    const unsigned G = gridDim.x * gridDim.y * gridDim.z;
    unsigned sum, cnt, mine, sp = 0u;
    for (;;) {
        sum = 0u; cnt = 0u; mine = 0u;
#pragma unroll
        for (unsigned j = 0; j < 16; ++j) { const unsigned c = xb_ld(&bar[XB_XCNT(j)]); sum += c; cnt += (c > 0u) ? 1u : 0u; mine = (j == x) ? c : mine; }
        if (sum == G) break;
        __builtin_amdgcn_s_sleep(1);
        if ((++sp & 255u) == 0u) { if (xb_ld(&bar[XB_TMO])) break; if (sp > XB_SPIN_CAP) { atomicAdd(&bar[XB_TMO], 1u); break; } }
    }
    nloc = mine > 0u ? mine : 1u; nx = cnt > 0u ? cnt : 1u;
}

__device__ __forceinline__ void xcd_barrier(const XcdBarrier& b) {
    asm volatile("s_waitcnt vmcnt(0)" ::: "memory");
    __syncthreads();
    if (threadIdx.x == 0) {
        unsigned* bar = b.bar;
        __builtin_amdgcn_s_waitcnt(0);
        unsigned nloc = b.st[0], nx = b.st[1]; const unsigned kbar = b.st[2]; b.st[2] = kbar + 1u;
        if (nloc == 0u) { xcd_barrier_complete(bar, b.x, nloc, nx); b.st[0] = nloc; b.st[1] = nx; }
        const unsigned old = xb_add(&bar[XB_XSUB(b.x)], 1u);
        const unsigned gen = old / nloc;
        if (old + 1u == (gen + 1u) * nloc) {
            __builtin_amdgcn_fence(__ATOMIC_RELEASE, "agent");
            asm volatile("s_waitcnt vmcnt(0)" ::: "memory");
            __hip_atomic_fetch_add(&bar[XB_TOP], 1u, __ATOMIC_RELAXED, __HIP_MEMORY_SCOPE_AGENT);
            __builtin_amdgcn_fence(__ATOMIC_ACQUIRE, "agent");
            XB_SPIN(xb_ld(&bar[XB_TOP]) < (kbar + 1u) * nx, bar);
            asm volatile("s_waitcnt vmcnt(0)" ::: "memory");
        } else {
            __builtin_amdgcn_fence(__ATOMIC_ACQUIRE, "agent");
            XB_SPIN(xb_ld(&bar[XB_TOP]) < (kbar + 1u) * nx, bar);
            asm volatile("s_waitcnt vmcnt(0)" ::: "memory");
        }
    }
    __syncthreads();
}

template <int CTRL> __device__ __forceinline__ float dppmov(float v) { return __builtin_bit_cast(float, __builtin_amdgcn_update_dpp(0, __builtin_bit_cast(int, v), CTRL, 0xf, 0xf, true)); }
__device__ __forceinline__ float wave_sum(float v) {
    v += dppmov<0xB1>(v); v += dppmov<0x4E>(v); v += dppmov<0x141>(v); v += dppmov<0x140>(v);
    return (__builtin_bit_cast(float, __builtin_amdgcn_readlane(__builtin_bit_cast(int, v), 0)) + __builtin_bit_cast(float, __builtin_amdgcn_readlane(__builtin_bit_cast(int, v), 16)))
         + (__builtin_bit_cast(float, __builtin_amdgcn_readlane(__builtin_bit_cast(int, v), 32)) + __builtin_bit_cast(float, __builtin_amdgcn_readlane(__builtin_bit_cast(int, v), 48)));
}
__device__ __forceinline__ float bf2f(unsigned short b) { return __builtin_bit_cast(float, (unsigned)b << 16); }
__device__ __forceinline__ float sigmoidf_(float x) { return __builtin_amdgcn_rcpf(1.f + __builtin_amdgcn_exp2f(-1.4426950408889634f * x)); }

namespace mix {
typedef short bf16x8 __attribute__((ext_vector_type(8)));
typedef short s16x4 __attribute__((ext_vector_type(4)));
typedef float f32x16 __attribute__((ext_vector_type(16)));
typedef float f32x2 __attribute__((ext_vector_type(2)));
typedef unsigned u32x2 __attribute__((ext_vector_type(2)));
constexpr float LOG2E = 1.4426950408889634f;
constexpr float QSCALE = 0.125f * LOG2E;
constexpr int ATT_K = 0, ATT_V = 65536;
constexpr int XCH_OFF = RING_BYTES + 1024;
constexpr size_t WS_AGG = 288 * MiB;
constexpr int NUNIT = BATCH * 64;
constexpr int SUB0_OFF = XCH_OFF + 2048;
constexpr int CWT_OFF = XCH_OFF + 4096;
constexpr int SEG_OFF = XCH_OFF + 12288;
static_assert(SEG_OFF + 16384 <= LDS_BYTES, "LDS exchange tables");

__device__ __forceinline__ int crow(int r, int hi) { return (r & 3) + 8 * (r >> 2) + 4 * hi; }
__device__ __forceinline__ float xhalf_max(float v) { auto rr = __builtin_amdgcn_permlane32_swap(__float_as_uint(v), __float_as_uint(v), false, false); return fmaxf(__uint_as_float(rr[0]), __uint_as_float(rr[1])); }
__device__ __forceinline__ float xhalf_sum(float v) { auto rr = __builtin_amdgcn_permlane32_swap(__float_as_uint(v), __float_as_uint(v), false, false); return __uint_as_float(rr[0]) + __uint_as_float(rr[1]); }
__device__ __forceinline__ float xhalf_other(float v) { auto rr = __builtin_amdgcn_permlane32_swap(__float_as_uint(v), __float_as_uint(v), false, false); return (threadIdx.x & 32) ? __uint_as_float(rr[0]) : __uint_as_float(rr[1]); }
__device__ __forceinline__ s16x4 vtr(const LAS unsigned char* p) { typedef short v4i16_t __attribute__((ext_vector_type(4))); return __builtin_bit_cast(s16x4, __builtin_amdgcn_ds_read_tr16_b64_v4i16((LAS v4i16_t*)p)); }
__device__ __forceinline__ unsigned cvtpk(float lo, float hi) { typedef __bf16 bf16x2_t __attribute__((ext_vector_type(2))); f32x2 v = {lo, hi}; bf16x2_t b = __builtin_convertvector(v, bf16x2_t); return __builtin_bit_cast(unsigned, b); }
__device__ __forceinline__ void fmac_s(float& acc, float a, float b) { asm("v_fmac_f32_e32 %0, %1, %2" : "+v"(acc) : "v"(a), "v"(b)); }
__device__ __forceinline__ float bflo(unsigned w) { return __builtin_bit_cast(float, w << 16); }
__device__ __forceinline__ float bfhi(unsigned w) { return __builtin_bit_cast(float, w & 0xffff0000u); }

__device__ __forceinline__ void attn_unit(LAS unsigned char* lds, const bf16* z, bf16* ymix, const float* sinks, int b, int n, int tid) {
    asm volatile("" : "+v"(tid));
    const int lane = tid & 63, wid = __builtin_amdgcn_readfirstlane(tid >> 6), r32 = lane & 31, hi = lane >> 5;
    const size_t row0 = (size_t)b * SEQ + (size_t)n * 128;
    const int hq = wid, hkv = wid >> 2;
    bf16x8 qr[4];
#pragma unroll
    for (int d0 = 0; d0 < 4; ++d0) qr[d0] = *(const GAS bf16x8*)(z + (row0 + r32) * NIN + ZQ + hq * 64 + 16 * d0 + 8 * hi);
#ifndef AREP_STAGE
#define AREP_STAGE 1
#define AREP_LOOP 1
#endif
    for (int arep_ = 0; arep_ < AREP_STAGE; ++arep_) {
    if (arep_) __syncthreads();
#pragma unroll
    for (int half = 0; half < 2; ++half) {
        v4u v[8];
        const bool have = (half == 1) || (n > 0);
#pragma unroll
        for (int i = 0; i < 8; ++i) { const int pi = (half * 8 + i) * 512 + tid, token = pi >> 5, c32 = pi & 31;
            if (have) v[i] = *(const GAS v4u*)(z + (row0 + token - 128) * NIN + ZK + 8 * c32); else v[i] = (v4u){0u, 0u, 0u, 0u}; }
#pragma unroll
        for (int i = 0; i < 8; ++i) { const int pi = (half * 8 + i) * 512 + tid, token = pi >> 5, c32 = pi & 31, kind = c32 >> 3, c = c32 & 7;
            const int dst = (kind < 2) ? (ATT_K + (kind & 1) * 32768 + token * 128 + ((c ^ ((token >> 1) & 7)) << 4))
                                       : (ATT_V + (kind & 1) * 32768 + (c >> 2) * 16384 + token * 64 + (c & 3) * 16);
            *(LAS v4u*)(lds + dst) = v[i]; }
    }
    }
    __syncthreads();
    const float sink2 = sinks[hq] * LOG2E;
    const LAS unsigned char* Kb = lds + ATT_K + hkv * 32768;
    const LAS unsigned char* Vb = lds + ATT_V + hkv * 32768 + ((lane >> 4) & 1) * 32 + (lane & 3) * 8 + (4 * hi + ((lane & 15) >> 2)) * 64;
    int koff[4];
#pragma unroll
    for (int d0 = 0; d0 < 4; ++d0) koff[d0] = r32 * 128 + (((2 * d0 + hi) ^ ((r32 >> 1) & 7)) << 4);
    LAS float* part = (LAS float*)(lds + XCH_OFF);
    const float NEG = -INFINITY;
    f32x16 mask0, mask4;
#pragma unroll
    for (int r = 0; r < 16; ++r) { const int cr = crow(r, hi); mask0[r] = (cr > r32) ? 0.f : NEG; mask4[r] = (cr <= r32) ? 0.f : NEG; }
    bf16x8 ones;
#pragma unroll
    for (int e = 0; e < 8; ++e) ones[e] = (short)0x3F80;
#pragma unroll 1
    for (int i4_ = 0; i4_ < 4 * AREP_LOOP; ++i4_) { const int i = i4_ & 3;
        const size_t qrow = row0 + 32 * i + r32;
        bf16x8 qn[4];
        { const size_t qnrow = row0 + 32 * ((i4_ + 1) & 3) + r32;
#pragma unroll
          for (int d0 = 0; d0 < 4; ++d0) qn[d0] = *(const GAS bf16x8*)(z + qnrow * NIN + ZQ + hq * 64 + 16 * d0 + 8 * hi); }
        const LAS unsigned char* kbi = Kb + 4096 * i;
        const LAS unsigned char* vbi = Vb + 2048 * i;
        f32x16 s[5];
#pragma unroll
        for (int kt = 0; kt < 5; ++kt) { s[kt] = kt == 0 ? mask0 : kt == 4 ? mask4 : (f32x16){};
#pragma unroll
            for (int d0 = 0; d0 < 4; ++d0) { const bf16x8 kf = *(const LAS bf16x8*)(kbi + 4096 * kt + koff[d0]); s[kt] = __builtin_amdgcn_mfma_f32_32x32x16_bf16(kf, qr[d0], s[kt], 0, 0, 0); } }
        if (n == 0) {
#pragma unroll
            for (int kt = 0; kt < 4; ++kt) if (i + kt < 4) {
#pragma unroll
                for (int r = 0; r < 16; ++r) s[kt][r] = NEG; } }
        float m = sink2;
#pragma unroll
        for (int kt = 0; kt < 5; ++kt)
#pragma unroll
            for (int r = 0; r < 16; r += 2) m = fmaxf(fmaxf(m, s[kt][r]), s[kt][r + 1]);
        m = xhalf_max(m);
#pragma unroll
        for (int kt = 0; kt < 5; ++kt)
#pragma unroll
            for (int r = 0; r < 16; ++r) s[kt][r] = __builtin_amdgcn_exp2f(s[kt][r] - m);
        f32x16 o[2], ls; o[0] = (f32x16){}; o[1] = (f32x16){}; ls = (f32x16){};
#pragma unroll
        for (int kt = 0; kt < 5; ++kt)
#pragma unroll
            for (int s2 = 0; s2 < 2; ++s2) {
                v4u pw; pw.x = cvtpk(s[kt][8 * s2 + 0], s[kt][8 * s2 + 1]); pw.y = cvtpk(s[kt][8 * s2 + 2], s[kt][8 * s2 + 3]); pw.z = cvtpk(s[kt][8 * s2 + 4], s[kt][8 * s2 + 5]); pw.w = cvtpk(s[kt][8 * s2 + 6], s[kt][8 * s2 + 7]);
                const bf16x8 pf = __builtin_bit_cast(bf16x8, pw);
#pragma unroll
                for (int blk = 0; blk < 2; ++blk) {
                    const s16x4 lo = vtr(vbi + (blk * 16384 + 2048 * kt + 1024 * s2)), hi4 = vtr(vbi + (blk * 16384 + 2048 * kt + 1024 * s2 + 512));
                    const bf16x8 vf = (bf16x8){lo[0], lo[1], lo[2], lo[3], hi4[0], hi4[1], hi4[2], hi4[3]};
                    o[blk] = __builtin_amdgcn_mfma_f32_32x32x16_bf16(vf, pf, o[blk], 0, 0, 0); }
                ls = __builtin_amdgcn_mfma_f32_32x32x16_bf16(ones, pf, ls, 0, 0, 0);
            }
        const float inv = __builtin_amdgcn_rcpf(ls[0] + __builtin_amdgcn_exp2f(sink2 - m)); float ss = 0.f;
#pragma unroll
        for (int blk = 0; blk < 2; ++blk)
#pragma unroll
            for (int r = 0; r < 16; ++r) ss = fmaf(o[blk][r], o[blk][r], ss);
        ss = xhalf_sum(ss) * (inv * inv);
        LAS float* pp = part + (i4_ & 1) * 256;
        if (hi == 0) pp[wid * 32 + r32] = ss;
        __syncthreads();
        float tot = 0.f;
#pragma unroll
        for (int w = 0; w < 8; ++w) tot += pp[w * 32 + r32];
        const float rs = __builtin_amdgcn_rsqf(tot * (1.0f / 512.0f) + RMS_EPS) * inv;
        bf16* orow = ymix + qrow * D + hq * 64 + 8 * hi;
#pragma unroll
        for (int blk = 0; blk < 2; ++blk)
#pragma unroll
            for (int gp = 0; gp < 2; ++gp) { const int ge = 2 * gp, go = 2 * gp + 1;
                const unsigned ex = cvtpk(o[blk][4 * ge] * rs, o[blk][4 * ge + 1] * rs), ey = cvtpk(o[blk][4 * ge + 2] * rs, o[blk][4 * ge + 3] * rs);
                const unsigned ox = cvtpk(o[blk][4 * go] * rs, o[blk][4 * go + 1] * rs), oy = cvtpk(o[blk][4 * go + 2] * rs, o[blk][4 * go + 3] * rs);
                auto sx = __builtin_amdgcn_permlane32_swap(ex, ox, false, false); auto sy = __builtin_amdgcn_permlane32_swap(ey, oy, false, false);
                v4u w; w.x = sx[0]; w.y = sy[0]; w.z = sx[1]; w.w = sy[1];
                *(GAS v4u*)(orow + 32 * blk + 16 * gp) = w; }
#pragma unroll
        for (int d0 = 0; d0 < 4; ++d0) qr[d0] = qn[d0];
    }
    __syncthreads();
}

__device__ __forceinline__ void conv_unit(LAS unsigned char* lds, const bf16* ub, bf16* ymix, const float* dw_w, const float* dw_b, const float* ln_g, const float* ln_b, int b, int n, int tid) {
    asm volatile("" : "+v"(tid));
    const int lane = tid & 63, wid = __builtin_amdgcn_readfirstlane(tid >> 6);
    LAS float* U = (LAS float*)lds;
    const int cp = tid & 127, tg = tid >> 7;
    f32x2 w[31];
#pragma unroll
    for (int k = 0; k < 31; ++k) w[k] = *(const GAS f32x2*)(dw_w + k * 256 + 2 * cp);
    const f32x2 bias = *(const GAS f32x2*)(dw_b + 2 * cp);
    const f32x4 lg = *(const GAS f32x4*)(ln_g + 4 * lane), lb = *(const GAS f32x4*)(ln_b + 4 * lane);
#pragma unroll 1
    for (int half = 0; half < 2; ++half) {
        const int t0 = n * 128 + half * 64;
        const size_t rowb = (size_t)b * SEQ;
        {
            v4u vv[6];
#pragma unroll
            for (int j = 0; j < 6; ++j) { const int task = tid + 512 * j, r = task >> 5, c8 = task & 31, tt = t0 - 30 + r;
                if (task < 94 * 32 && tt >= 0) vv[j] = *(const GAS v4u*)(ub + (rowb + tt) * 256 + 8 * c8); else vv[j] = (v4u){0u, 0u, 0u, 0u}; }
#pragma unroll
            for (int j = 0; j < 6; ++j) { const int task = tid + 512 * j, r = task >> 5, c8 = task & 31;
                if (task < 94 * 32) { const f32x4 u0 = (f32x4){bflo(vv[j].x), bfhi(vv[j].x), bflo(vv[j].y), bfhi(vv[j].y)}, u1 = (f32x4){bflo(vv[j].z), bfhi(vv[j].z), bflo(vv[j].w), bfhi(vv[j].w)};
                    *(LAS f32x4*)(U + r * 256 + 8 * c8) = u0; *(LAS f32x4*)(U + r * 256 + 8 * c8 + 4) = u1; } }
        }
        __syncthreads();
        float acc0[2][8], acc1[2][8];
#pragma unroll
        for (int g = 0; g < 2; ++g) {
            const LAS float* up = U + (tg * 16 + g * 8) * 256 + 2 * cp;
#pragma unroll
            for (int jj = 0; jj < 8; ++jj) { acc0[g][jj] = bias[0]; acc1[g][jj] = bias[1]; }
#pragma unroll
            for (int rr = 0; rr < 38; ++rr) { const f32x2 u2 = *(const LAS f32x2*)(up + rr * 256);
#pragma unroll
                for (int jj = 0; jj < 8; ++jj) { const int k = rr - jj; if (k >= 0 && k <= 30) { fmac_s(acc0[g][jj], w[k][0], u2[0]); fmac_s(acc1[g][jj], w[k][1], u2[1]); } } }
        }
        __syncthreads();
#pragma unroll
        for (int g = 0; g < 2; ++g)
#pragma unroll
            for (int jj = 0; jj < 8; ++jj) *(LAS f32x2*)(U + (tg * 16 + g * 8 + jj) * 256 + 2 * cp) = (f32x2){acc0[g][jj], acc1[g][jj]};
        __syncthreads();
#pragma unroll
        for (int jj = 0; jj < 8; ++jj) { const int tok = wid * 8 + jj;
            f32x4 x = *(const LAS f32x4*)(U + tok * 256 + 4 * lane);
            const float mu = wave_sum((x[0] + x[1]) + (x[2] + x[3])) * (1.f / 256.f);
            x = x - mu;
            const float var = wave_sum((x[0] * x[0] + x[1] * x[1]) + (x[2] * x[2] + x[3] * x[3])) * (1.f / 256.f);
            const float rstd = __builtin_amdgcn_rsqf(var + LN_EPS);
            f32x4 y = x * rstd * lg + lb;
#pragma unroll
            for (int e = 0; e < 4; ++e) y[e] = y[e] * sigmoidf_(y[e]);
            const float ss = wave_sum((y[0] * y[0] + y[1] * y[1]) + (y[2] * y[2] + y[3] * y[3]));
            const float rs = __builtin_amdgcn_rsqf(ss * (1.f / 256.f) + RMS_EPS);
            u32x2 o; o.x = cvtpk(y[0] * rs, y[1] * rs); o.y = cvtpk(y[2] * rs, y[3] * rs);
            *(GAS u32x2*)(ymix + (rowb + t0 + tok) * D + 512 + 4 * lane) = o; }
        __syncthreads();
    }
}

struct LruState { f32x16 H[2][2]; };
__device__ __forceinline__ bf16x8 ident_frag(int s, int hi, int col) {
    bf16x8 f;
#pragma unroll
    for (int e = 0; e < 8; ++e) f[e] = (16 * s + 8 * hi + e == col) ? (short)0x3F80 : (short)0;
    return f;
}
__device__ __forceinline__ void lru_tables(LAS unsigned char* lds, const float* cw, const float* cb, const float* ba, const float* bx, const float* lam, int tid) {
    LAS float* cwt = (LAS float*)(lds + CWT_OFF);
    for (int e = tid; e < 1024; e += 512) cwt[e] = cw[e];
    if (tid < 256) { cwt[1024 + tid] = cb[tid]; cwt[1280 + tid] = ba[tid]; }
    else { const int c = tid - 256; cwt[1536 + c] = bx[c]; const float lm = -lam[c]; cwt[1792 + c] = fmaxf(lm, 0.f) + log1pf(__expf(-fabsf(lm))); }
}
__device__ __forceinline__ int pidx(int token, int ch) { return token * 256 + (ch ^ ((token & 7) << 2)); }
__device__ __forceinline__ void lru_local(LruState& st, const bf16* z, const bf16* wfrag, float* agg, LAS unsigned char* lds, int b, int n, int tid) {
    asm volatile("" : "+v"(tid));
    const int lane = tid & 63, wid = __builtin_amdgcn_readfirstlane(tid >> 6), r32 = lane & 31, hi = lane >> 5, hd = wid >> 1, th = wid & 1;
    float fin[2][2];
    LAS float* PL = (LAS float*)lds;
    const LAS float* cwt = (const LAS float*)(lds + CWT_OFF);
    const size_t row_w = (size_t)b * SEQ + (size_t)n * 128 + th * 64;
    const int tseq_w = n * 128 + th * 64;
    v4u xv[4][4];
#define LRU_LOAD_ROWS(tm) do { const int tseq_ = tseq_w + 32 * (tm) + r32; _Pragma("unroll") for (int s = 0; s < 4; ++s) { const bf16* zp = z + (row_w + 32 * (tm) + r32) * NIN + ZRX + hd * 64 + 16 * s + 8 * hi; \
        _Pragma("unroll") for (int k = 0; k < 4; ++k) xv[s][k] = *(const GAS v4u*)(zp - (ptrdiff_t)(tseq_ >= 3 - k ? 3 - k : 0) * NIN); } } while (0)
#define LRU_BUILD_XF(tm) do { const int tseq_ = tseq_w + 32 * (tm) + r32, tok_ = th * 64 + 32 * (tm) + r32; _Pragma("unroll") for (int s = 0; s < 4; ++s) { const int ch = hd * 64 + 16 * s + 8 * hi; \
            f32x4 a0 = *(const LAS f32x4*)(cwt + 1024 + ch), a1 = *(const LAS f32x4*)(cwt + 1024 + ch + 4); \
            _Pragma("unroll") for (int k = 0; k < 4; ++k) { const float mk = tseq_ >= 3 - k ? 1.f : 0.f; \
                const f32x4 w0 = *(const LAS f32x4*)(cwt + k * 256 + ch), w1 = *(const LAS f32x4*)(cwt + k * 256 + ch + 4); \
                const v4u x = xv[s][k]; \
                a0[0] += w0[0] * (mk * bflo(x.x)); a0[1] += w0[1] * (mk * bfhi(x.x)); a0[2] += w0[2] * (mk * bflo(x.y)); a0[3] += w0[3] * (mk * bfhi(x.y)); \
                a1[0] += w1[0] * (mk * bflo(x.z)); a1[1] += w1[1] * (mk * bfhi(x.z)); a1[2] += w1[2] * (mk * bflo(x.w)); a1[3] += w1[3] * (mk * bfhi(x.w)); } \
            v4u pw; pw.x = cvtpk(a0[0], a0[1]); pw.y = cvtpk(a0[2], a0[3]); pw.z = cvtpk(a1[0], a1[1]); pw.w = cvtpk(a1[2], a1[3]); \
            xf[tm][s] = __builtin_bit_cast(bf16x8, pw); \
            *(LAS f32x4*)(PL + pidx(tok_, ch)) = a0; *(LAS f32x4*)(PL + pidx(tok_, ch + 4)) = a1; } \
        asm volatile("s_waitcnt lgkmcnt(0)" ::: "memory"); } while (0)
    LRU_LOAD_ROWS(0);
    bf16x8 waf[4], wxf[4];
#pragma unroll
    for (int s = 0; s < 4; ++s) { waf[s] = *(const GAS bf16x8*)(wfrag + ((size_t)((0 * 4 + hd) * 2 + 0) * 4 + s) * 512 + lane * 8); wxf[s] = *(const GAS bf16x8*)(wfrag + ((size_t)((1 * 4 + hd) * 2 + 0) * 4 + s) * 512 + lane * 8); }
    bf16x8 xf[2][4];
    LRU_BUILD_XF(0);
    LRU_LOAD_ROWS(1);
#pragma unroll
    for (int tn = 0; tn < 2; ++tn) {
        const int c = hd * 64 + 32 * tn + r32;
        const float bav = cwt[1280 + c], bxv = cwt[1536 + c], sp = cwt[1792 + c];
        int cx[4];
#pragma unroll
        for (int e = 0; e < 4; ++e) cx[e] = c ^ ((4 * hi + e) << 2);
        bf16x8 waf2[4], wxf2[4];
        float CA = 1.f, CB = 0.f;
#pragma unroll
        for (int tm = 0; tm < 2; ++tm) {
            __builtin_amdgcn_sched_barrier(0);
            if (tn == 0 && tm == 1) { LRU_BUILD_XF(1);
#pragma unroll
                for (int s = 0; s < 4; ++s) { waf2[s] = *(const GAS bf16x8*)(wfrag + ((size_t)((0 * 4 + hd) * 2 + 1) * 4 + s) * 512 + lane * 8); wxf2[s] = *(const GAS bf16x8*)(wfrag + ((size_t)((1 * 4 + hd) * 2 + 1) * 4 + s) * 512 + lane * 8); }
                __builtin_amdgcn_sched_barrier(0); }
            f32x16 ra = (f32x16){}, ia = (f32x16){};
#pragma unroll
            for (int s = 0; s < 4; ++s) { ra = __builtin_amdgcn_mfma_f32_32x32x16_bf16(xf[tm][s], waf[s], ra, 0, 0, 0); ia = __builtin_amdgcn_mfma_f32_32x32x16_bf16(xf[tm][s], wxf[s], ia, 0, 0, 0); }
            LAS float* pl = PL + (th * 64 + 32 * tm + 4 * hi) * 256;
#pragma unroll
            for (int r = 0; r < 16; ++r) { const float rg = sigmoidf_(ra[r] + bav), ig = sigmoidf_(ia[r] + bxv);
                const float a = __builtin_amdgcn_exp2f((-8.f * LOG2E) * rg * sp);
                ra[r] = a;
                ia[r] = __builtin_amdgcn_sqrtf(fmaf(-a, a, 1.f)) * (ig * pl[((r & 3) + 8 * (r >> 2)) * 256 + cx[r & 3]]); }
#pragma unroll
            for (int g = 0; g < 4; ++g)
#pragma unroll
                for (int e = 1; e < 4; ++e) { ia[4 * g + e] = ra[4 * g + e] * ia[4 * g + e - 1] + ia[4 * g + e]; ra[4 * g + e] = ra[4 * g + e] * ra[4 * g + e - 1]; }
#pragma unroll
            for (int g = 0; g < 4; ++g) {
                const float ownA = ra[4 * g + 3], ownB = ia[4 * g + 3];
                const float othA = xhalf_other(ownA), othB = xhalf_other(ownB);
                float EA = 0.f, EB = 0.f;
                { const float A = hi ? othA : ownA, B = hi ? othB : ownB; if (!hi) { EA = CA; EB = CB; } CB = A * CB + B; CA = A * CA; }
                { const float A = hi ? ownA : othA, B = hi ? ownB : othB; if (hi) { EA = CA; EB = CB; } CB = A * CB + B; CA = A * CA; }
#pragma unroll
                for (int e = 0; e < 4; ++e) { ia[4 * g + e] += ra[4 * g + e] * EB; pl[(e + 8 * g) * 256 + cx[e]] = ra[4 * g + e] * EA; }
            }
            st.H[tm][tn] = ia;
        }
        fin[tn][0] = CA; fin[tn][1] = CB;
        if (tn == 0) {
#pragma unroll
            for (int s = 0; s < 4; ++s) { waf[s] = waf2[s]; wxf[s] = wxf2[s]; } }
    }
#undef LRU_LOAD_ROWS
#undef LRU_BUILD_XF
    LAS f32x2* sub0 = (LAS f32x2*)(lds + SUB0_OFF);
    if (th == 0 && hi == 0) {
#pragma unroll
        for (int tn = 0; tn < 2; ++tn) sub0[(hd * 2 + tn) * 32 + r32] = (f32x2){fin[tn][0], fin[tn][1]}; }
    __syncthreads();
    if (th == 1 && hi == 0) {
#pragma unroll
        for (int tn = 0; tn < 2; ++tn) { const f32x2 f0 = sub0[(hd * 2 + tn) * 32 + r32]; const int c = hd * 64 + 32 * tn + r32, unit = b * 64 + n;
            agg[(size_t)unit * 256 + c] = fin[tn][0] * f0[0]; agg[(size_t)(NUNIT + unit) * 256 + c] = fin[tn][0] * f0[1] + fin[tn][1]; } }
}
__device__ __forceinline__ float gelu_tanh(float x) { const float u = 0.7978845608028654f * (x + 0.044715f * x * x * x); const float e = __expf(2.f * u); const float th = 1.f - 2.f * __builtin_amdgcn_rcpf(e + 1.f); return 0.5f * x * (1.f + th); }
__device__ __forceinline__ void lru_final(LruState& st, LAS unsigned char* lds, const bf16* z, bf16* ymix, const float* agg, int b, int n, int tid) {
    asm volatile("" : "+v"(tid));
    const int lane = tid & 63, wid = __builtin_amdgcn_readfirstlane(tid >> 6), r32 = lane & 31, hi = lane >> 5, hd = wid >> 1, th = wid & 1;
    const size_t row_u = (size_t)b * SEQ + (size_t)n * 128, row_w = row_u + th * 64;
    LAS float* Y = (LAS float*)lds;
    LAS f32x2* seg = (LAS f32x2*)(lds + SEG_OFF);
    { f32x4 SA = (f32x4){1.f, 1.f, 1.f, 1.f}, SB = (f32x4){0.f, 0.f, 0.f, 0.f}; f32x4 ta[8], tb[8];
      const float* aA = agg + (size_t)(b * 64) * 256 + 4 * lane; const float* aB = agg + (size_t)(NUNIT + b * 64) * 256 + 4 * lane;
#pragma unroll
      for (int jj = 0; jj < 8; ++jj) { const int j = 8 * wid + jj;
          if (j < n) { ta[jj] = *(const GAS f32x4*)(aA + (size_t)j * 256); tb[jj] = *(const GAS f32x4*)(aB + (size_t)j * 256); } else { ta[jj] = (f32x4){1.f, 1.f, 1.f, 1.f}; tb[jj] = (f32x4){0.f, 0.f, 0.f, 0.f}; } }
#pragma unroll
      for (int jj = 0; jj < 8; ++jj) { SB = ta[jj] * SB + tb[jj]; SA = ta[jj] * SA; }
#pragma unroll
      for (int e = 0; e < 4; ++e) seg[wid * 256 + 4 * lane + e] = (f32x2){SA[e], SB[e]}; }
    bf16x8 gf[2][4];
#pragma unroll
    for (int tm = 0; tm < 2; ++tm)
#pragma unroll
        for (int s = 0; s < 4; ++s) gf[tm][s] = *(const GAS bf16x8*)(z + (row_w + 32 * tm + r32) * NIN + ZRG + hd * 64 + 16 * s + 8 * hi);
    __syncthreads();
#pragma unroll
    for (int tn = 0; tn < 2; ++tn) {
        const int col = 32 * tn + r32, c = hd * 64 + col;
        float carry = 0.f;
#pragma unroll
        for (int w = 0; w < 8; ++w) { const f32x2 sg = seg[w * 256 + c]; carry = sg[0] * carry + sg[1]; }
        if (th == 1) { const f32x2 f0 = ((const LAS f32x2*)(lds + SUB0_OFF))[(hd * 2 + tn) * 32 + r32]; carry = f0[0] * carry + f0[1]; }
#pragma unroll
        for (int tm = 0; tm < 2; ++tm) {
            f32x16 gd = (f32x16){};
#pragma unroll
            for (int s = 0; s < 4; ++s) gd = __builtin_amdgcn_mfma_f32_32x32x16_bf16(gf[tm][s], ident_frag(s, hi, col), gd, 0, 0, 0);
#pragma unroll
            for (int r = 0; r < 16; ++r) { LAS float* yp = Y + pidx(th * 64 + 32 * tm + crow(r, hi), c);
                const float h = st.H[tm][tn][r] + *yp * carry; *yp = h * gd[r]; }
        }
    }
    __syncthreads();
#pragma unroll
    for (int jj = 0; jj < 16; ++jj) { const int tok = wid * 16 + jj;
        const f32x4 y = *(const LAS f32x4*)(Y + pidx(tok, 4 * lane));
        const float ss = wave_sum((y[0] * y[0] + y[1] * y[1]) + (y[2] * y[2] + y[3] * y[3]));
        const float rs = __builtin_amdgcn_rsqf(ss * (1.f / 256.f) + RMS_EPS);
        u32x2 o; o.x = cvtpk(y[0] * rs, y[1] * rs); o.y = cvtpk(y[2] * rs, y[3] * rs);
        *(GAS u32x2*)(ymix + (row_u + tok) * D + 768 + 4 * lane) = o; }
    __syncthreads();
}
}

struct Frame {
    LAS unsigned char* lds;
    volatile LAS unsigned* MISC;
    gu32* ctl;
    int vcu, G;
};
__device__ __forceinline__ int otid() { int t = threadIdx.x; asm volatile("" : "+v"(t)); return t; }
struct Lw { int tid, lane, wave; __device__ __forceinline__ Lw() { tid = otid(); lane = tid & 63; wave = __builtin_amdgcn_readfirstlane(tid >> 6); } };
struct Args { const float* in[21]; float* out; unsigned char* ws; int ph_lo, ph_hi, bar_region, pad; };
typedef const __attribute__((address_space(4))) Args* ArgsP;
#define ARGS_PTR() ({ ArgsP p_ = (ArgsP)__builtin_amdgcn_kernarg_segment_ptr(); asm volatile("" : "+s"(p_)); p_; })
enum { I_X = 0, I_NORM1, I_WIN, I_SINKS, I_CDW, I_CDB, I_CLG, I_CLB, I_LCW, I_LCB, I_LWA, I_LBA, I_LWX, I_LBX, I_LAM, I_MIXN, I_WOUT, I_NORM2, I_WUP, I_WDOWN, I_FNORM };
constexpr int PH_PRO = 0, PH_L0 = 1, PH_PER_LAYER = 6, PH_FINAL = PH_L0 + DEPTH * PH_PER_LAYER, PH_N = PH_FINAL + 1;

template <bool REMAP> __device__ __forceinline__ void transpose_item(const float* W, const float* gain, int K, int N, bf16* WT, LAS float* scr, int item, int lane) {
    const int nblk = N / 32, kb = item / nblk, nb = item % nblk, k0 = 64 * kb, n0 = 32 * nb;
    int ns = n0; if (REMAP && n0 >= 768 && n0 < 1280) { const int t = n0 - 768, w = t & 255; ns = 768 + ((w >> 5) & 1) * 256 + (t >> 8) * 128 + (w >> 6) * 32; }
    f32x4 v[8]; float g[8];
#pragma unroll
    for (int i = 0; i < 8; ++i) { const int row = 8 * i + (lane >> 3); v[i] = *(const GAS f32x4*)(W + (size_t)(k0 + row) * N + ns + 4 * (lane & 7)); g[i] = gain ? gain[k0 + row] : 1.f; }
#pragma unroll
    for (int i = 0; i < 8; ++i) { const int row = 8 * i + (lane >> 3); *(LAS f32x4*)(scr + row * 36 + 4 * (lane & 7)) = v[i] * g[i]; }
    LDS_WAIT(); asm volatile("" ::: "memory");
    const int n = lane & 31, h = lane >> 5;
#pragma unroll
    for (int j = 0; j < 4; ++j) { const int kc = 2 * j + h; const LAS float* s = scr + (8 * kc) * 36 + n;
        v4u o; o.x = pk2(s[0 * 36], s[1 * 36]); o.y = pk2(s[2 * 36], s[3 * 36]); o.z = pk2(s[4 * 36], s[5 * 36]); o.w = pk2(s[6 * 36], s[7 * 36]);
        *(GAS v4u*)(WT + (size_t)(n0 + n) * K + k0 + 8 * kc) = o; }
    LDS_WAIT(); asm volatile("" ::: "memory");
}
constexpr int I_IN = (D / 64) * (NIN / 32), I_OUT = (D / 64) * (D / 32), I_UP = (D / 64) * (FF / 32), I_DN = (FF / 64) * (D / 32);
__device__ __forceinline__ void weight_item(ArgsP ap, int l, int mat, int r, LAS float* scr, int lane) {
    unsigned char* wl = ap->ws + WS_W + (size_t)l * W_LAYER;
    if (mat == 0)      transpose_item<true>(ap->in[I_WIN] + (size_t)l * D * NIN, ap->in[I_NORM1] + l * D, D, NIN, (bf16*)(wl + W_IN), scr, r, lane);
    else if (mat == 1) transpose_item<false>(ap->in[I_WOUT] + (size_t)l * D * D, ap->in[I_MIXN] + l * D, D, D, (bf16*)(wl + W_OUT), scr, r, lane);
    else if (mat == 2) transpose_item<false>(ap->in[I_WUP] + (size_t)l * D * FF, ap->in[I_NORM2] + l * D, D, FF, (bf16*)(wl + W_UP), scr, r, lane);
    else               transpose_item<false>(ap->in[I_WDOWN] + (size_t)l * FF * D, nullptr, FF, D, (bf16*)(wl + W_DOWN), scr, r, lane);
}
__device__ __forceinline__ void slack_weights(Frame& F, ArgsP ap, int l) {
    if (blockIdx.x < 128) return;
    const Lw L;
    LAS float* scr = (LAS float*)(F.lds + RING_OFF + L.wave * 16384);
    const int gw = ((int)blockIdx.x - 128) * NWAVES + L.wave, NGW = 128 * NWAVES;
    const int total = I_OUT + I_UP + I_DN + (l == 0 ? I_IN : 0);
    for (int it = gw; it < total; it += NGW) {
        int r = it;
        if (r < I_OUT) { weight_item(ap, l, 1, r, scr, L.lane); continue; } r -= I_OUT;
        if (r < I_UP) { weight_item(ap, l, 2, r, scr, L.lane); continue; } r -= I_UP;
        if (r < I_DN) { weight_item(ap, l, 3, r, scr, L.lane); continue; } r -= I_DN;
        weight_item(ap, 1, 0, r, scr, L.lane);
    }
}
__device__ __forceinline__ void rows_to_bf16_ss(int lane, const float* x, bf16* hb, float* ssp, int m0) {
    f32x4 v[4][4]; float s[4] = {0.f, 0.f, 0.f, 0.f};
#pragma unroll
    for (int q = 0; q < 4; ++q) { const GAS f32x4* xr = (const GAS f32x4*)(x + (size_t)(m0 + q) * D) + lane;
#pragma unroll
        for (int j = 0; j < 4; ++j) v[q][j] = xr[64 * j]; }
#pragma unroll
    for (int q = 0; q < 4; ++q) {
#pragma unroll
        for (int j = 0; j < 4; ++j) s[q] += (v[q][j].x * v[q][j].x + v[q][j].y * v[q][j].y) + (v[q][j].z * v[q][j].z + v[q][j].w * v[q][j].w);
        s[q] = wave_sum(s[q]);
        GAS unsigned long long* o8 = (GAS unsigned long long*)(hb + (size_t)(m0 + q) * HB_LD) + lane;
#pragma unroll
        for (int j = 0; j < 4; ++j) o8[64 * j] = (unsigned long long)pk2(v[q][j].x, v[q][j].y) | ((unsigned long long)pk2(v[q][j].z, v[q][j].w) << 32);
    }
    if (lane < 16) *(GAS f32x4*)(ssp + pg8::ssp_idx(m0, lane)) = lane == 0 ? (f32x4){s[0], s[1], s[2], s[3]} : (f32x4){0.f, 0.f, 0.f, 0.f};
}
__device__ __forceinline__ void p0_prologue(Frame& F, ArgsP ap) {
    const Lw L;
    LAS float* scr = (LAS float*)(F.lds + RING_OFF + L.wave * 16384);
    const int gw = F.vcu * NWAVES + L.wave, NGW = F.G * NWAVES;
    for (int it = gw; it < I_IN; it += NGW) weight_item(ap, 0, 0, it, scr, L.lane);
    for (int it = gw; it < DEPTH * 64; it += NGW) { const int l = it >> 6, gate = (it >> 5) & 1, hd = (it >> 3) & 3, tn = (it >> 2) & 1, s = it & 3;
        const float* W = ap->in[gate ? I_LWX : I_LWA] + (size_t)l * 4 * 64 * 64; float t[8];
#pragma unroll
        for (int e = 0; e < 8; ++e) t[e] = W[(size_t)(hd * 64 + 16 * s + 8 * (L.lane >> 5) + e) * 64 + 32 * tn + (L.lane & 31)];
        v4u o; o.x = pk2(t[0], t[1]); o.y = pk2(t[2], t[3]); o.z = pk2(t[4], t[5]); o.w = pk2(t[6], t[7]);
        *(GAS v4u*)((bf16*)(ap->ws + WS_WFRAG) + (size_t)l * WFRAG_LAYER + (size_t)(it & 63) * 512 + L.lane * 8) = o; }
    bf16* hb = (bf16*)(ap->ws + WS_HB); float* ssp = (float*)(ap->ws + WS_SSP);
    for (int m = 4 * gw; m < M; m += 4 * NGW) rows_to_bf16_ss(L.lane, ap->in[I_X], hb, ssp, m);
}

__global__ void __launch_bounds__(NWAVES * 64, 2) skel_fwd(Args args) {
    extern __shared__ __attribute__((aligned(16))) unsigned char lds[];
    Frame F;
    F.lds = (LAS unsigned char*)lds;
    F.MISC = (volatile LAS unsigned*)(F.lds + MISC_OFF);
    F.G = gridDim.x; { const int bx = blockIdx.x; F.vcu = (F.G % 8 == 0) ? (bx % 8) * (F.G / 8) + bx / 8 : bx; }
    ArgsP ap0 = ARGS_PTR();
    unsigned char* ws = ap0->ws;
    F.ctl = (gu32*)(ws + WS_CTL);
    for (int u = otid(); u < (LDS_BYTES - LDSCTL_OFF) / 4; u += NWAVES * 64) ((LAS unsigned*)(F.lds + LDSCTL_OFF))[u] = 0u;
    __syncthreads();
    XcdBarrier bar = xcd_barrier_post((unsigned*)(F.ctl + CW_BAR) + ap0->bar_region * XCD_BAR_WORDS, F.MISC + 8);
    bf16* hb = (bf16*)(ws + WS_HB); float* ssp = (float*)(ws + WS_SSP); float* ssp2 = (float*)(ws + WS_SSP2); bf16* z = (bf16*)(ws + WS_Z); bf16* ymix = (bf16*)(ws + WS_YMIX); bf16* hh = (bf16*)(ws + WS_HH);

#ifndef MKEEP
#define MKEEP(x) true
#endif
constexpr unsigned INPROJ_PNPERM = 3u | (4u << 3) | (6u << 6) | (0u << 9) | (1u << 12) | (2u << 15) | (5u << 18);
#ifndef PROBE_KLOOP_PHASE
#define PROBE_KLOOP_AGAIN(l, k) do {} while (0)
#else
#define PROBE_KLOOP_AGAIN(l, k) do { if ((l) == 0 && (k) == PROBE_KLOOP_PHASE) { xcd_barrier(bar); pg8::EpiAny E2 = E; E2.mode = 9 + (int)__hip_atomic_load(F.ctl + 8, __ATOMIC_RELAXED, __HIP_MEMORY_SCOPE_AGENT); pg8::gemm_phase<pg8::EpiAny, pg8::StaticOrder, PG8_ALIGN, PG8_SP2>(F.lds + RING_OFF, g, S, E2); } } while (0)
#endif
#ifndef DOWN_REV
#define DOWN_REV 1
#endif
#ifndef PROBE_UP_AGAIN
#define PROBE_UP_AGAIN(l) do {} while (0)
#endif
#ifndef MREP
#define MREP(x) 1
#endif
#ifndef KEEP
#define KEEP(x) true
#endif
    const int lo = ap0->ph_lo, hi = ap0->ph_hi;
#define IN(p) (lo <= (p) && (p) < hi)
#define SEAM(p) do { if (IN(p) && IN((p) + 1)) xcd_barrier(bar); } while (0)
    if (IN(PH_PRO)) { p0_prologue(F, ARGS_PTR()); SEAM(PH_PRO); }
#define LAYER_BODY(l) do { \
        const int p = PH_L0 + l * PH_PER_LAYER; \
        unsigned char* wl = ws + WS_W + (size_t)l * W_LAYER; \
        if (IN(p) && KEEP(0)) { \
            pg8::Gemm g{hb, (const bf16*)(wl + W_IN), M, NIN, D, 1, HB_LD}; pg8::StaticOrder S; S.init(M, NIN, F.G, (int)blockIdx.x); S.pnperm = INPROJ_PNPERM; \
            const LAS float* rs_tab = (const LAS float*)(F.lds + mix::XCH_OFF); \
            { LAS float* tab = (LAS float*)(F.lds + mix::XCH_OFF); pg8::Unit u_; const int t_ = otid(); const int r_ = t_ >> 1, hf_ = t_ & 1; \
              f32x4 a_[4], b_[4]; bool ok_[4]; \
              _Pragma("unroll") for (int i_ = 0; i_ < 4; ++i_) { ok_[i_] = S.next(i_, u_); a_[i_] = (f32x4){0.f, 0.f, 0.f, 0.f}; b_[i_] = a_[i_]; \
                  if (ok_[i_]) { const float* p_ = ssp + pg8::ssp_idx(u_.pm * 256 + r_, 8 * hf_); _Pragma("unroll") for (int e_ = 0; e_ < 4; ++e_) { a_[i_][e_] = p_[16 * e_]; b_[i_][e_] = p_[16 * (4 + e_)]; } } } \
              _Pragma("unroll") for (int i_ = 0; i_ < 4; ++i_) { float s_ = ((a_[i_][0] + a_[i_][1]) + (a_[i_][2] + a_[i_][3])) + ((b_[i_][0] + b_[i_][1]) + (b_[i_][2] + b_[i_][3])); s_ += dppmov<0xB1>(s_); \
                  if (ok_[i_] && !hf_) tab[i_ * 256 + r_] = __builtin_amdgcn_rsqf(s_ * (1.0f / 1024.0f) + RMS_EPS); } \
              __syncthreads(); } \
            pg8::EpiAny E{0, z, NIN, nullptr, nullptr, 512, mix::QSCALE, rs_tab, nullptr, nullptr, nullptr, (bf16*)(ws + WS_UBUF)}; \
            pg8::gemm_phase<pg8::EpiAny, pg8::StaticOrder, PG8_ALIGN, PG8_SP2>(F.lds + RING_OFF, g, S, E); \
            slack_weights(F, ARGS_PTR(), l); \
            SEAM(p); \
        } \
        if (IN(p + 1)) { \
            const int b = F.vcu >> 6, n = F.vcu & 63; ArgsP ap = ARGS_PTR(); \
            float* agg = (float*)(ws + mix::WS_AGG); \
            mix::lru_tables(F.lds, ap->in[I_LCW] + l * 4 * 256, ap->in[I_LCB] + l * 256, ap->in[I_LBA] + l * 256, ap->in[I_LBX] + l * 256, ap->in[I_LAM] + l * 256, otid()); \
            for (int rep_ = 0; rep_ < MREP(0); ++rep_) mix::attn_unit(F.lds, z, ymix, ap->in[I_SINKS] + l * 8, b, n, otid()); \
            for (int rep_ = 0; rep_ < MREP(1); ++rep_) mix::conv_unit(F.lds, (const bf16*)(ws + WS_UBUF), ymix, ap->in[I_CDW] + l * 31 * 256, ap->in[I_CDB] + l * 256, ap->in[I_CLG] + l * 256, ap->in[I_CLB] + l * 256, b, n, otid()); \
            mix::LruState st; \
            for (int rep_ = 0; rep_ < MREP(2); ++rep_) mix::lru_local(st, z, (const bf16*)(ws + WS_WFRAG) + (size_t)l * WFRAG_LAYER, agg, F.lds, b, n, otid()); \
            xcd_barrier(bar); \
            if (MKEEP(3)) mix::lru_final(st, F.lds, z, ymix, agg, b, n, otid()); \
            SEAM(p + 1); \
        } \
        if (IN(p + 3) && KEEP(3)) { \
            pg8::Gemm g{ymix, (const bf16*)(wl + W_OUT), M, D, D, 1, 0}; pg8::StaticOrder S; S.init(M, D, F.G, (int)blockIdx.x); \
            pg8::EpiAny E{2, hb, HB_LD, nullptr, ssp2, 0, 1.f, nullptr, nullptr, nullptr, nullptr, nullptr, hb}; \
            pg8::gemm_phase<pg8::EpiAny, pg8::StaticOrder, PG8_ALIGN, PG8_SP2>(F.lds + RING_OFF, g, S, E); \
            PROBE_KLOOP_AGAIN(l, 3); \
            SEAM(p + 3); \
        } \
        if (IN(p + 4) && KEEP(4)) { \
            pg8::Gemm g{hb, (const bf16*)(wl + W_UP), M, FF, D, 1, HB_LD}; pg8::StaticOrder S; S.init(M, FF, F.G, (int)blockIdx.x); \
            pg8::EpiAny E{1, hh, FF, nullptr, nullptr, 0, 1.f, nullptr, nullptr, nullptr, nullptr, nullptr}; \
            pg8::gemm_phase<pg8::EpiAny, pg8::StaticOrder, PG8_ALIGN, PG8_SP2>(F.lds + RING_OFF, g, S, E); \
            PROBE_UP_AGAIN(l); \
            SEAM(p + 4); \
        } \
        if (IN(p + 5) && KEEP(5)) { \
            pg8::Gemm g{hh, (const bf16*)(wl + W_DOWN), M, D, FF, 1, 0}; pg8::StaticOrder S; S.init(M, D, F.G, (int)blockIdx.x); S.rev16 = DOWN_REV; \
            ArgsP ap = ARGS_PTR(); \
            pg8::EpiAny E{l == DEPTH - 1 ? 4 : 3, hb, HB_LD, ssp2, ssp, D  , 1.f, nullptr, ap->out, ap->in[I_FNORM], (unsigned*)(F.ctl + CW_FIN), nullptr, hb}; \
            pg8::gemm_phase<pg8::EpiAny, pg8::StaticOrder, PG8_ALIGN, PG8_SP2>(F.lds + RING_OFF, g, S, E); \
            PROBE_KLOOP_AGAIN(l, 5); \
            if (l < DEPTH - 1) SEAM(p + 5); \
        } \
     \
    } while (0)
    LAYER_BODY(0);
    LAYER_BODY(1);
#undef LAYER_BODY
    static_assert(DEPTH == 2, "two layer bodies are expanded by hand");
#undef IN
#undef SEAM
}


#ifndef MK_N_LAUNCHES
#define MK_N_LAUNCHES 1
#endif
extern "C" void kernel_launch(void* const* d_in, const int* in_sizes, int n_in, void* d_out, int out_size, void* d_ws, size_t ws_size, hipStream_t stream) {
    static int grid = 0;
    if (grid == 0) {
        if (n_in != 21 || in_sizes[0] != M * D || out_size != M * D || ws_size < WS_END) {
            fprintf(stderr, "kernel_launch: unexpected shapes n_in %d in0 %d out %d ws %zu\n", n_in, n_in > 0 ? in_sizes[0] : -1, out_size, ws_size); grid = -1; return; }
        int dev = 0, cus = 0;
        if (hipGetDevice(&dev) != hipSuccess || hipDeviceGetAttribute(&cus, hipDeviceAttributeMultiprocessorCount, dev) != hipSuccess) { grid = -1; return; }
        if (hipFuncSetAttribute((const void*)skel_fwd, hipFuncAttributeMaxDynamicSharedMemorySize, LDS_BYTES) != hipSuccess) { fprintf(stderr, "kernel_launch: hipFuncSetAttribute failed\n"); grid = -1; return; }
        grid = cus;
        if (grid != 256) { fprintf(stderr, "kernel_launch: built for 256 CUs, found %d\n", cus); grid = -1; return; }
    }
    if (grid < 0) return;
    (void)hipMemsetAsync((char*)d_ws + WS_CTL, 0, CTL_ZERO_BYTES, stream);
    Args a{};
    for (int i = 0; i < 21; ++i) a.in[i] = (const float*)d_in[i];
    a.out = (float*)d_out; a.ws = (unsigned char*)d_ws;
    int region = 0;
#define SKEL(lo, hi) do { a.ph_lo = (lo); a.ph_hi = (hi); a.bar_region = region++; hipLaunchKernelGGL(skel_fwd, dim3(grid), dim3(NWAVES * 64), LDS_BYTES, stream, a); } while (0)
#if defined(PROBE_REPEAT)
    SKEL(PH_PRO, PROBE_REPEAT + 1); SKEL(PROBE_REPEAT, PROBE_REPEAT + 1); SKEL(PROBE_REPEAT + 1, PH_N);
#elif MK_N_LAUNCHES == 1
    SKEL(PH_PRO, PH_N);
#else
    SKEL(PH_PRO, PH_PRO + 1);
    for (int l = 0; l < DEPTH; ++l) { const int p = PH_L0 + l * PH_PER_LAYER; SKEL(p, p + 1); SKEL(p + 1, p + 2); SKEL(p + 3, p + 4); SKEL(p + 4, p + 5); SKEL(p + 5, p + 6); }
    SKEL(PH_FINAL, PH_FINAL + 1);
#endif
#undef SKEL
}
```

```cpp
#include <hip/hip_runtime.h>
#include <cstdio>
#include <cstdint>
namespace pg8 {
#define PG8_LAS __attribute__((address_space(3)))
typedef unsigned short bf16_t;
typedef short bf16x8 __attribute__((ext_vector_type(8)));
typedef float f32x4 __attribute__((ext_vector_type(4)));
typedef unsigned u32x4 __attribute__((ext_vector_type(4)));
constexpr int BM = 256, BK = 64, HALF = 128, HTB = HALF * BK * 2  , STAGE_BYTES = 8 * HTB, NXCD = 8;
#ifndef PG8_WGM
#define PG8_WGM 4
#endif
constexpr int WGM = PG8_WGM;

__host__ __device__ __forceinline__ int lds_byte(int r, int c) { const int st = (r >> 4) * 2 + (c >> 5), rr = r & 15, cc = c & 31, ob = rr * 64 + cc * 2; return st * 1024 + (ob ^ (((ob >> 9) & 1) << 5)); }
__host__ __device__ __forceinline__ void stage_rc(int b, int& R, int& C) { const int st = b / 1024, sb = b % 1024, swz = sb ^ (((sb >> 9) & 1) << 5); R = (st >> 1) * 16 + swz / 64; C = (st & 1) * 32 + (swz % 64) / 2; }
__host__ __device__ __forceinline__ int perm32(int rho) { const int n = rho >> 4, i = rho & 15; return 8 * (i >> 2) + 4 * n + (i & 3); }

struct Unit { int pm, pn, slot; };
struct Gemm { const bf16_t* A; const bf16_t* Bt; int M, N, K; int adj; int lda; };

struct StaticOrder {
    int nM, nN, nwg, G, c; int rev16; unsigned pnperm;
    __host__ __device__ __forceinline__ void init(int M, int N, int G_, int c_) { nM = M / BM; nN = N / BM; nwg = nM * nN; G = G_; c = c_; pnperm = 0u; rev16 = 0; }
    __host__ __device__ __forceinline__ bool next(int i, Unit& u) const {
        const long L = (long)i * G + c; if (L >= nwg) return false;
        int wgid = (int)L; { const int q = nwg / NXCD, r = nwg % NXCD, xcd = wgid % NXCD, off = wgid / NXCD; wgid = (xcd < r ? xcd * (q + 1) : r * (q + 1) + (xcd - r) * q) + off; }
        const int nig = WGM * nN, gid = wgid / nig, fm = gid * WGM, gsz = (nM - fm) < WGM ? (nM - fm) : WGM;
        u.pm = fm + ((wgid % nig) % gsz); u.pn = (wgid % nig) / gsz; if (pnperm) u.pn = (int)((pnperm >> (3 * u.pn)) & 7u); if (rev16) u.pm = (u.pm & ~15) | (15 - (u.pm & 15)); u.slot = i; return true;
    }
    __device__ __forceinline__ void a_ready(const Unit&) const {}
    __device__ __forceinline__ void done(const Unit&) const {}
};

__device__ __forceinline__ unsigned cvt_pk_bf16(float lo, float hi) { typedef float f2_ __attribute__((ext_vector_type(2))); typedef __bf16 b2_ __attribute__((ext_vector_type(2))); f2_ v = {lo, hi}; b2_ b = __builtin_convertvector(v, b2_); return __builtin_bit_cast(unsigned, b); }

constexpr float EPI_RMS_EPS = 1e-6f;
__device__ __forceinline__ float rows4_sum(float v) {
    auto a = __builtin_amdgcn_permlane32_swap(__float_as_uint(v), __float_as_uint(v), false, false); v = __uint_as_float(a[0]) + __uint_as_float(a[1]);
    auto b = __builtin_amdgcn_permlane16_swap(__float_as_uint(v), __float_as_uint(v), false, false); return __uint_as_float(b[0]) + __uint_as_float(b[1]);
}
__device__ __forceinline__ float epi_sigmoid(float x) { return __builtin_amdgcn_rcpf(1.f + __builtin_amdgcn_exp2f(-1.4426950408889634f * x)); }
__device__ __forceinline__ float epi_gelu_tanh(float x) { const float u = 0.7978845608028654f * (x + 0.044715f * x * x * x); const float ex = __builtin_amdgcn_exp2f(2.f * 1.4426950408889634f * u); return 0.5f * x * (2.f - 2.f * __builtin_amdgcn_rcpf(ex + 1.f)); }
#ifndef HH_PLAIN
#define HH_STORE(w, p) __builtin_nontemporal_store(w, p)
#else
#define HH_STORE(w, p) (*(p) = (w))
#endif
__device__ __forceinline__ constexpr unsigned ssp_idx(int row, int part) { return (unsigned)(((row >> 4) * 16 + part) * 16 + (row & 15)); }
__device__ __forceinline__ unsigned ror8(unsigned v) { return (unsigned)__builtin_amdgcn_update_dpp((int)v, (int)v, 0x128, 0xf, 0xf, false); }
__device__ __forceinline__ u32x4 ror8(u32x4 v) { u32x4 r; r.x = ror8(v.x); r.y = ror8(v.y); r.z = ror8(v.z); r.w = ror8(v.w); return r; }
__device__ __forceinline__ u32x4 sel4(bool c, u32x4 a, u32x4 b) { u32x4 r; r.x = c ? a.x : b.x; r.y = c ? a.y : b.y; r.z = c ? a.z : b.z; r.w = c ? a.w : b.w; return r; }
struct EpiAny {
    static constexpr bool PERM = true, AFTER_DRAIN = false;
    int mode; bf16_t* O; int ldc; const float* ssp_r; float* ssp_w; int qcols; float qscale; const PG8_LAS float* rs_tab; float* fout; const float* fgain; unsigned* fcnt; bf16_t* ubuf; const bf16_t* R;

    __device__ __forceinline__ void final_rows(const f32x4 (&acc)[2][2][4][2], const Unit& u, int wr, int wc, int fr, int fq) const {
        typedef float f32x2 __attribute__((ext_vector_type(2)));
        const int row0 = u.pm * BM + wr * 64 + fr, col0 = u.pn * BM + wc * 64 + 8 * fq;
        const bool hi = (fr & 8) != 0;
        f32x4 h[2][2][4][2];
        { f32x4 pp[2][4]; int rowp_ = row0; asm volatile("" : "+v"(rowp_));
#pragma unroll
            for (int ai = 0; ai < 2; ++ai)
#pragma unroll
                for (int m = 0; m < 4; ++m) { _Pragma("unroll") for (int e = 0; e < 4; ++e) pp[ai][m][e] = ssp_r[ssp_idx(rowp_ + ai * HALF + m * 16, 4 * fq + e)]; }
#pragma unroll
            for (int ai = 0; ai < 2; ++ai)
#pragma unroll
                for (int m = 0; m < 4; ++m) { const f32x4 p = pp[ai][m]; float s = (p[0] + p[1]) + (p[2] + p[3]); s = rows4_sum(s); const float r2 = __builtin_amdgcn_rcpf(s * (1.0f / 1024.0f) + EPI_RMS_EPS);
#pragma unroll
                    for (int bj = 0; bj < 2; ++bj) { h[ai][bj][m][0] = acc[ai][bj][m][0] * r2; h[ai][bj][m][1] = acc[ai][bj][m][1] * r2; } }
            asm volatile("" ::: "memory"); }
        float sqv[2][4];
        { u32x4 rb[2][4][2]; int rowl_ = row0 - (hi ? 8 : 0), coll_ = col0 + (hi ? 32 : 0); asm volatile("" : "+v"(rowl_), "+v"(coll_));
#pragma unroll
            for (int ai = 0; ai < 2; ++ai)
#pragma unroll
                for (int m = 0; m < 4; ++m) {
                    rb[ai][m][0] = *(const u32x4*)(R + (size_t)(unsigned)((rowl_ + ai * HALF + m * 16) * ldc + coll_));
                    rb[ai][m][1] = *(const u32x4*)(R + (size_t)(unsigned)((rowl_ + ai * HALF + m * 16 + 8) * ldc + (coll_ ^ 32))); }
#pragma unroll
            for (int ai = 0; ai < 2; ++ai)
#pragma unroll
                for (int m = 0; m < 4; ++m) { f32x2 sq2 = {0.f, 0.f};
                    const u32x4 rx = sel4(hi, rb[ai][m][1], rb[ai][m][0]), ry = ror8(sel4(hi, rb[ai][m][0], rb[ai][m][1]));
#pragma unroll
                    for (int bj = 0; bj < 2; ++bj) { const u32x4 r = bj ? ry : rx; f32x4 a0 = h[ai][bj][m][0], a1 = h[ai][bj][m][1];
                        a0[0] += __builtin_bit_cast(float, r.x << 16); a0[1] += __builtin_bit_cast(float, r.x & 0xffff0000u); a0[2] += __builtin_bit_cast(float, r.y << 16); a0[3] += __builtin_bit_cast(float, r.y & 0xffff0000u);
                        a1[0] += __builtin_bit_cast(float, r.z << 16); a1[1] += __builtin_bit_cast(float, r.z & 0xffff0000u); a1[2] += __builtin_bit_cast(float, r.w << 16); a1[3] += __builtin_bit_cast(float, r.w & 0xffff0000u);
                        h[ai][bj][m][0] = a0; h[ai][bj][m][1] = a1;
                        sq2 += (f32x2){a0[0], a0[1]} * (f32x2){a0[0], a0[1]} + (f32x2){a0[2], a0[3]} * (f32x2){a0[2], a0[3]}; sq2 += (f32x2){a1[0], a1[1]} * (f32x2){a1[0], a1[1]} + (f32x2){a1[2], a1[3]} * (f32x2){a1[2], a1[3]}; }
                    sqv[ai][m] = rows4_sum(sq2[0] + sq2[1]); } }
        { int rows_ = row0; asm volatile("" : "+v"(rows_));
#pragma unroll
            for (int ai = 0; ai < 2; ++ai)
#pragma unroll
                for (int m = 0; m < 4; ++m)
                    if (fq == 0) __hip_atomic_store(ssp_w + ssp_idx(rows_ + ai * HALF + m * 16, u.pn * 4 + wc), sqv[ai][m], __ATOMIC_RELAXED, __HIP_MEMORY_SCOPE_AGENT); }
        asm volatile("s_waitcnt vmcnt(0)" ::: "memory");
        unsigned* cnt = fcnt + 64 * (2 * u.pm + wr);
        if ((threadIdx.x & 63) == 0) __hip_atomic_fetch_add(cnt, 1u, __ATOMIC_RELAXED, __HIP_MEMORY_SCOPE_AGENT);
        { unsigned sp_ = 0; while ((unsigned)__builtin_amdgcn_readfirstlane(__hip_atomic_load(cnt, __ATOMIC_RELAXED, __HIP_MEMORY_SCOPE_AGENT)) < 16u) { __builtin_amdgcn_s_sleep(1); if (++sp_ > (1u << 20)) break; } }
        float rsv[2][4];
        { float pt[2][4][4]; int rowq_ = row0; asm volatile("" : "+v"(rowq_));
#pragma unroll
            for (int ai = 0; ai < 2; ++ai)
#pragma unroll
                for (int m = 0; m < 4; ++m)
#pragma unroll
                    for (int e = 0; e < 4; ++e) pt[ai][m][e] = __hip_atomic_load(ssp_w + ssp_idx(rowq_ + ai * HALF + m * 16, 4 * fq + e), __ATOMIC_RELAXED, __HIP_MEMORY_SCOPE_AGENT);
#pragma unroll
            for (int ai = 0; ai < 2; ++ai)
#pragma unroll
                for (int m = 0; m < 4; ++m) { float s = (pt[ai][m][0] + pt[ai][m][1]) + (pt[ai][m][2] + pt[ai][m][3]); s = rows4_sum(s); rsv[ai][m] = __builtin_amdgcn_rsqf(s * (1.0f / 1024.0f) + EPI_RMS_EPS); } }
        f32x4 g[2][2];
#pragma unroll
        for (int bj = 0; bj < 2; ++bj) { g[bj][0] = *(const f32x4*)(fgain + col0 + bj * 32); g[bj][1] = *(const f32x4*)(fgain + col0 + bj * 32 + 4); }
        asm volatile("" ::: "memory");
        int rowo_ = row0; asm volatile("" : "+v"(rowo_));
#pragma unroll
        for (int ai = 0; ai < 2; ++ai)
#pragma unroll
            for (int m = 0; m < 4; ++m)
#pragma unroll
                for (int bj = 0; bj < 2; ++bj) {
                    const f32x4 P = h[ai][bj][m][0] * rsv[ai][m] * g[bj][0], Q = h[ai][bj][m][1] * rsv[ai][m] * g[bj][1];
                    u32x4 pu, qu; pu.x = __float_as_uint(P[0]); pu.y = __float_as_uint(P[1]); pu.z = __float_as_uint(P[2]); pu.w = __float_as_uint(P[3]);
                    qu.x = __float_as_uint(Q[0]); qu.y = __float_as_uint(Q[1]); qu.z = __float_as_uint(Q[2]); qu.w = __float_as_uint(Q[3]);
                    const u32x4 qr = ror8(qu);
                    float* op = fout + (size_t)(unsigned)((rowo_ + ai * HALF + m * 16 - (hi ? 8 : 0)) * qcols + col0 + bj * 32);
                    *(u32x4*)(op + (hi ? 4 : 0)) = sel4(hi, qr, pu);
                    *(u32x4*)(op + 8 * qcols + (hi ? 0 : 4)) = sel4(hi, pu, qr); }
    }
    __device__ __forceinline__ void operator()(const f32x4 (&acc)[2][2][4][2], const Unit& u, int wr, int wc, int fr_, int fq_) const {
        int fr = fr_, fq = fq_; asm volatile("" : "+v"(fr), "+v"(fq));
        const int row0 = u.pm * BM + wr * 64 + fr, col0 = u.pn * BM + wc * 32 + 8 * fq;
        if (mode > 4) return;
        if (mode == 4) { final_rows(acc, u, wr, wc, fr, fq); return; }
        if (mode == 1) {
            typedef float f32x2 __attribute__((ext_vector_type(2)));
            const bool hi1 = (fr & 8) != 0; const int rowa_ = row0 - (hi1 ? 8 : 0), cola_ = u.pn * BM + wc * 64 + 8 * fq + (hi1 ? 32 : 0);
#pragma unroll
            for (int ai = 0; ai < 2; ++ai)
#pragma unroll
                for (int m = 0; m < 4; ++m) { u32x4 wx, wy;
#pragma unroll
                    for (int bj = 0; bj < 2; ++bj) { const f32x4 a0 = acc[ai][bj][m][0], a1 = acc[ai][bj][m][1];
                        f32x2 p0 = __builtin_elementwise_max((f32x2){a0[0], a0[1]}, (f32x2){0.f, 0.f}), p1 = __builtin_elementwise_max((f32x2){a0[2], a0[3]}, (f32x2){0.f, 0.f});
                        f32x2 p2 = __builtin_elementwise_max((f32x2){a1[0], a1[1]}, (f32x2){0.f, 0.f}), p3 = __builtin_elementwise_max((f32x2){a1[2], a1[3]}, (f32x2){0.f, 0.f});
                        p0 = p0 * p0; p1 = p1 * p1; p2 = p2 * p2; p3 = p3 * p3;
                        u32x4 w; w.x = cvt_pk_bf16(p0[0], p0[1]); w.y = cvt_pk_bf16(p1[0], p1[1]); w.z = cvt_pk_bf16(p2[0], p2[1]); w.w = cvt_pk_bf16(p3[0], p3[1]);
                        if (bj) wy = w; else wx = w; }
                    const u32x4 wyr = ror8(wy); bf16_t* pa = O + (size_t)(unsigned)((rowa_ + ai * HALF + m * 16) * ldc + cola_);
                    HH_STORE(sel4(hi1, wyr, wx), (u32x4*)pa);
                    HH_STORE(sel4(hi1, wx, wyr), (u32x4*)(O + (size_t)(unsigned)((rowa_ + ai * HALF + m * 16 + 8) * ldc + (cola_ ^ 32)))); }
            return;
        }
        if (mode < 2) {
            const float sc = (u.pn * BM < qcols) ? qscale : 1.f;
            const int kind = (u.pn == 3 || u.pn == 4) ? 1 : (u.pn == 6) ? 2 : 0;
            const bool hi0 = (fr & 8) != 0; const int cola0_ = u.pn * BM + wc * 64 + 8 * fq + (hi0 ? 32 : 0);
#pragma unroll
            for (int ai = 0; ai < 2; ++ai)
#pragma unroll
                for (int m = 0; m < 4; ++m) { const int row = row0 + ai * HALF + m * 16;
                    const float rs = rs_tab[u.slot * BM + wr * 64 + fr + ai * HALF + m * 16] * sc;
                    if (kind == 1) {
                        f32x4 v0 = acc[ai][0][m][0] * rs, v1 = acc[ai][0][m][1] * rs; const f32x4 g0 = acc[ai][1][m][0] * rs, g1 = acc[ai][1][m][1] * rs;
#pragma unroll
                        for (int e = 0; e < 4; ++e) { v0[e] *= epi_sigmoid(g0[e]); v1[e] *= epi_sigmoid(g1[e]); }
                        u32x4 w; w.x = cvt_pk_bf16(v0[0], v0[1]); w.y = cvt_pk_bf16(v0[2], v0[3]); w.z = cvt_pk_bf16(v1[0], v1[1]); w.w = cvt_pk_bf16(v1[2], v1[3]);
                        *(u32x4*)(ubuf + (size_t)row * 256 + (u.pn - 3) * HALF + wc * 32 + 8 * fq) = w;
                    } else {
                    u32x4 wx, wy;
#pragma unroll
                    for (int bj = 0; bj < 2; ++bj) { f32x4 v0 = acc[ai][bj][m][0] * rs, v1 = acc[ai][bj][m][1] * rs;
                        if (kind == 2) {
#pragma unroll
                            for (int e = 0; e < 4; ++e) { v0[e] = epi_gelu_tanh(v0[e]); v1[e] = epi_gelu_tanh(v1[e]); } }
                        u32x4 w; w.x = cvt_pk_bf16(v0[0], v0[1]); w.y = cvt_pk_bf16(v0[2], v0[3]); w.z = cvt_pk_bf16(v1[0], v1[1]); w.w = cvt_pk_bf16(v1[2], v1[3]);
                        if (bj) wy = w; else wx = w; }
                    const u32x4 wyr = ror8(wy);
                    *(u32x4*)(O + (size_t)(unsigned)((row - (hi0 ? 8 : 0)) * ldc + cola0_)) = sel4(hi0, wyr, wx);
                    *(u32x4*)(O + (size_t)(unsigned)((row - (hi0 ? 8 : 0) + 8) * ldc + (cola0_ ^ 32))) = sel4(hi0, wx, wyr); } }
        } else {
            typedef float f32x2 __attribute__((ext_vector_type(2)));
            f32x4 sa[2][2][4][2];
            if (mode == 3) {
                f32x4 pp[2][4]; int rowp_ = row0; asm volatile("" : "+v"(rowp_));
#pragma unroll
                for (int ai = 0; ai < 2; ++ai)
#pragma unroll
                    for (int m = 0; m < 4; ++m) { _Pragma("unroll") for (int e = 0; e < 4; ++e) pp[ai][m][e] = ssp_r[ssp_idx(rowp_ + ai * HALF + m * 16, 4 * fq + e)]; }
#pragma unroll
                for (int ai = 0; ai < 2; ++ai)
#pragma unroll
                    for (int m = 0; m < 4; ++m) { const f32x4 p = pp[ai][m]; float s = (p[0] + p[1]) + (p[2] + p[3]); s = rows4_sum(s); const float r2 = __builtin_amdgcn_rcpf(s * (1.0f / 1024.0f) + EPI_RMS_EPS);
#pragma unroll
                        for (int bj = 0; bj < 2; ++bj) { sa[ai][bj][m][0] = acc[ai][bj][m][0] * r2; sa[ai][bj][m][1] = acc[ai][bj][m][1] * r2; } }
                asm volatile("" ::: "memory");
            } else {
#pragma unroll
                for (int ai = 0; ai < 2; ++ai)
#pragma unroll
                    for (int m = 0; m < 4; ++m)
#pragma unroll
                        for (int bj = 0; bj < 2; ++bj) { sa[ai][bj][m][0] = acc[ai][bj][m][0]; sa[ai][bj][m][1] = acc[ai][bj][m][1]; }
            }
            const bool hi = (fr & 8) != 0;
            int rowl_ = row0 - (hi ? 8 : 0), coll_ = u.pn * BM + wc * 64 + 8 * fq + (hi ? 32 : 0); asm volatile("" : "+v"(rowl_), "+v"(coll_));
            u32x4 rb[2][4][2];
#pragma unroll
            for (int ai = 0; ai < 2; ++ai)
#pragma unroll
                for (int m = 0; m < 4; ++m) {
                    rb[ai][m][0] = *(const u32x4*)(R + (size_t)(unsigned)((rowl_ + ai * HALF + m * 16) * ldc + coll_));
                    rb[ai][m][1] = *(const u32x4*)(R + (size_t)(unsigned)((rowl_ + ai * HALF + m * 16 + 8) * ldc + (coll_ ^ 32))); }
#pragma unroll
            for (int ai = 0; ai < 2; ++ai)
#pragma unroll
                for (int m = 0; m < 4; ++m) { int row = row0 + ai * HALF + m * 16; asm volatile("" : "+v"(row));
                    f32x2 sq2 = {0.f, 0.f};
                    const u32x4 rx = sel4(hi, rb[ai][m][1], rb[ai][m][0]), ry = ror8(sel4(hi, rb[ai][m][0], rb[ai][m][1]));
                    u32x4 wx, wy;
#pragma unroll
                    for (int bj = 0; bj < 2; ++bj) {
                        const u32x4 r = bj ? ry : rx; const f32x4 a0 = sa[ai][bj][m][0], a1 = sa[ai][bj][m][1];
                        const f32x2 v0 = (f32x2){a0[0], a0[1]} + (f32x2){__builtin_bit_cast(float, r.x << 16), __builtin_bit_cast(float, r.x & 0xffff0000u)};
                        const f32x2 v1 = (f32x2){a0[2], a0[3]} + (f32x2){__builtin_bit_cast(float, r.y << 16), __builtin_bit_cast(float, r.y & 0xffff0000u)};
                        const f32x2 v2 = (f32x2){a1[0], a1[1]} + (f32x2){__builtin_bit_cast(float, r.z << 16), __builtin_bit_cast(float, r.z & 0xffff0000u)};
                        const f32x2 v3 = (f32x2){a1[2], a1[3]} + (f32x2){__builtin_bit_cast(float, r.w << 16), __builtin_bit_cast(float, r.w & 0xffff0000u)};
                        sq2 += v0 * v0 + v1 * v1; sq2 += v2 * v2 + v3 * v3;
                        u32x4 w; w.x = cvt_pk_bf16(v0[0], v0[1]); w.y = cvt_pk_bf16(v1[0], v1[1]); w.z = cvt_pk_bf16(v2[0], v2[1]); w.w = cvt_pk_bf16(v3[0], v3[1]);
                        if (bj) wy = w; else wx = w; }
                    const u32x4 wyr = ror8(wy);
                    const unsigned offa = (unsigned)((row - (hi ? 8 : 0)) * ldc + coll_);
                    *(u32x4*)(O + (size_t)offa) = sel4(hi, wyr, wx);
                    *(u32x4*)(O + (size_t)(unsigned)((row - (hi ? 8 : 0) + 8) * ldc + (coll_ ^ 32))) = sel4(hi, wx, wyr);
                    float sq = sq2[0] + sq2[1];
                    sq = rows4_sum(sq);
                    if (fq == 0) ssp_w[ssp_idx(row, u.pn * 4 + wc)] = sq; }
        }
    }
};
template <class Epi, class Sched, bool ALIGN_EPI = false, bool SP2 = false>
__device__ __forceinline__ void gemm_phase(PG8_LAS unsigned char* lds, const Gemm g, const Sched& S, const Epi& E) {
    int tid_ = threadIdx.x; asm volatile("" : "+v"(tid_));
    const int tid = tid_, wid = __builtin_amdgcn_readfirstlane(tid >> 6), lane = tid & 63, wr = wid >> 2, wc = wid & 3, fr = lane & 15, fq = lane >> 4;
    const int K = g.K, nt = K / BK;
    const int lda = g.lda ? g.lda : K;
    unsigned voffA[2], voffB[2];
#pragma unroll
    for (int i = 0; i < 2; ++i) { int R, C; stage_rc(tid * 16 + i * 8192, R, C); const int Rb = Epi::PERM ? ((g.adj ? (R >> 5) * 64 : (R & ~31)) + perm32(R & 31)) : R;
        voffA[i] = (unsigned)(R * lda + C) * 2u; voffB[i] = (unsigned)(Rb * K + C) * 2u; }
    const size_t kstep = (size_t)(BK * 2);
    const size_t hstepK = (size_t)HALF * K * 2, tstepB = 2 * hstepK;
    const size_t hstep = (size_t)HALF * lda * 2, tstep = 2 * hstep;
    const size_t hstepB = g.adj ? (size_t)32 * K * 2 : hstepK;
    const unsigned ldsw = (unsigned)wid * 1024u;
    const int aoff = lds_byte(wr * 64 + fr, fq * 8), boff = lds_byte(wc * 32 + fr, fq * 8);
#define PG8_SA(b, h) (((b) * 2 + (h)) * HTB)
#define PG8_SB(b, h) ((4 + (b) * 2 + (h)) * HTB)
#define PG8_STAGE(bufoff, gbase, voff) do { _Pragma("unroll") for (int _i = 0; _i < 2; ++_i) \
        __builtin_amdgcn_global_load_lds((const unsigned*)((const char*)(gbase) + (voff)[_i]), (PG8_LAS unsigned*)(lds + (bufoff) + ldsw + _i * 8192), 16, 0, 0); } while (0)
#define PG8_LDA(dst, b, h) do { _Pragma("unroll") for (int m = 0; m < 4; ++m) _Pragma("unroll") for (int k = 0; k < 2; ++k) dst[m][k] = *(const PG8_LAS bf16x8*)(lds + PG8_SA(b, h) + aoff + m * 2048 + k * 1024); } while (0)
#define PG8_LDB(dst, b, h) do { _Pragma("unroll") for (int n = 0; n < 2; ++n) _Pragma("unroll") for (int k = 0; k < 2; ++k) dst[n][k] = *(const PG8_LAS bf16x8*)(lds + PG8_SB(b, h) + boff + n * 2048 + k * 1024); } while (0)
#define PG8_MMA(ai, bj, At, Bt) do { __builtin_amdgcn_s_setprio(1); _Pragma("unroll") for (int m = 0; m < 4; ++m) _Pragma("unroll") for (int n = 0; n < 2; ++n) _Pragma("unroll") for (int k = 0; k < 2; ++k) \
        acc[ai][bj][m][n] = __builtin_amdgcn_mfma_f32_16x16x32_bf16(Bt[n][k], At[m][k], acc[ai][bj][m][n], 0, 0, 0); __builtin_amdgcn_s_setprio(0); } while (0)
#define PG8_WAIT_V(n) asm volatile("s_waitcnt vmcnt(" #n ")" ::: "memory")
#define PG8_WAIT_L(n) asm volatile("s_waitcnt lgkmcnt(" #n ")" ::: "memory")
#define PG8_BAR __builtin_amdgcn_s_barrier()
#define PG8_SCHED __builtin_amdgcn_sched_barrier(0)
    Unit cur, nxt; int ui = 0;
    if (!S.next(0, cur)) return;
    f32x4 acc[2][2][4][2];
#pragma unroll
    for (int a = 0; a < 2; ++a)
#pragma unroll
        for (int b = 0; b < 2; ++b)
#pragma unroll
            for (int m = 0; m < 4; ++m)
#pragma unroll
                for (int n = 0; n < 2; ++n) acc[a][b][m][n] = (f32x4){0.f, 0.f, 0.f, 0.f};
    bf16x8 At[4][2], B0[2][2], B1[2][2];
    const char* cA = (const char*)g.A + (size_t)cur.pm * tstep; const char* cB = (const char*)g.Bt + (size_t)cur.pn * tstepB;
    S.a_ready(cur);
    if constexpr (SP2) {
        PG8_STAGE(PG8_SB(0, 0), cB, voffB); PG8_STAGE(PG8_SB(0, 1), cB + hstepB, voffB); PG8_STAGE(PG8_SA(0, 0), cA, voffA); PG8_STAGE(PG8_SA(0, 1), cA + hstep, voffA);
        if (wr == 1) PG8_BAR;
        PG8_WAIT_V(2); PG8_BAR;
        PG8_STAGE(PG8_SB(1, 0), cB + kstep, voffB); PG8_STAGE(PG8_SA(1, 0), cA + kstep, voffA); PG8_STAGE(PG8_SB(1, 1), cB + hstepB + kstep, voffB);
        PG8_WAIT_V(6); PG8_BAR;
    } else {
        PG8_STAGE(PG8_SB(0, 0), cB, voffB); PG8_STAGE(PG8_SA(0, 0), cA, voffA); PG8_STAGE(PG8_SB(0, 1), cB + hstepB, voffB); PG8_STAGE(PG8_SA(0, 1), cA + hstep, voffA);
        if (wr == 1) PG8_BAR;
        PG8_WAIT_V(4); PG8_BAR;
        PG8_STAGE(PG8_SB(1, 0), cB + kstep, voffB); PG8_STAGE(PG8_SA(1, 0), cA + kstep, voffA); PG8_STAGE(PG8_SB(1, 1), cB + hstepB + kstep, voffB);
        PG8_WAIT_V(6); PG8_BAR;
    }
    for (;;) {
        const bool has_next = S.next(ui + 1, nxt);
        const char* nA = has_next ? (const char*)g.A + (size_t)nxt.pm * tstep : cA; const char* nB = has_next ? (const char*)g.Bt + (size_t)nxt.pn * tstepB : cB;
        for (int t = 0; t < nt; t += 2) {
            const bool last = (t == nt - 2);
            const char* a1 = cA + (size_t)(t + 1) * kstep;
            const char* a2 = last ? nA : cA + (size_t)(t + 2) * kstep; const char* b2 = last ? nB : cB + (size_t)(t + 2) * kstep;
            const char* a3 = a2 + kstep; const char* b3 = b2 + kstep;
            if (last && has_next) S.a_ready(nxt);
            if constexpr (SP2) {
            PG8_LDB(B0, 0, 0); PG8_LDB(B1, 0, 1); PG8_SCHED; PG8_LDA(At, 0, 0); PG8_STAGE(PG8_SA(1, 1), a1 + hstep, voffA);
            PG8_WAIT_V(8); PG8_WAIT_L(0); PG8_BAR; PG8_MMA(0, 0, At, B0); PG8_MMA(0, 1, At, B1); PG8_BAR; PG8_SCHED;
            PG8_LDA(At, 0, 1); PG8_STAGE(PG8_SB(0, 0), b2, voffB); PG8_STAGE(PG8_SB(0, 1), b2 + hstepB, voffB); PG8_STAGE(PG8_SA(0, 0), a2, voffA);
            PG8_WAIT_V(8); PG8_WAIT_L(0); PG8_BAR; PG8_MMA(1, 0, At, B0); PG8_MMA(1, 1, At, B1); PG8_BAR; PG8_SCHED;
            PG8_LDB(B0, 1, 0); PG8_LDB(B1, 1, 1); PG8_SCHED; PG8_LDA(At, 1, 0); PG8_STAGE(PG8_SA(0, 1), a2 + hstep, voffA);
            PG8_WAIT_V(8); PG8_WAIT_L(0); PG8_BAR; PG8_MMA(0, 0, At, B0); PG8_MMA(0, 1, At, B1); PG8_BAR; PG8_SCHED;
            PG8_LDA(At, 1, 1); PG8_STAGE(PG8_SB(1, 0), b3, voffB); PG8_STAGE(PG8_SB(1, 1), b3 + hstepB, voffB); PG8_STAGE(PG8_SA(1, 0), a3, voffA);
            PG8_WAIT_V(8); PG8_WAIT_L(0); PG8_BAR; PG8_MMA(1, 0, At, B0); PG8_MMA(1, 1, At, B1); PG8_BAR; PG8_SCHED;
            } else {
            PG8_LDB(B0, 0, 0); PG8_SCHED; PG8_LDA(At, 0, 0); PG8_STAGE(PG8_SA(1, 1), a1 + hstep, voffA);
            PG8_WAIT_L(8); PG8_BAR; PG8_WAIT_L(0); PG8_MMA(0, 0, At, B0); PG8_BAR; PG8_SCHED;
            PG8_LDB(B1, 0, 1); PG8_STAGE(PG8_SB(0, 0), b2, voffB);
            PG8_BAR; PG8_WAIT_L(0); PG8_MMA(0, 1, At, B1); PG8_BAR;
            PG8_LDA(At, 0, 1); PG8_STAGE(PG8_SA(0, 0), a2, voffA);
            PG8_BAR; PG8_WAIT_L(0); PG8_MMA(1, 0, At, B0); PG8_BAR; PG8_SCHED;
            PG8_STAGE(PG8_SB(0, 1), b2 + hstepB, voffB);
            PG8_WAIT_V(6); PG8_BAR; PG8_MMA(1, 1, At, B1); PG8_BAR;
            PG8_LDB(B0, 1, 0); PG8_SCHED; PG8_LDA(At, 1, 0); PG8_STAGE(PG8_SA(0, 1), a2 + hstep, voffA);
            PG8_WAIT_L(8); PG8_BAR; PG8_WAIT_L(0); PG8_MMA(0, 0, At, B0); PG8_BAR; PG8_SCHED;
            PG8_LDB(B1, 1, 1); PG8_STAGE(PG8_SB(1, 0), b3, voffB);
            PG8_BAR; PG8_WAIT_L(0); PG8_MMA(0, 1, At, B1); PG8_BAR;
            PG8_LDA(At, 1, 1); PG8_STAGE(PG8_SA(1, 0), a3, voffA);
            PG8_BAR; PG8_WAIT_L(0); PG8_MMA(1, 0, At, B0); PG8_BAR; PG8_SCHED;
            PG8_STAGE(PG8_SB(1, 1), b3 + hstepB, voffB);
            PG8_WAIT_V(6); PG8_BAR; PG8_MMA(1, 1, At, B1); PG8_BAR;
            }
        }
        if constexpr (ALIGN_EPI) { if (wr == 0) PG8_BAR; }
        if constexpr (!Epi::AFTER_DRAIN) { E(acc, cur, wr, wc, fr, fq); S.done(cur); }
        if (!has_next) break;
#pragma unroll
        for (int a = 0; a < 2; ++a)
#pragma unroll
            for (int b = 0; b < 2; ++b)
#pragma unroll
                for (int m = 0; m < 4; ++m)
#pragma unroll
                    for (int n = 0; n < 2; ++n) acc[a][b][m][n] = (f32x4){0.f, 0.f, 0.f, 0.f};
        cur = nxt; cA = nA; cB = nB; ++ui;
        if constexpr (ALIGN_EPI) { if (wr == 1) PG8_BAR; }
    }
    PG8_WAIT_V(0);
    if constexpr (!ALIGN_EPI) { if (wr == 0) PG8_BAR; }
    PG8_BAR;
    if constexpr (Epi::AFTER_DRAIN) { E.fused(acc, cur, wr, wc, fr, fq, lds, wid, lane); S.done(cur); }
#undef PG8_SA
#undef PG8_SB
#undef PG8_STAGE
#undef PG8_LDA
#undef PG8_LDB
#undef PG8_MMA
#undef PG8_WAIT_V
#undef PG8_WAIT_L
#undef PG8_BAR
#undef PG8_SCHED
}
}

#ifndef PG8_SP2
#define PG8_SP2 true
#endif
#ifndef PG8_ALIGN
#define PG8_ALIGN true
#endif
constexpr int NWAVES = 8;
constexpr int D = 1024, BATCH = 4, SEQ = 8192, DEPTH = 2;
constexpr int M = BATCH * SEQ;
constexpr int NIN = 1792, FF = 4096;
constexpr int ZQ = 0, ZK = 512, ZV = 640, ZCV = 768, ZCG = 1024, ZRX = 1280, ZRG = 1536;
constexpr float RMS_EPS = 1e-6f, LN_EPS = 1e-5f;
constexpr size_t MiB = 1u << 20;
constexpr size_t WS_CTL = 0, CTL_ZERO_BYTES = 160 * 1024;
constexpr size_t WS_WFRAG = 1 * MiB; constexpr int WFRAG_LAYER = 64 * 512;
constexpr size_t WS_W = 2 * MiB, W_LAYER = 22 * MiB, W_IN = 0, W_OUT = 4 * MiB, W_UP = 6 * MiB, W_DOWN = 14 * MiB;
constexpr size_t WS_SSP = 46 * MiB;
constexpr int HB_LD = D + 64;
constexpr size_t WS_HB = 386 * MiB;
constexpr size_t WS_Z = 112 * MiB;
constexpr int YM_LD = D + 64, HH_LD = FF + 64;
constexpr size_t WS_YMIX = 224 * MiB;
constexpr size_t WS_HH = 112 * MiB;


constexpr size_t WS_SSP2 = 48 * MiB;
constexpr size_t WS_UBUF = 50 * MiB;
constexpr size_t WS_END = 458 * MiB;
constexpr int CW_FIN = 18432;
constexpr int CW_BAR = 4096;
constexpr int RING_OFF = 0, RING_BYTES = 131072;
constexpr int LDSCTL_OFF = RING_BYTES, MISC_OFF = LDSCTL_OFF + 320;
static_assert((CW_FIN + 256 * 64) * 4 <= (int)CTL_ZERO_BYTES && (CW_BAR + 4 * 3456) <= CW_FIN, "control words inside the memset region");
constexpr int LDS_BYTES = 163840;
#define GAS __attribute__((address_space(1)))
#define LAS __attribute__((address_space(3)))
typedef unsigned short bf16;
typedef unsigned v4u __attribute__((ext_vector_type(4)));
typedef float f32x4 __attribute__((ext_vector_type(4)));
typedef short bf16x8 __attribute__((ext_vector_type(8)));
typedef GAS unsigned gu32;
typedef GAS unsigned long long gu64;
#define RLX_AGENT __ATOMIC_RELAXED, __HIP_MEMORY_SCOPE_AGENT
#define LDS_WAIT() asm volatile("s_waitcnt lgkmcnt(0)" ::: "memory")
#define VM_WAIT() asm volatile("s_waitcnt vmcnt(0)" ::: "memory")
__device__ __forceinline__ unsigned long long rt() { return __builtin_amdgcn_s_memrealtime(); }
__device__ __forceinline__ unsigned f2bf(float f) { unsigned u = __builtin_bit_cast(unsigned, f); return (u + 0x7fffu + ((u >> 16) & 1u)) >> 16; }
__device__ __forceinline__ unsigned pk2(float lo, float hi) { return f2bf(lo) | (f2bf(hi) << 16); }
#define XB_TMO      128
#define XB_XCNT(j)  (256  + 64 * (j))
#define XB_XSUB(j)  (1280 + 64 * (j))
#define XB_XGEN(j)  (2304 + 64 * (j))
#define XB_TOP      3328
#define XB_TOPGEN   3392
#define XCD_BAR_WORDS 3456
#define XB_SPIN_CAP (1u << 18)

__device__ __forceinline__ unsigned xb_ld(unsigned* p)              { return __hip_atomic_load(p, __ATOMIC_RELAXED, __HIP_MEMORY_SCOPE_AGENT); }
__device__ __forceinline__ unsigned xb_add(unsigned* p, unsigned v) { return __hip_atomic_fetch_add(p, v, __ATOMIC_RELAXED, __HIP_MEMORY_SCOPE_AGENT); }
__device__ __forceinline__ unsigned xb_xcc_id() { return (unsigned)__builtin_amdgcn_s_getreg((3 << 11) | 20) & 0xFu; }
#define XB_SPIN(cond, bar) do { unsigned _sp = 0; while (cond) { __builtin_amdgcn_s_sleep(1); \
    if ((++_sp & 255u) == 0u) { if (xb_ld(&(bar)[XB_TMO])) break; if (_sp > XB_SPIN_CAP) { atomicAdd(&(bar)[XB_TMO], 1u); break; } } } } while (0)

struct XcdBarrier {
    unsigned* bar; unsigned x;
    volatile LAS unsigned* st;
};

__device__ __forceinline__ XcdBarrier xcd_barrier_post(unsigned* bar, volatile LAS unsigned* st) {
    XcdBarrier b; b.bar = bar; b.x = xb_xcc_id(); b.st = st;
    if (threadIdx.x == 0) (void)xb_add(&bar[XB_XCNT(b.x)], 1u);
    return b;
}
__device__ __forceinline__ void xcd_barrier_complete(unsigned* bar, unsigned x, unsigned& nloc, unsigned& nx) {
    const unsigned G = gridDim.x * gridDim.y * gridDim.z;
    unsigned sum, cnt, mine, sp = 0u;
    for (;;) {
        sum = 0u; cnt = 0u; mine = 0u;
#pragma unroll
        for (unsigned j = 0; j < 16; ++j) { const unsigned c = xb_ld(&bar[XB_XCNT(j)]); sum += c; cnt += (c > 0u) ? 1u : 0u; mine = (j == x) ? c : mine; }
        if (sum == G) break;
        __builtin_amdgcn_s_sleep(1);
        if ((++sp & 255u) == 0u) { if (xb_ld(&bar[XB_TMO])) break; if (sp > XB_SPIN_CAP) { atomicAdd(&bar[XB_TMO], 1u); break; } }
    }
    nloc = mine > 0u ? mine : 1u; nx = cnt > 0u ? cnt : 1u;
}

__device__ __forceinline__ void xcd_barrier(const XcdBarrier& b) {
    asm volatile("s_waitcnt vmcnt(0)" ::: "memory");
    __syncthreads();
    if (threadIdx.x == 0) {
        unsigned* bar = b.bar;
        __builtin_amdgcn_s_waitcnt(0);
        unsigned nloc = b.st[0], nx = b.st[1]; const unsigned kbar = b.st[2]; b.st[2] = kbar + 1u;
        if (nloc == 0u) { xcd_barrier_complete(bar, b.x, nloc, nx); b.st[0] = nloc; b.st[1] = nx; }
        const unsigned old = xb_add(&bar[XB_XSUB(b.x)], 1u);
        const unsigned gen = old / nloc;
        if (old + 1u == (gen + 1u) * nloc) {
            __builtin_amdgcn_fence(__ATOMIC_RELEASE, "agent");
            asm volatile("s_waitcnt vmcnt(0)" ::: "memory");
            __hip_atomic_fetch_add(&bar[XB_TOP], 1u, __ATOMIC_RELAXED, __HIP_MEMORY_SCOPE_AGENT);
            __builtin_amdgcn_fence(__ATOMIC_ACQUIRE, "agent");
            XB_SPIN(xb_ld(&bar[XB_TOP]) < (kbar + 1u) * nx, bar);
            asm volatile("s_waitcnt vmcnt(0)" ::: "memory");
        } else {
            __builtin_amdgcn_fence(__ATOMIC_ACQUIRE, "agent");
            XB_SPIN(xb_ld(&bar[XB_TOP]) < (kbar + 1u) * nx, bar);
            asm volatile("s_waitcnt vmcnt(0)" ::: "memory");
        }
    }
    __syncthreads();
}

template <int CTRL> __device__ __forceinline__ float dppmov(float v) { return __builtin_bit_cast(float, __builtin_amdgcn_update_dpp(0, __builtin_bit_cast(int, v), CTRL, 0xf, 0xf, true)); }
__device__ __forceinline__ float wave_sum(float v) {
    v += dppmov<0xB1>(v); v += dppmov<0x4E>(v); v += dppmov<0x141>(v); v += dppmov<0x140>(v);
    return (__builtin_bit_cast(float, __builtin_amdgcn_readlane(__builtin_bit_cast(int, v), 0)) + __builtin_bit_cast(float, __builtin_amdgcn_readlane(__builtin_bit_cast(int, v), 16)))
         + (__builtin_bit_cast(float, __builtin_amdgcn_readlane(__builtin_bit_cast(int, v), 32)) + __builtin_bit_cast(float, __builtin_amdgcn_readlane(__builtin_bit_cast(int, v), 48)));
}
__device__ __forceinline__ float bf2f(unsigned short b) { return __builtin_bit_cast(float, (unsigned)b << 16); }
__device__ __forceinline__ float sigmoidf_(float x) { return __builtin_amdgcn_rcpf(1.f + __builtin_amdgcn_exp2f(-1.4426950408889634f * x)); }

namespace mix {
typedef short bf16x8 __attribute__((ext_vector_type(8)));
typedef short s16x4 __attribute__((ext_vector_type(4)));
typedef float f32x16 __attribute__((ext_vector_type(16)));
typedef float f32x2 __attribute__((ext_vector_type(2)));
typedef unsigned u32x2 __attribute__((ext_vector_type(2)));
constexpr float LOG2E = 1.4426950408889634f;
constexpr float QSCALE = 0.125f * LOG2E;
constexpr int ATT_K = 0, ATT_V = 65536;
constexpr int XCH_OFF = RING_BYTES + 1024;
constexpr size_t WS_AGG = 296 * MiB;
constexpr int NUNIT = BATCH * 64;
constexpr int SUB0_OFF = XCH_OFF + 2048;
constexpr int CWT_OFF = XCH_OFF + 4096;
constexpr int SEG_OFF = XCH_OFF + 12288;
static_assert(SEG_OFF + 16384 <= LDS_BYTES, "LDS exchange tables");

__device__ __forceinline__ int crow(int r, int hi) { return (r & 3) + 8 * (r >> 2) + 4 * hi; }
__device__ __forceinline__ float xhalf_max(float v) { auto rr = __builtin_amdgcn_permlane32_swap(__float_as_uint(v), __float_as_uint(v), false, false); return fmaxf(__uint_as_float(rr[0]), __uint_as_float(rr[1])); }
__device__ __forceinline__ float xhalf_sum(float v) { auto rr = __builtin_amdgcn_permlane32_swap(__float_as_uint(v), __float_as_uint(v), false, false); return __uint_as_float(rr[0]) + __uint_as_float(rr[1]); }
__device__ __forceinline__ float xhalf_other(float v) { auto rr = __builtin_amdgcn_permlane32_swap(__float_as_uint(v), __float_as_uint(v), false, false); return (threadIdx.x & 32) ? __uint_as_float(rr[0]) : __uint_as_float(rr[1]); }
__device__ __forceinline__ s16x4 vtr(const LAS unsigned char* p) { typedef short v4i16_t __attribute__((ext_vector_type(4))); return __builtin_bit_cast(s16x4, __builtin_amdgcn_ds_read_tr16_b64_v4i16((LAS v4i16_t*)p)); }
__device__ __forceinline__ unsigned cvtpk(float lo, float hi) { typedef __bf16 bf16x2_t __attribute__((ext_vector_type(2))); f32x2 v = {lo, hi}; bf16x2_t b = __builtin_convertvector(v, bf16x2_t); return __builtin_bit_cast(unsigned, b); }
__device__ __forceinline__ void fmac_s(float& acc, float a, float b) { asm("v_fmac_f32_e32 %0, %1, %2" : "+v"(acc) : "v"(a), "v"(b)); }
__device__ __forceinline__ float bflo(unsigned w) { return __builtin_bit_cast(float, w << 16); }
__device__ __forceinline__ float bfhi(unsigned w) { return __builtin_bit_cast(float, w & 0xffff0000u); }

__device__ __forceinline__ void attn_unit(LAS unsigned char* lds, const bf16* z, bf16* ymix, const float* sinks, int b, int n, int tid) {
    asm volatile("" : "+v"(tid));
    const int lane = tid & 63, wid = __builtin_amdgcn_readfirstlane(tid >> 6), r32 = lane & 31, hi = lane >> 5;
    const size_t row0 = (size_t)b * SEQ + (size_t)n * 128;
    const int hq = wid, hkv = wid >> 2;
    bf16x8 qr[4];
#pragma unroll
    for (int d0 = 0; d0 < 4; ++d0) qr[d0] = *(const GAS bf16x8*)(z + (row0 + r32) * NIN + ZQ + hq * 64 + 16 * d0 + 8 * hi);
#ifndef AREP_STAGE
#define AREP_STAGE 1
#define AREP_LOOP 1
#endif
    for (int arep_ = 0; arep_ < AREP_STAGE; ++arep_) {
    if (arep_) __syncthreads();
#pragma unroll
    for (int half = 0; half < 2; ++half) {
        v4u v[8];
        const bool have = (half == 1) || (n > 0);
#pragma unroll
        for (int i = 0; i < 8; ++i) { const int pi = (half * 8 + i) * 512 + tid, token = pi >> 5, c32 = pi & 31;
            if (have) v[i] = *(const GAS v4u*)(z + (row0 + token - 128) * NIN + ZK + 8 * c32); else v[i] = (v4u){0u, 0u, 0u, 0u}; }
#pragma unroll
        for (int i = 0; i < 8; ++i) { const int pi = (half * 8 + i) * 512 + tid, token = pi >> 5, c32 = pi & 31, kind = c32 >> 3, c = c32 & 7;
            const int dst = (kind < 2) ? (ATT_K + (kind & 1) * 32768 + token * 128 + ((c ^ ((token >> 1) & 7)) << 4))
                                       : (ATT_V + (kind & 1) * 32768 + (c >> 2) * 16384 + token * 64 + (c & 3) * 16);
            *(LAS v4u*)(lds + dst) = v[i]; }
    }
    }
    __syncthreads();
    const float sink2 = sinks[hq] * LOG2E;
    const LAS unsigned char* Kb = lds + ATT_K + hkv * 32768;
    const LAS unsigned char* Vb = lds + ATT_V + hkv * 32768 + ((lane >> 4) & 1) * 32 + (lane & 3) * 8 + (4 * hi + ((lane & 15) >> 2)) * 64;
    int koff[4];
#pragma unroll
    for (int d0 = 0; d0 < 4; ++d0) koff[d0] = r32 * 128 + (((2 * d0 + hi) ^ ((r32 >> 1) & 7)) << 4);
    LAS float* part = (LAS float*)(lds + XCH_OFF);
    const float NEG = -INFINITY;
    f32x16 mask0, mask4;
#pragma unroll
    for (int r = 0; r < 16; ++r) { const int cr = crow(r, hi); mask0[r] = (cr > r32) ? 0.f : NEG; mask4[r] = (cr <= r32) ? 0.f : NEG; }
    bf16x8 ones;
#pragma unroll
    for (int e = 0; e < 8; ++e) ones[e] = (short)0x3F80;
#pragma unroll 1
    for (int i4_ = 0; i4_ < 4 * AREP_LOOP; ++i4_) { const int i = i4_ & 3;
        const size_t qrow = row0 + 32 * i + r32;
        bf16x8 qn[4];
        { const size_t qnrow = row0 + 32 * ((i4_ + 1) & 3) + r32;
#pragma unroll
          for (int d0 = 0; d0 < 4; ++d0) qn[d0] = *(const GAS bf16x8*)(z + qnrow * NIN + ZQ + hq * 64 + 16 * d0 + 8 * hi); }
        const LAS unsigned char* kbi = Kb + 4096 * i;
        const LAS unsigned char* vbi = Vb + 2048 * i;
        f32x16 s[5];
#pragma unroll
        for (int kt = 0; kt < 5; ++kt) { s[kt] = kt == 0 ? mask0 : kt == 4 ? mask4 : (f32x16){};
#pragma unroll
            for (int d0 = 0; d0 < 4; ++d0) { const bf16x8 kf = *(const LAS bf16x8*)(kbi + 4096 * kt + koff[d0]); s[kt] = __builtin_amdgcn_mfma_f32_32x32x16_bf16(kf, qr[d0], s[kt], 0, 0, 0); } }
        if (n == 0) {
#pragma unroll
            for (int kt = 0; kt < 4; ++kt) if (i + kt < 4) {
#pragma unroll
                for (int r = 0; r < 16; ++r) s[kt][r] = NEG; } }
        float m = sink2;
#pragma unroll
        for (int kt = 0; kt < 5; ++kt)
#pragma unroll
            for (int r = 0; r < 16; r += 2) m = fmaxf(fmaxf(m, s[kt][r]), s[kt][r + 1]);
        m = xhalf_max(m);
#pragma unroll
        for (int kt = 0; kt < 5; ++kt)
#pragma unroll
            for (int r = 0; r < 16; ++r) s[kt][r] = __builtin_amdgcn_exp2f(s[kt][r] - m);
        f32x16 o[2], ls; o[0] = (f32x16){}; o[1] = (f32x16){}; ls = (f32x16){};
#pragma unroll
        for (int kt = 0; kt < 5; ++kt)
#pragma unroll
            for (int s2 = 0; s2 < 2; ++s2) {
                v4u pw; pw.x = cvtpk(s[kt][8 * s2 + 0], s[kt][8 * s2 + 1]); pw.y = cvtpk(s[kt][8 * s2 + 2], s[kt][8 * s2 + 3]); pw.z = cvtpk(s[kt][8 * s2 + 4], s[kt][8 * s2 + 5]); pw.w = cvtpk(s[kt][8 * s2 + 6], s[kt][8 * s2 + 7]);
                const bf16x8 pf = __builtin_bit_cast(bf16x8, pw);
#pragma unroll
                for (int blk = 0; blk < 2; ++blk) {
                    const s16x4 lo = vtr(vbi + (blk * 16384 + 2048 * kt + 1024 * s2)), hi4 = vtr(vbi + (blk * 16384 + 2048 * kt + 1024 * s2 + 512));
                    const bf16x8 vf = (bf16x8){lo[0], lo[1], lo[2], lo[3], hi4[0], hi4[1], hi4[2], hi4[3]};
                    o[blk] = __builtin_amdgcn_mfma_f32_32x32x16_bf16(vf, pf, o[blk], 0, 0, 0); }
                ls = __builtin_amdgcn_mfma_f32_32x32x16_bf16(ones, pf, ls, 0, 0, 0);
            }
        const float inv = __builtin_amdgcn_rcpf(ls[0] + __builtin_amdgcn_exp2f(sink2 - m)); float ss = 0.f;
#pragma unroll
        for (int blk = 0; blk < 2; ++blk)
#pragma unroll
            for (int r = 0; r < 16; ++r) ss = fmaf(o[blk][r], o[blk][r], ss);
        ss = xhalf_sum(ss) * (inv * inv);
        LAS float* pp = part + (i4_ & 1) * 256;
        if (hi == 0) pp[wid * 32 + r32] = ss;
        __syncthreads();
        float tot = 0.f;
#pragma unroll
        for (int w = 0; w < 8; ++w) tot += pp[w * 32 + r32];
        const float rs = __builtin_amdgcn_rsqf(tot * (1.0f / 512.0f) + RMS_EPS) * inv;
        bf16* orow = ymix + qrow * YM_LD + hq * 64 + 8 * hi;
#pragma unroll
        for (int blk = 0; blk < 2; ++blk)
#pragma unroll
            for (int gp = 0; gp < 2; ++gp) { const int ge = 2 * gp, go = 2 * gp + 1;
                const unsigned ex = cvtpk(o[blk][4 * ge] * rs, o[blk][4 * ge + 1] * rs), ey = cvtpk(o[blk][4 * ge + 2] * rs, o[blk][4 * ge + 3] * rs);
                const unsigned ox = cvtpk(o[blk][4 * go] * rs, o[blk][4 * go + 1] * rs), oy = cvtpk(o[blk][4 * go + 2] * rs, o[blk][4 * go + 3] * rs);
                auto sx = __builtin_amdgcn_permlane32_swap(ex, ox, false, false); auto sy = __builtin_amdgcn_permlane32_swap(ey, oy, false, false);
                v4u w; w.x = sx[0]; w.y = sy[0]; w.z = sx[1]; w.w = sy[1];
                *(GAS v4u*)(orow + 32 * blk + 16 * gp) = w; }
#pragma unroll
        for (int d0 = 0; d0 < 4; ++d0) qr[d0] = qn[d0];
    }
    __syncthreads();
}

__device__ __forceinline__ void conv_unit(LAS unsigned char* lds, const bf16* ub, bf16* ymix, const float* dw_w, const float* dw_b, const float* ln_g, const float* ln_b, int b, int n, int tid) {
    asm volatile("" : "+v"(tid));
    const int lane = tid & 63, wid = __builtin_amdgcn_readfirstlane(tid >> 6);
    LAS float* U = (LAS float*)lds;
    const int cp = tid & 127, tg = tid >> 7;
    f32x2 w[31];
#pragma unroll
    for (int k = 0; k < 31; ++k) w[k] = *(const GAS f32x2*)(dw_w + k * 256 + 2 * cp);
    const f32x2 bias = *(const GAS f32x2*)(dw_b + 2 * cp);
    const f32x4 lg = *(const GAS f32x4*)(ln_g + 4 * lane), lb = *(const GAS f32x4*)(ln_b + 4 * lane);
#pragma unroll 1
    for (int half = 0; half < 2; ++half) {
        const int t0 = n * 128 + half * 64;
        const size_t rowb = (size_t)b * SEQ;
        {
            v4u vv[6];
#pragma unroll
            for (int j = 0; j < 6; ++j) { const int task = tid + 512 * j, r = task >> 5, c8 = task & 31, tt = t0 - 30 + r;
                if (task < 94 * 32 && tt >= 0) vv[j] = *(const GAS v4u*)(ub + (rowb + tt) * 256 + 8 * c8); else vv[j] = (v4u){0u, 0u, 0u, 0u}; }
#pragma unroll
            for (int j = 0; j < 6; ++j) { const int task = tid + 512 * j, r = task >> 5, c8 = task & 31;
                if (task < 94 * 32) { const f32x4 u0 = (f32x4){bflo(vv[j].x), bfhi(vv[j].x), bflo(vv[j].y), bfhi(vv[j].y)}, u1 = (f32x4){bflo(vv[j].z), bfhi(vv[j].z), bflo(vv[j].w), bfhi(vv[j].w)};
                    *(LAS f32x4*)(U + r * 256 + 8 * c8) = u0; *(LAS f32x4*)(U + r * 256 + 8 * c8 + 4) = u1; } }
        }
        __syncthreads();
        float acc0[2][8], acc1[2][8];
#pragma unroll
        for (int g = 0; g < 2; ++g) {
            const LAS float* up = U + (tg * 16 + g * 8) * 256 + 2 * cp;
#pragma unroll
            for (int jj = 0; jj < 8; ++jj) { acc0[g][jj] = bias[0]; acc1[g][jj] = bias[1]; }
#pragma unroll
            for (int rr = 0; rr < 38; ++rr) { const f32x2 u2 = *(const LAS f32x2*)(up + rr * 256);
#pragma unroll
                for (int jj = 0; jj < 8; ++jj) { const int k = rr - jj; if (k >= 0 && k <= 30) { fmac_s(acc0[g][jj], w[k][0], u2[0]); fmac_s(acc1[g][jj], w[k][1], u2[1]); } } }
        }
        __syncthreads();
#pragma unroll
        for (int g = 0; g < 2; ++g)
#pragma unroll
            for (int jj = 0; jj < 8; ++jj) *(LAS f32x2*)(U + (tg * 16 + g * 8 + jj) * 256 + 2 * cp) = (f32x2){acc0[g][jj], acc1[g][jj]};
        __syncthreads();
#pragma unroll
        for (int jj = 0; jj < 8; ++jj) { const int tok = wid * 8 + jj;
            f32x4 x = *(const LAS f32x4*)(U + tok * 256 + 4 * lane);
            const float mu = wave_sum((x[0] + x[1]) + (x[2] + x[3])) * (1.f / 256.f);
            x = x - mu;
            const float var = wave_sum((x[0] * x[0] + x[1] * x[1]) + (x[2] * x[2] + x[3] * x[3])) * (1.f / 256.f);
            const float rstd = __builtin_amdgcn_rsqf(var + LN_EPS);
            f32x4 y = x * rstd * lg + lb;
#pragma unroll
            for (int e = 0; e < 4; ++e) y[e] = y[e] * sigmoidf_(y[e]);
            const float ss = wave_sum((y[0] * y[0] + y[1] * y[1]) + (y[2] * y[2] + y[3] * y[3]));
            const float rs = __builtin_amdgcn_rsqf(ss * (1.f / 256.f) + RMS_EPS);
            u32x2 o; o.x = cvtpk(y[0] * rs, y[1] * rs); o.y = cvtpk(y[2] * rs, y[3] * rs);
            *(GAS u32x2*)(ymix + (rowb + t0 + tok) * YM_LD + 512 + 4 * lane) = o; }
        __syncthreads();
    }
}

struct LruState { f32x16 H[2][2]; };
__device__ __forceinline__ bf16x8 ident_frag(int s, int hi, int col) {
    bf16x8 f;
#pragma unroll
    for (int e = 0; e < 8; ++e) f[e] = (16 * s + 8 * hi + e == col) ? (short)0x3F80 : (short)0;
    return f;
}
__device__ __forceinline__ void lru_tables(LAS unsigned char* lds, const float* cw, const float* cb, const float* ba, const float* bx, const float* lam, int tid) {
    LAS float* cwt = (LAS float*)(lds + CWT_OFF);
    for (int e = tid; e < 1024; e += 512) cwt[e] = cw[e];
    if (tid < 256) { cwt[1024 + tid] = cb[tid]; cwt[1280 + tid] = ba[tid]; }
    else { const int c = tid - 256; cwt[1536 + c] = bx[c]; const float lm = -lam[c]; cwt[1792 + c] = fmaxf(lm, 0.f) + log1pf(__expf(-fabsf(lm))); }
}
__device__ __forceinline__ int pidx(int token, int ch) { return token * 256 + (ch ^ ((token & 7) << 2)); }
__device__ __forceinline__ void lru_local(LruState& st, const bf16* z, const bf16* wfrag, float* agg, LAS unsigned char* lds, int b, int n, int tid) {
    asm volatile("" : "+v"(tid));
    const int lane = tid & 63, wid = __builtin_amdgcn_readfirstlane(tid >> 6), r32 = lane & 31, hi = lane >> 5, hd = wid >> 1, th = wid & 1;
    float fin[2][2];
    LAS float* PL = (LAS float*)lds;
    const LAS float* cwt = (const LAS float*)(lds + CWT_OFF);
    const size_t row_w = (size_t)b * SEQ + (size_t)n * 128 + th * 64;
    const int tseq_w = n * 128 + th * 64;
    v4u xv[4][4];
#define LRU_LOAD_ROWS(tm) do { const int tseq_ = tseq_w + 32 * (tm) + r32; _Pragma("unroll") for (int s = 0; s < 4; ++s) { const bf16* zp = z + (row_w + 32 * (tm) + r32) * NIN + ZRX + hd * 64 + 16 * s + 8 * hi; \
        _Pragma("unroll") for (int k = 0; k < 4; ++k) xv[s][k] = *(const GAS v4u*)(zp - (ptrdiff_t)(tseq_ >= 3 - k ? 3 - k : 0) * NIN); } } while (0)
#define LRU_BUILD_XF(tm) do { const int tseq_ = tseq_w + 32 * (tm) + r32, tok_ = th * 64 + 32 * (tm) + r32; _Pragma("unroll") for (int s = 0; s < 4; ++s) { const int ch = hd * 64 + 16 * s + 8 * hi; \
            f32x4 a0 = *(const LAS f32x4*)(cwt + 1024 + ch), a1 = *(const LAS f32x4*)(cwt + 1024 + ch + 4); \
            _Pragma("unroll") for (int k = 0; k < 4; ++k) { const float mk = tseq_ >= 3 - k ? 1.f : 0.f; \
                const f32x4 w0 = *(const LAS f32x4*)(cwt + k * 256 + ch), w1 = *(const LAS f32x4*)(cwt + k * 256 + ch + 4); \
                const v4u x = xv[s][k]; \
                a0[0] += w0[0] * (mk * bflo(x.x)); a0[1] += w0[1] * (mk * bfhi(x.x)); a0[2] += w0[2] * (mk * bflo(x.y)); a0[3] += w0[3] * (mk * bfhi(x.y)); \
                a1[0] += w1[0] * (mk * bflo(x.z)); a1[1] += w1[1] * (mk * bfhi(x.z)); a1[2] += w1[2] * (mk * bflo(x.w)); a1[3] += w1[3] * (mk * bfhi(x.w)); } \
            v4u pw; pw.x = cvtpk(a0[0], a0[1]); pw.y = cvtpk(a0[2], a0[3]); pw.z = cvtpk(a1[0], a1[1]); pw.w = cvtpk(a1[2], a1[3]); \
            xf[tm][s] = __builtin_bit_cast(bf16x8, pw); \
            *(LAS f32x4*)(PL + pidx(tok_, ch)) = a0; *(LAS f32x4*)(PL + pidx(tok_, ch + 4)) = a1; } \
        asm volatile("s_waitcnt lgkmcnt(0)" ::: "memory"); } while (0)
    LRU_LOAD_ROWS(0);
    bf16x8 waf[4], wxf[4];
#pragma unroll
    for (int s = 0; s < 4; ++s) { waf[s] = *(const GAS bf16x8*)(wfrag + ((size_t)((0 * 4 + hd) * 2 + 0) * 4 + s) * 512 + lane * 8); wxf[s] = *(const GAS bf16x8*)(wfrag + ((size_t)((1 * 4 + hd) * 2 + 0) * 4 + s) * 512 + lane * 8); }
    bf16x8 xf[2][4];
    LRU_BUILD_XF(0);
    LRU_LOAD_ROWS(1);
#pragma unroll
    for (int tn = 0; tn < 2; ++tn) {
        const int c = hd * 64 + 32 * tn + r32;
        const float bav = cwt[1280 + c], bxv = cwt[1536 + c], sp = cwt[1792 + c];
        int cx[4];
#pragma unroll
        for (int e = 0; e < 4; ++e) cx[e] = c ^ ((4 * hi + e) << 2);
        bf16x8 waf2[4], wxf2[4];
        float CA = 1.f, CB = 0.f;
#pragma unroll
        for (int tm = 0; tm < 2; ++tm) {
            __builtin_amdgcn_sched_barrier(0);
            if (tn == 0 && tm == 1) { LRU_BUILD_XF(1);
#pragma unroll
                for (int s = 0; s < 4; ++s) { waf2[s] = *(const GAS bf16x8*)(wfrag + ((size_t)((0 * 4 + hd) * 2 + 1) * 4 + s) * 512 + lane * 8); wxf2[s] = *(const GAS bf16x8*)(wfrag + ((size_t)((1 * 4 + hd) * 2 + 1) * 4 + s) * 512 + lane * 8); }
                __builtin_amdgcn_sched_barrier(0); }
            f32x16 ra = (f32x16){}, ia = (f32x16){};
#pragma unroll
            for (int s = 0; s < 4; ++s) { ra = __builtin_amdgcn_mfma_f32_32x32x16_bf16(xf[tm][s], waf[s], ra, 0, 0, 0); ia = __builtin_amdgcn_mfma_f32_32x32x16_bf16(xf[tm][s], wxf[s], ia, 0, 0, 0); }
            LAS float* pl = PL + (th * 64 + 32 * tm + 4 * hi) * 256;
#pragma unroll
            for (int r = 0; r < 16; ++r) { const float rg = sigmoidf_(ra[r] + bav), ig = sigmoidf_(ia[r] + bxv);
                const float a = __builtin_amdgcn_exp2f((-8.f * LOG2E) * rg * sp);
                ra[r] = a;
                ia[r] = __builtin_amdgcn_sqrtf(fmaf(-a, a, 1.f)) * (ig * pl[((r & 3) + 8 * (r >> 2)) * 256 + cx[r & 3]]); }
#pragma unroll
            for (int g = 0; g < 4; ++g)
#pragma unroll
                for (int e = 1; e < 4; ++e) { ia[4 * g + e] = ra[4 * g + e] * ia[4 * g + e - 1] + ia[4 * g + e]; ra[4 * g + e] = ra[4 * g + e] * ra[4 * g + e - 1]; }
#pragma unroll
            for (int g = 0; g < 4; ++g) {
                const float ownA = ra[4 * g + 3], ownB = ia[4 * g + 3];
                const float othA = xhalf_other(ownA), othB = xhalf_other(ownB);
                float EA = 0.f, EB = 0.f;
                { const float A = hi ? othA : ownA, B = hi ? othB : ownB; if (!hi) { EA = CA; EB = CB; } CB = A * CB + B; CA = A * CA; }
                { const float A = hi ? ownA : othA, B = hi ? ownB : othB; if (hi) { EA = CA; EB = CB; } CB = A * CB + B; CA = A * CA; }
#pragma unroll
                for (int e = 0; e < 4; ++e) { ia[4 * g + e] += ra[4 * g + e] * EB; pl[(e + 8 * g) * 256 + cx[e]] = ra[4 * g + e] * EA; }
            }
            st.H[tm][tn] = ia;
        }
        fin[tn][0] = CA; fin[tn][1] = CB;
        if (tn == 0) {
#pragma unroll
            for (int s = 0; s < 4; ++s) { waf[s] = waf2[s]; wxf[s] = wxf2[s]; } }
    }
#undef LRU_LOAD_ROWS
#undef LRU_BUILD_XF
    LAS f32x2* sub0 = (LAS f32x2*)(lds + SUB0_OFF);
    if (th == 0 && hi == 0) {
#pragma unroll
        for (int tn = 0; tn < 2; ++tn) sub0[(hd * 2 + tn) * 32 + r32] = (f32x2){fin[tn][0], fin[tn][1]}; }
    __syncthreads();
    if (th == 1 && hi == 0) {
#pragma unroll
        for (int tn = 0; tn < 2; ++tn) { const f32x2 f0 = sub0[(hd * 2 + tn) * 32 + r32]; const int c = hd * 64 + 32 * tn + r32, unit = b * 64 + n;
            agg[(size_t)unit * 256 + c] = fin[tn][0] * f0[0]; agg[(size_t)(NUNIT + unit) * 256 + c] = fin[tn][0] * f0[1] + fin[tn][1]; } }
}
__device__ __forceinline__ float gelu_tanh(float x) { const float u = 0.7978845608028654f * (x + 0.044715f * x * x * x); const float e = __expf(2.f * u); const float th = 1.f - 2.f * __builtin_amdgcn_rcpf(e + 1.f); return 0.5f * x * (1.f + th); }
__device__ __forceinline__ void lru_final(LruState& st, LAS unsigned char* lds, const bf16* z, bf16* ymix, const float* agg, int b, int n, int tid) {
    asm volatile("" : "+v"(tid));
    const int lane = tid & 63, wid = __builtin_amdgcn_readfirstlane(tid >> 6), r32 = lane & 31, hi = lane >> 5, hd = wid >> 1, th = wid & 1;
    const size_t row_u = (size_t)b * SEQ + (size_t)n * 128, row_w = row_u + th * 64;
    LAS float* Y = (LAS float*)lds;
    LAS f32x2* seg = (LAS f32x2*)(lds + SEG_OFF);
    { f32x4 SA = (f32x4){1.f, 1.f, 1.f, 1.f}, SB = (f32x4){0.f, 0.f, 0.f, 0.f}; f32x4 ta[8], tb[8];
      const float* aA = agg + (size_t)(b * 64) * 256 + 4 * lane; const float* aB = agg + (size_t)(NUNIT + b * 64) * 256 + 4 * lane;
#pragma unroll
      for (int jj = 0; jj < 8; ++jj) { const int j = 8 * wid + jj;
          if (j < n) { ta[jj] = *(const GAS f32x4*)(aA + (size_t)j * 256); tb[jj] = *(const GAS f32x4*)(aB + (size_t)j * 256); } else { ta[jj] = (f32x4){1.f, 1.f, 1.f, 1.f}; tb[jj] = (f32x4){0.f, 0.f, 0.f, 0.f}; } }
#pragma unroll
      for (int jj = 0; jj < 8; ++jj) { SB = ta[jj] * SB + tb[jj]; SA = ta[jj] * SA; }
#pragma unroll
      for (int e = 0; e < 4; ++e) seg[wid * 256 + 4 * lane + e] = (f32x2){SA[e], SB[e]}; }
    bf16x8 gf[2][4];
#pragma unroll
    for (int tm = 0; tm < 2; ++tm)
#pragma unroll
        for (int s = 0; s < 4; ++s) gf[tm][s] = *(const GAS bf16x8*)(z + (row_w + 32 * tm + r32) * NIN + ZRG + hd * 64 + 16 * s + 8 * hi);
    __syncthreads();
#pragma unroll
    for (int tn = 0; tn < 2; ++tn) {
        const int col = 32 * tn + r32, c = hd * 64 + col;
        float carry = 0.f;
#pragma unroll
        for (int w = 0; w < 8; ++w) { const f32x2 sg = seg[w * 256 + c]; carry = sg[0] * carry + sg[1]; }
        if (th == 1) { const f32x2 f0 = ((const LAS f32x2*)(lds + SUB0_OFF))[(hd * 2 + tn) * 32 + r32]; carry = f0[0] * carry + f0[1]; }
#pragma unroll
        for (int tm = 0; tm < 2; ++tm) {
            f32x16 gd = (f32x16){};
#pragma unroll
            for (int s = 0; s < 4; ++s) gd = __builtin_amdgcn_mfma_f32_32x32x16_bf16(gf[tm][s], ident_frag(s, hi, col), gd, 0, 0, 0);
#pragma unroll
            for (int r = 0; r < 16; ++r) { LAS float* yp = Y + pidx(th * 64 + 32 * tm + crow(r, hi), c);
                const float h = st.H[tm][tn][r] + *yp * carry; *yp = h * gd[r]; }
        }
    }
    __syncthreads();
#pragma unroll
    for (int jj = 0; jj < 16; ++jj) { const int tok = wid * 16 + jj;
        const f32x4 y = *(const LAS f32x4*)(Y + pidx(tok, 4 * lane));
        const float ss = wave_sum((y[0] * y[0] + y[1] * y[1]) + (y[2] * y[2] + y[3] * y[3]));
        const float rs = __builtin_amdgcn_rsqf(ss * (1.f / 256.f) + RMS_EPS);
        u32x2 o; o.x = cvtpk(y[0] * rs, y[1] * rs); o.y = cvtpk(y[2] * rs, y[3] * rs);
        *(GAS u32x2*)(ymix + (row_u + tok) * YM_LD + 768 + 4 * lane) = o; }
    __syncthreads();
}
}

struct Frame {
    LAS unsigned char* lds;
    volatile LAS unsigned* MISC;
    gu32* ctl;
    int vcu, G;
};
__device__ __forceinline__ int otid() { int t = threadIdx.x; asm volatile("" : "+v"(t)); return t; }
struct Lw { int tid, lane, wave; __device__ __forceinline__ Lw() { tid = otid(); lane = tid & 63; wave = __builtin_amdgcn_readfirstlane(tid >> 6); } };
struct Args { const float* in[21]; float* out; unsigned char* ws; int ph_lo, ph_hi, bar_region, pad; };
typedef const __attribute__((address_space(4))) Args* ArgsP;
#define ARGS_PTR() ({ ArgsP p_ = (ArgsP)__builtin_amdgcn_kernarg_segment_ptr(); asm volatile("" : "+s"(p_)); p_; })
enum { I_X = 0, I_NORM1, I_WIN, I_SINKS, I_CDW, I_CDB, I_CLG, I_CLB, I_LCW, I_LCB, I_LWA, I_LBA, I_LWX, I_LBX, I_LAM, I_MIXN, I_WOUT, I_NORM2, I_WUP, I_WDOWN, I_FNORM };
constexpr int PH_PRO = 0, PH_L0 = 1, PH_PER_LAYER = 6, PH_FINAL = PH_L0 + DEPTH * PH_PER_LAYER, PH_N = PH_FINAL + 1;

template <bool REMAP> __device__ __forceinline__ void transpose_item(const float* W, const float* gain, int K, int N, bf16* WT, LAS float* scr, int item, int lane) {
    const int nblk = N / 32, kb = item / nblk, nb = item % nblk, k0 = 64 * kb, n0 = 32 * nb;
    int ns = n0; if (REMAP && n0 >= 768 && n0 < 1280) { const int t = n0 - 768, w = t & 255; ns = 768 + ((w >> 5) & 1) * 256 + (t >> 8) * 128 + (w >> 6) * 32; }
    f32x4 v[8]; float g[8];
#pragma unroll
    for (int i = 0; i < 8; ++i) { const int row = 8 * i + (lane >> 3); v[i] = *(const GAS f32x4*)(W + (size_t)(k0 + row) * N + ns + 4 * (lane & 7)); g[i] = gain ? gain[k0 + row] : 1.f; }
#pragma unroll
    for (int i = 0; i < 8; ++i) { const int row = 8 * i + (lane >> 3); *(LAS f32x4*)(scr + row * 36 + 4 * (lane & 7)) = v[i] * g[i]; }
    LDS_WAIT(); asm volatile("" ::: "memory");
    const int n = lane & 31, h = lane >> 5;
#pragma unroll
    for (int j = 0; j < 4; ++j) { const int kc = 2 * j + h; const LAS float* s = scr + (8 * kc) * 36 + n;
        v4u o; o.x = pk2(s[0 * 36], s[1 * 36]); o.y = pk2(s[2 * 36], s[3 * 36]); o.z = pk2(s[4 * 36], s[5 * 36]); o.w = pk2(s[6 * 36], s[7 * 36]);
        *(GAS v4u*)(WT + (size_t)(n0 + n) * K + k0 + 8 * kc) = o; }
    LDS_WAIT(); asm volatile("" ::: "memory");
}
constexpr int I_IN = (D / 64) * (NIN / 32), I_OUT = (D / 64) * (D / 32), I_UP = (D / 64) * (FF / 32), I_DN = (FF / 64) * (D / 32);
__device__ __forceinline__ void weight_item(ArgsP ap, int l, int mat, int r, LAS float* scr, int lane) {
    unsigned char* wl = ap->ws + WS_W + (size_t)l * W_LAYER;
    if (mat == 0)      transpose_item<true>(ap->in[I_WIN] + (size_t)l * D * NIN, ap->in[I_NORM1] + l * D, D, NIN, (bf16*)(wl + W_IN), scr, r, lane);
    else if (mat == 1) transpose_item<false>(ap->in[I_WOUT] + (size_t)l * D * D, ap->in[I_MIXN] + l * D, D, D, (bf16*)(wl + W_OUT), scr, r, lane);
    else if (mat == 2) transpose_item<false>(ap->in[I_WUP] + (size_t)l * D * FF, ap->in[I_NORM2] + l * D, D, FF, (bf16*)(wl + W_UP), scr, r, lane);
    else               transpose_item<false>(ap->in[I_WDOWN] + (size_t)l * FF * D, nullptr, FF, D, (bf16*)(wl + W_DOWN), scr, r, lane);
}
__device__ __forceinline__ void slack_weights(Frame& F, ArgsP ap, int l) {
    if (blockIdx.x < 128) return;
    const Lw L;
    LAS float* scr = (LAS float*)(F.lds + RING_OFF + L.wave * 16384);
    const int gw = ((int)blockIdx.x - 128) * NWAVES + L.wave, NGW = 128 * NWAVES;
    const int total = I_OUT + I_UP + I_DN + (l == 0 ? I_IN : 0);
    for (int it = gw; it < total; it += NGW) {
        int r = it;
        if (r < I_OUT) { weight_item(ap, l, 1, r, scr, L.lane); continue; } r -= I_OUT;
        if (r < I_UP) { weight_item(ap, l, 2, r, scr, L.lane); continue; } r -= I_UP;
        if (r < I_DN) { weight_item(ap, l, 3, r, scr, L.lane); continue; } r -= I_DN;
        weight_item(ap, 1, 0, r, scr, L.lane);
    }
}
__device__ __forceinline__ void rows_to_bf16_ss(int lane, const float* x, bf16* hb, float* ssp, int m0) {
    f32x4 v[4][4]; float s[4] = {0.f, 0.f, 0.f, 0.f};
#pragma unroll
    for (int q = 0; q < 4; ++q) { const GAS f32x4* xr = (const GAS f32x4*)(x + (size_t)(m0 + q) * D) + lane;
#pragma unroll
        for (int j = 0; j < 4; ++j) v[q][j] = xr[64 * j]; }
#pragma unroll
    for (int q = 0; q < 4; ++q) {
#pragma unroll
        for (int j = 0; j < 4; ++j) s[q] += (v[q][j].x * v[q][j].x + v[q][j].y * v[q][j].y) + (v[q][j].z * v[q][j].z + v[q][j].w * v[q][j].w);
        s[q] = wave_sum(s[q]);
        GAS unsigned long long* o8 = (GAS unsigned long long*)(hb + (size_t)(m0 + q) * HB_LD) + lane;
#pragma unroll
        for (int j = 0; j < 4; ++j) o8[64 * j] = (unsigned long long)pk2(v[q][j].x, v[q][j].y) | ((unsigned long long)pk2(v[q][j].z, v[q][j].w) << 32);
    }
    if (lane < 16) *(GAS f32x4*)(ssp + pg8::ssp_idx(m0, lane)) = lane == 0 ? (f32x4){s[0], s[1], s[2], s[3]} : (f32x4){0.f, 0.f, 0.f, 0.f};
}
__device__ __forceinline__ void p0_prologue(Frame& F, ArgsP ap) {
    const Lw L;
    LAS float* scr = (LAS float*)(F.lds + RING_OFF + L.wave * 16384);
    const int gw = F.vcu * NWAVES + L.wave, NGW = F.G * NWAVES;
    for (int it = gw; it < I_IN; it += NGW) weight_item(ap, 0, 0, it, scr, L.lane);
    for (int it = gw; it < DEPTH * 64; it += NGW) { const int l = it >> 6, gate = (it >> 5) & 1, hd = (it >> 3) & 3, tn = (it >> 2) & 1, s = it & 3;
        const float* W = ap->in[gate ? I_LWX : I_LWA] + (size_t)l * 4 * 64 * 64; float t[8];
#pragma unroll
        for (int e = 0; e < 8; ++e) t[e] = W[(size_t)(hd * 64 + 16 * s + 8 * (L.lane >> 5) + e) * 64 + 32 * tn + (L.lane & 31)];
        v4u o; o.x = pk2(t[0], t[1]); o.y = pk2(t[2], t[3]); o.z = pk2(t[4], t[5]); o.w = pk2(t[6], t[7]);
        *(GAS v4u*)((bf16*)(ap->ws + WS_WFRAG) + (size_t)l * WFRAG_LAYER + (size_t)(it & 63) * 512 + L.lane * 8) = o; }
    bf16* hb = (bf16*)(ap->ws + WS_HB); float* ssp = (float*)(ap->ws + WS_SSP);
    for (int m = 4 * gw; m < M; m += 4 * NGW) rows_to_bf16_ss(L.lane, ap->in[I_X], hb, ssp, m);
}

__global__ void __launch_bounds__(NWAVES * 64, 2) skel_fwd(Args args) {
    extern __shared__ __attribute__((aligned(16))) unsigned char lds[];
    Frame F;
    F.lds = (LAS unsigned char*)lds;
    F.MISC = (volatile LAS unsigned*)(F.lds + MISC_OFF);
    F.G = gridDim.x; { const int bx = blockIdx.x; F.vcu = (F.G % 8 == 0) ? (bx % 8) * (F.G / 8) + bx / 8 : bx; }
    ArgsP ap0 = ARGS_PTR();
    unsigned char* ws = ap0->ws;
    F.ctl = (gu32*)(ws + WS_CTL);
    for (int u = otid(); u < (LDS_BYTES - LDSCTL_OFF) / 4; u += NWAVES * 64) ((LAS unsigned*)(F.lds + LDSCTL_OFF))[u] = 0u;
    __syncthreads();
    XcdBarrier bar = xcd_barrier_post((unsigned*)(F.ctl + CW_BAR) + ap0->bar_region * XCD_BAR_WORDS, F.MISC + 8);
    bf16* hb = (bf16*)(ws + WS_HB); float* ssp = (float*)(ws + WS_SSP); float* ssp2 = (float*)(ws + WS_SSP2); bf16* z = (bf16*)(ws + WS_Z); bf16* ymix = (bf16*)(ws + WS_YMIX); bf16* hh = (bf16*)(ws + WS_HH);

#ifndef MKEEP
#define MKEEP(x) true
#endif
constexpr unsigned INPROJ_PNPERM = 3u | (4u << 3) | (6u << 6) | (0u << 9) | (1u << 12) | (2u << 15) | (5u << 18);
#ifndef PROBE_KLOOP_PHASE
#define PROBE_KLOOP_AGAIN(l, k) do {} while (0)
#else
#define PROBE_KLOOP_AGAIN(l, k) do { if ((l) == 0 && (k) == PROBE_KLOOP_PHASE) { xcd_barrier(bar); pg8::EpiAny E2 = E; E2.mode = 9 + (int)__hip_atomic_load(F.ctl + 8, __ATOMIC_RELAXED, __HIP_MEMORY_SCOPE_AGENT); pg8::gemm_phase<pg8::EpiAny, pg8::StaticOrder, PG8_ALIGN, PG8_SP2>(F.lds + RING_OFF, g, S, E2); } } while (0)
#endif
#ifndef DOWN_REV
#define DOWN_REV 1
#endif
#ifndef PROBE_UP_AGAIN
#define PROBE_UP_AGAIN(l) do {} while (0)
#endif
#ifndef MREP
#define MREP(x) 1
#endif
#ifndef KEEP
#define KEEP(x) true
#endif
    const int lo = ap0->ph_lo, hi = ap0->ph_hi;
#define IN(p) (lo <= (p) && (p) < hi)
#define SEAM(p) do { if (IN(p) && IN((p) + 1)) xcd_barrier(bar); } while (0)
    if (IN(PH_PRO)) { p0_prologue(F, ARGS_PTR()); SEAM(PH_PRO); }
#if defined(PROBE_DRY)
#define DRYSEL(a, b) (ap0->pad != 0 ? (a) : (b))
#ifndef DRY_EMODE
#define DRY_EMODE 2
#endif
#else
#define DRYSEL(a, b) (b)
#endif
#define LAYER_BODY(l) do { \
        const int p = PH_L0 + l * PH_PER_LAYER; \
        unsigned char* wl = ws + WS_W + (size_t)l * W_LAYER; \
        if (IN(p) && KEEP(0)) { \
            pg8::Gemm g{hb, (const bf16*)(wl + W_IN), M, NIN, D, 1, HB_LD}; pg8::StaticOrder S; S.init(M, NIN, F.G, (int)blockIdx.x); S.pnperm = INPROJ_PNPERM; \
            const LAS float* rs_tab = (const LAS float*)(F.lds + mix::XCH_OFF); \
            { LAS float* tab = (LAS float*)(F.lds + mix::XCH_OFF); pg8::Unit u_; const int t_ = otid(); const int r_ = t_ >> 1, hf_ = t_ & 1; \
              f32x4 a_[4], b_[4]; bool ok_[4]; \
              _Pragma("unroll") for (int i_ = 0; i_ < 4; ++i_) { ok_[i_] = S.next(i_, u_); a_[i_] = (f32x4){0.f, 0.f, 0.f, 0.f}; b_[i_] = a_[i_]; \
                  if (ok_[i_]) { const float* p_ = ssp + pg8::ssp_idx(u_.pm * 256 + r_, 8 * hf_); _Pragma("unroll") for (int e_ = 0; e_ < 4; ++e_) { a_[i_][e_] = p_[16 * e_]; b_[i_][e_] = p_[16 * (4 + e_)]; } } } \
              _Pragma("unroll") for (int i_ = 0; i_ < 4; ++i_) { float s_ = ((a_[i_][0] + a_[i_][1]) + (a_[i_][2] + a_[i_][3])) + ((b_[i_][0] + b_[i_][1]) + (b_[i_][2] + b_[i_][3])); s_ += dppmov<0xB1>(s_); \
                  if (ok_[i_] && !hf_) tab[i_ * 256 + r_] = __builtin_amdgcn_rsqf(s_ * (1.0f / 1024.0f) + RMS_EPS); } \
              __syncthreads(); } \
            pg8::EpiAny E{0, z, NIN, nullptr, nullptr, 512, mix::QSCALE, rs_tab, nullptr, nullptr, nullptr, (bf16*)(ws + WS_UBUF)}; \
            pg8::gemm_phase<pg8::EpiAny, pg8::StaticOrder, PG8_ALIGN, PG8_SP2>(F.lds + RING_OFF, g, S, E); \
            slack_weights(F, ARGS_PTR(), l); \
            SEAM(p); \
        } \
        if (IN(p + 1)) { \
            const int b = F.vcu >> 6, n = F.vcu & 63; ArgsP ap = ARGS_PTR(); \
            float* agg = (float*)(ws + mix::WS_AGG); \
            mix::lru_tables(F.lds, ap->in[I_LCW] + l * 4 * 256, ap->in[I_LCB] + l * 256, ap->in[I_LBA] + l * 256, ap->in[I_LBX] + l * 256, ap->in[I_LAM] + l * 256, otid()); \
            for (int rep_ = 0; rep_ < MREP(0); ++rep_) mix::attn_unit(F.lds, z, ymix, ap->in[I_SINKS] + l * 8, b, n, otid()); \
            for (int rep_ = 0; rep_ < MREP(1); ++rep_) mix::conv_unit(F.lds, (const bf16*)(ws + WS_UBUF), ymix, ap->in[I_CDW] + l * 31 * 256, ap->in[I_CDB] + l * 256, ap->in[I_CLG] + l * 256, ap->in[I_CLB] + l * 256, b, n, otid()); \
            mix::LruState st; \
            for (int rep_ = 0; rep_ < MREP(2); ++rep_) mix::lru_local(st, z, (const bf16*)(ws + WS_WFRAG) + (size_t)l * WFRAG_LAYER, agg, F.lds, b, n, otid()); \
            xcd_barrier(bar); \
            if (MKEEP(3)) mix::lru_final(st, F.lds, z, ymix, agg, b, n, otid()); \
            SEAM(p + 1); \
        } \
        if (IN(p + 3) && KEEP(3)) { \
            pg8::Gemm g{ymix, (const bf16*)(wl + W_OUT), M, D, D, 1, YM_LD}; pg8::StaticOrder S; S.init(M, D, F.G, (int)blockIdx.x); \
            pg8::EpiAny E{DRYSEL(DRY_EMODE, 2), DRYSEL((bf16*)(ws + 66 * MiB), hb), HB_LD, nullptr, DRYSEL((float*)(ws + 140 * MiB), ssp2), 0, 1.f, nullptr, nullptr, nullptr, nullptr, nullptr, DRYSEL((bf16*)(ws + 66 * MiB), hb)}; \
            pg8::gemm_phase<pg8::EpiAny, pg8::StaticOrder, PG8_ALIGN, PG8_SP2>(F.lds + RING_OFF, g, S, E); \
            PROBE_KLOOP_AGAIN(l, 3); \
            SEAM(p + 3); \
        } \
        if (IN(p + 4) && KEEP(4)) { \
            pg8::Gemm g{hb, (const bf16*)(wl + W_UP), M, FF, D, 1, HB_LD}; pg8::StaticOrder S; S.init(M, FF, F.G, (int)blockIdx.x); \
            pg8::EpiAny E{1, hh, HH_LD, nullptr, nullptr, 0, 1.f, nullptr, nullptr, nullptr, nullptr, nullptr}; \
            pg8::gemm_phase<pg8::EpiAny, pg8::StaticOrder, PG8_ALIGN, PG8_SP2>(F.lds + RING_OFF, g, S, E); \
            PROBE_UP_AGAIN(l); \
            SEAM(p + 4); \
        } \
        if (IN(p + 5) && KEEP(5)) { \
            pg8::Gemm g{hh, (const bf16*)(wl + W_DOWN), M, D, FF, 1, HH_LD}; pg8::StaticOrder S; S.init(M, D, F.G, (int)blockIdx.x); S.rev16 = DOWN_REV; \
            ArgsP ap = ARGS_PTR(); \
            pg8::EpiAny E{l == DEPTH - 1 ? 4 : 3, hb, HB_LD, ssp2, ssp, D  , 1.f, nullptr, ap->out, ap->in[I_FNORM], (unsigned*)(F.ctl + CW_FIN), nullptr, hb}; \
            pg8::gemm_phase<pg8::EpiAny, pg8::StaticOrder, PG8_ALIGN, PG8_SP2>(F.lds + RING_OFF, g, S, E); \
            PROBE_KLOOP_AGAIN(l, 5); \
            if (l < DEPTH - 1) SEAM(p + 5); \
        } \
     \
    } while (0)
    LAYER_BODY(0);
    LAYER_BODY(1);
#undef LAYER_BODY
    static_assert(DEPTH == 2, "two layer bodies are expanded by hand");
#undef IN
#undef SEAM
}


#if defined(PROBE_DRY)
#define PROBE_WS_EXTRA 0
#else
#define PROBE_WS_EXTRA 0
#endif
#ifndef MK_N_LAUNCHES
#define MK_N_LAUNCHES 1
#endif
extern "C" void kernel_launch(void* const* d_in, const int* in_sizes, int n_in, void* d_out, int out_size, void* d_ws, size_t ws_size, hipStream_t stream) {
    static int grid = 0;
    if (grid == 0) {
        if (n_in != 21 || in_sizes[0] != M * D || out_size != M * D || ws_size < WS_END + PROBE_WS_EXTRA) {
            fprintf(stderr, "kernel_launch: unexpected shapes n_in %d in0 %d out %d ws %zu\n", n_in, n_in > 0 ? in_sizes[0] : -1, out_size, ws_size); grid = -1; return; }
        int dev = 0, cus = 0;
        if (hipGetDevice(&dev) != hipSuccess || hipDeviceGetAttribute(&cus, hipDeviceAttributeMultiprocessorCount, dev) != hipSuccess) { grid = -1; return; }
        if (hipFuncSetAttribute((const void*)skel_fwd, hipFuncAttributeMaxDynamicSharedMemorySize, LDS_BYTES) != hipSuccess) { fprintf(stderr, "kernel_launch: hipFuncSetAttribute failed\n"); grid = -1; return; }
        grid = cus;
        if (grid != 256) { fprintf(stderr, "kernel_launch: built for 256 CUs, found %d\n", cus); grid = -1; return; }
    }
    if (grid < 0) return;
    (void)hipMemsetAsync((char*)d_ws + WS_CTL, 0, CTL_ZERO_BYTES, stream);
    Args a{};
    for (int i = 0; i < 21; ++i) a.in[i] = (const float*)d_in[i];
    a.out = (float*)d_out; a.ws = (unsigned char*)d_ws;
    int region = 0;
#define SKEL(lo, hi) do { a.ph_lo = (lo); a.ph_hi = (hi); a.bar_region = region++; hipLaunchKernelGGL(skel_fwd, dim3(grid), dim3(NWAVES * 64), LDS_BYTES, stream, a); } while (0)
#if defined(PROBE_DRY)
    SKEL(PH_PRO, PH_L0 + PROBE_DRY); a.pad = 1; SKEL(PH_L0 + PROBE_DRY, PH_L0 + PROBE_DRY + 1); a.pad = 0; SKEL(PH_L0 + PROBE_DRY, PH_N);
#elif defined(PROBE_REPEAT)
    SKEL(PH_PRO, PROBE_REPEAT + 1); SKEL(PROBE_REPEAT, PROBE_REPEAT + 1); SKEL(PROBE_REPEAT + 1, PH_N);
#elif MK_N_LAUNCHES == 1
    SKEL(PH_PRO, PH_N);
#else
    SKEL(PH_PRO, PH_PRO + 1);
    for (int l = 0; l < DEPTH; ++l) { const int p = PH_L0 + l * PH_PER_LAYER; SKEL(p, p + 1); SKEL(p + 1, p + 2); SKEL(p + 3, p + 4); SKEL(p + 4, p + 5); SKEL(p + 5, p + 6); }
    SKEL(PH_FINAL, PH_FINAL + 1);
#endif
#undef SKEL
}
```

```cpp
#include <hip/hip_runtime.h>
#include <cstdio>
#include <cstdint>
namespace pg8 {
#define PG8_LAS __attribute__((address_space(3)))
typedef unsigned short bf16_t;
typedef short bf16x8 __attribute__((ext_vector_type(8)));
typedef float f32x4 __attribute__((ext_vector_type(4)));
typedef unsigned u32x4 __attribute__((ext_vector_type(4)));
constexpr int BM = 256, BK = 64, HALF = 128, HTB = HALF * BK * 2  , STAGE_BYTES = 8 * HTB, NXCD = 8;
#ifndef PG8_WGM
#define PG8_WGM 4
#endif
constexpr int WGM = PG8_WGM;

__host__ __device__ __forceinline__ int lds_byte(int r, int c) { const int st = (r >> 4) * 2 + (c >> 5), rr = r & 15, cc = c & 31, ob = rr * 64 + cc * 2; return st * 1024 + (ob ^ (((ob >> 9) & 1) << 5)); }
__host__ __device__ __forceinline__ void stage_rc(int b, int& R, int& C) { const int st = b / 1024, sb = b % 1024, swz = sb ^ (((sb >> 9) & 1) << 5); R = (st >> 1) * 16 + swz / 64; C = (st & 1) * 32 + (swz % 64) / 2; }
__host__ __device__ __forceinline__ int perm32(int rho) { const int n = rho >> 4, i = rho & 15; return 8 * (i >> 2) + 4 * n + (i & 3); }

struct Unit { int pm, pn, slot; };
struct Gemm { const bf16_t* A; const bf16_t* Bt; int M, N, K; int adj; int lda; };

struct StaticOrder {
    int nM, nN, nwg, G, c; int rev16; unsigned pnperm;
    __host__ __device__ __forceinline__ void init(int M, int N, int G_, int c_) { nM = M / BM; nN = N / BM; nwg = nM * nN; G = G_; c = c_; pnperm = 0u; rev16 = 0; }
    __host__ __device__ __forceinline__ bool next(int i, Unit& u) const {
        const long L = (long)i * G + c; if (L >= nwg) return false;
        int wgid = (int)L; { const int q = nwg / NXCD, r = nwg % NXCD, xcd = wgid % NXCD, off = wgid / NXCD; wgid = (xcd < r ? xcd * (q + 1) : r * (q + 1) + (xcd - r) * q) + off; }
        const int nig = WGM * nN, gid = wgid / nig, fm = gid * WGM, gsz = (nM - fm) < WGM ? (nM - fm) : WGM;
        u.pm = fm + ((wgid % nig) % gsz); u.pn = (wgid % nig) / gsz; if (pnperm) u.pn = (int)((pnperm >> (3 * u.pn)) & 7u); if (rev16) u.pm = (u.pm & ~15) | (15 - (u.pm & 15)); u.slot = i; return true;
    }
    __device__ __forceinline__ void a_ready(const Unit&) const {}
    __device__ __forceinline__ void done(const Unit&) const {}
};

__device__ __forceinline__ unsigned cvt_pk_bf16(float lo, float hi) { typedef float f2_ __attribute__((ext_vector_type(2))); typedef __bf16 b2_ __attribute__((ext_vector_type(2))); f2_ v = {lo, hi}; b2_ b = __builtin_convertvector(v, b2_); return __builtin_bit_cast(unsigned, b); }

constexpr float EPI_RMS_EPS = 1e-6f;
__device__ __forceinline__ float rows4_sum(float v) {
    auto a = __builtin_amdgcn_permlane32_swap(__float_as_uint(v), __float_as_uint(v), false, false); v = __uint_as_float(a[0]) + __uint_as_float(a[1]);
    auto b = __builtin_amdgcn_permlane16_swap(__float_as_uint(v), __float_as_uint(v), false, false); return __uint_as_float(b[0]) + __uint_as_float(b[1]);
}
__device__ __forceinline__ float epi_sigmoid(float x) { return __builtin_amdgcn_rcpf(1.f + __builtin_amdgcn_exp2f(-1.4426950408889634f * x)); }
__device__ __forceinline__ float epi_gelu_tanh(float x) { const float u = 0.7978845608028654f * (x + 0.044715f * x * x * x); const float ex = __builtin_amdgcn_exp2f(2.f * 1.4426950408889634f * u); return 0.5f * x * (2.f - 2.f * __builtin_amdgcn_rcpf(ex + 1.f)); }
#ifndef HH_PLAIN
#define HH_STORE(w, p) __builtin_nontemporal_store(w, p)
#else
#define HH_STORE(w, p) (*(p) = (w))
#endif
__device__ __forceinline__ constexpr unsigned ssp_idx(int row, int part) { return (unsigned)(((row >> 4) * 16 + part) * 16 + (row & 15)); }
__device__ __forceinline__ unsigned ror8(unsigned v) { return (unsigned)__builtin_amdgcn_update_dpp((int)v, (int)v, 0x128, 0xf, 0xf, false); }
__device__ __forceinline__ u32x4 ror8(u32x4 v) { u32x4 r; r.x = ror8(v.x); r.y = ror8(v.y); r.z = ror8(v.z); r.w = ror8(v.w); return r; }
__device__ __forceinline__ u32x4 sel4(bool c, u32x4 a, u32x4 b) { u32x4 r; r.x = c ? a.x : b.x; r.y = c ? a.y : b.y; r.z = c ? a.z : b.z; r.w = c ? a.w : b.w; return r; }
#define RES_SLOT(j) (((j) == 0 ? 4 : (j) == 1 ? 5 : (j) == 2 ? 0 : (j) == 3 ? 1 : (j) == 4 ? 6 : (j) == 5 ? 7 : 2) * HTB)
struct EpiAny {
    static constexpr bool PERM = true, AFTER_DRAIN = false;
    int mode; bf16_t* O; int ldc; const float* ssp_r; float* ssp_w; int qcols; float qscale; const PG8_LAS float* rs_tab; float* fout; const float* fgain; unsigned* fcnt; bf16_t* ubuf; const bf16_t* R;

    __device__ __forceinline__ void final_rows(const f32x4 (&acc)[2][2][4][2], const Unit& u, int wr, int wc, int fr, int fq, const PG8_LAS unsigned char* rl) const {
        typedef float f32x2 __attribute__((ext_vector_type(2)));
        const int row0 = u.pm * BM + wr * 64 + fr, col0 = u.pn * BM + wc * 64 + 8 * fq;
        const bool hi = (fr & 8) != 0;
        f32x4 h[2][2][4][2];
        { f32x4 pp[2][4]; int rowp_ = row0; asm volatile("" : "+v"(rowp_));
#pragma unroll
            for (int ai = 0; ai < 2; ++ai)
#pragma unroll
                for (int m = 0; m < 4; ++m) { _Pragma("unroll") for (int e = 0; e < 4; ++e) pp[ai][m][e] = ssp_r[ssp_idx(rowp_ + ai * HALF + m * 16, 4 * fq + e)]; }
#pragma unroll
            for (int ai = 0; ai < 2; ++ai)
#pragma unroll
                for (int m = 0; m < 4; ++m) { const f32x4 p = pp[ai][m]; float s = (p[0] + p[1]) + (p[2] + p[3]); s = rows4_sum(s); const float r2 = __builtin_amdgcn_rcpf(s * (1.0f / 1024.0f) + EPI_RMS_EPS);
#pragma unroll
                    for (int bj = 0; bj < 2; ++bj) { h[ai][bj][m][0] = acc[ai][bj][m][0] * r2; h[ai][bj][m][1] = acc[ai][bj][m][1] * r2; } }
            asm volatile("" ::: "memory"); }
        float sqv[2][4];
        { const int lane16_ = (fr + 16 * fq) * 16; if (rl) asm volatile("s_waitcnt vmcnt(0)" ::: "memory");
            u32x4 rb[2][4][2]; int rowl_ = row0 - (hi ? 8 : 0), coll_ = col0 + (hi ? 32 : 0); asm volatile("" : "+v"(rowl_), "+v"(coll_));
#pragma unroll
            for (int ai = 0; ai < 2; ++ai)
#pragma unroll
                for (int m = 0; m < 4; ++m) { const int j_ = ai * 4 + m;
                    if (rl && j_ < 7) {
                        rb[ai][m][0] = *(const PG8_LAS u32x4*)(rl + RES_SLOT(j_) + lane16_); rb[ai][m][1] = *(const PG8_LAS u32x4*)(rl + RES_SLOT(j_) + 8192 + lane16_);
                    } else {
                    rb[ai][m][0] = *(const u32x4*)(R + (size_t)(unsigned)((rowl_ + ai * HALF + m * 16) * ldc + coll_));
                    rb[ai][m][1] = *(const u32x4*)(R + (size_t)(unsigned)((rowl_ + ai * HALF + m * 16 + 8) * ldc + (coll_ ^ 32))); } }
#pragma unroll
            for (int ai = 0; ai < 2; ++ai)
#pragma unroll
                for (int m = 0; m < 4; ++m) { f32x2 sq2 = {0.f, 0.f};
                    const u32x4 rx = sel4(hi, rb[ai][m][1], rb[ai][m][0]), ry = ror8(sel4(hi, rb[ai][m][0], rb[ai][m][1]));
#pragma unroll
                    for (int bj = 0; bj < 2; ++bj) { const u32x4 r = bj ? ry : rx; f32x4 a0 = h[ai][bj][m][0], a1 = h[ai][bj][m][1];
                        a0[0] += __builtin_bit_cast(float, r.x << 16); a0[1] += __builtin_bit_cast(float, r.x & 0xffff0000u); a0[2] += __builtin_bit_cast(float, r.y << 16); a0[3] += __builtin_bit_cast(float, r.y & 0xffff0000u);
                        a1[0] += __builtin_bit_cast(float, r.z << 16); a1[1] += __builtin_bit_cast(float, r.z & 0xffff0000u); a1[2] += __builtin_bit_cast(float, r.w << 16); a1[3] += __builtin_bit_cast(float, r.w & 0xffff0000u);
                        h[ai][bj][m][0] = a0; h[ai][bj][m][1] = a1;
                        sq2 += (f32x2){a0[0], a0[1]} * (f32x2){a0[0], a0[1]} + (f32x2){a0[2], a0[3]} * (f32x2){a0[2], a0[3]}; sq2 += (f32x2){a1[0], a1[1]} * (f32x2){a1[0], a1[1]} + (f32x2){a1[2], a1[3]} * (f32x2){a1[2], a1[3]}; }
                    sqv[ai][m] = rows4_sum(sq2[0] + sq2[1]); } }
        { int rows_ = row0; asm volatile("" : "+v"(rows_));
#pragma unroll
            for (int h = 0; h < 2; ++h) { const float v = fq == 0 ? sqv[0][h] : fq == 1 ? sqv[0][2 + h] : fq == 2 ? sqv[1][h] : sqv[1][2 + h];
                __hip_atomic_store(ssp_w + ssp_idx(rows_ + (fq >> 1) * HALF + ((fq & 1) * 2 + h) * 16, u.pn * 4 + wc), v, __ATOMIC_RELAXED, __HIP_MEMORY_SCOPE_AGENT); } }
        asm volatile("s_waitcnt vmcnt(0)" ::: "memory");
        unsigned* cnt = fcnt + 64 * (2 * u.pm + wr);
        if ((threadIdx.x & 63) == 0) __hip_atomic_fetch_add(cnt, 1u, __ATOMIC_RELAXED, __HIP_MEMORY_SCOPE_AGENT);
        { unsigned sp_ = 0; while ((unsigned)__builtin_amdgcn_readfirstlane(__hip_atomic_load(cnt, __ATOMIC_RELAXED, __HIP_MEMORY_SCOPE_AGENT)) < 16u) { __builtin_amdgcn_s_sleep(1); if (++sp_ > (1u << 20)) break; } }
        float rsv[2][4];
        { float pt[2][4][4]; int rowq_ = row0; asm volatile("" : "+v"(rowq_));
#pragma unroll
            for (int ai = 0; ai < 2; ++ai)
#pragma unroll
                for (int m = 0; m < 4; ++m)
#pragma unroll
                    for (int e = 0; e < 4; ++e) pt[ai][m][e] = __hip_atomic_load(ssp_w + ssp_idx(rowq_ + ai * HALF + m * 16, 4 * fq + e), __ATOMIC_RELAXED, __HIP_MEMORY_SCOPE_AGENT);
#pragma unroll
            for (int ai = 0; ai < 2; ++ai)
#pragma unroll
                for (int m = 0; m < 4; ++m) { float s = (pt[ai][m][0] + pt[ai][m][1]) + (pt[ai][m][2] + pt[ai][m][3]); s = rows4_sum(s); rsv[ai][m] = __builtin_amdgcn_rsqf(s * (1.0f / 1024.0f) + EPI_RMS_EPS); } }
        f32x4 g[2][2];
#pragma unroll
        for (int bj = 0; bj < 2; ++bj) { g[bj][0] = *(const f32x4*)(fgain + col0 + bj * 32); g[bj][1] = *(const f32x4*)(fgain + col0 + bj * 32 + 4); }
        asm volatile("" ::: "memory");
        int rowo_ = row0; asm volatile("" : "+v"(rowo_));
#pragma unroll
        for (int ai = 0; ai < 2; ++ai)
#pragma unroll
            for (int m = 0; m < 4; ++m)
#pragma unroll
                for (int bj = 0; bj < 2; ++bj) {
                    const f32x4 P = h[ai][bj][m][0] * rsv[ai][m] * g[bj][0], Q = h[ai][bj][m][1] * rsv[ai][m] * g[bj][1];
                    u32x4 pu, qu; pu.x = __float_as_uint(P[0]); pu.y = __float_as_uint(P[1]); pu.z = __float_as_uint(P[2]); pu.w = __float_as_uint(P[3]);
                    qu.x = __float_as_uint(Q[0]); qu.y = __float_as_uint(Q[1]); qu.z = __float_as_uint(Q[2]); qu.w = __float_as_uint(Q[3]);
                    const u32x4 qr = ror8(qu);
                    float* op = fout + (size_t)(unsigned)((rowo_ + ai * HALF + m * 16 - (hi ? 8 : 0)) * qcols + col0 + bj * 32);
                    *(u32x4*)(op + (hi ? 4 : 0)) = sel4(hi, qr, pu);
                    *(u32x4*)(op + 8 * qcols + (hi ? 0 : 4)) = sel4(hi, pu, qr); }
    }
    __device__ __forceinline__ void operator()(const f32x4 (&acc)[2][2][4][2], const Unit& u, int wr, int wc, int fr_, int fq_, const PG8_LAS unsigned char* rl = nullptr) const {
        int fr = fr_, fq = fq_; asm volatile("" : "+v"(fr), "+v"(fq));
        const int row0 = u.pm * BM + wr * 64 + fr, col0 = u.pn * BM + wc * 32 + 8 * fq;
        if (mode > 4) return;
        if (mode == 4) { final_rows(acc, u, wr, wc, fr, fq, rl); return; }
        if (mode == 1) {
            typedef float f32x2 __attribute__((ext_vector_type(2)));
            const bool hi1 = (fr & 8) != 0; const int rowa_ = row0 - (hi1 ? 8 : 0), cola_ = u.pn * BM + wc * 64 + 8 * fq + (hi1 ? 32 : 0);
#pragma unroll
            for (int ai = 0; ai < 2; ++ai)
#pragma unroll
                for (int m = 0; m < 4; ++m) { u32x4 wx, wy;
#pragma unroll
                    for (int bj = 0; bj < 2; ++bj) { const f32x4 a0 = acc[ai][bj][m][0], a1 = acc[ai][bj][m][1];
                        f32x2 p0 = __builtin_elementwise_max((f32x2){a0[0], a0[1]}, (f32x2){0.f, 0.f}), p1 = __builtin_elementwise_max((f32x2){a0[2], a0[3]}, (f32x2){0.f, 0.f});
                        f32x2 p2 = __builtin_elementwise_max((f32x2){a1[0], a1[1]}, (f32x2){0.f, 0.f}), p3 = __builtin_elementwise_max((f32x2){a1[2], a1[3]}, (f32x2){0.f, 0.f});
                        p0 = p0 * p0; p1 = p1 * p1; p2 = p2 * p2; p3 = p3 * p3;
                        u32x4 w; w.x = cvt_pk_bf16(p0[0], p0[1]); w.y = cvt_pk_bf16(p1[0], p1[1]); w.z = cvt_pk_bf16(p2[0], p2[1]); w.w = cvt_pk_bf16(p3[0], p3[1]);
                        if (bj) wy = w; else wx = w; }
                    const u32x4 wyr = ror8(wy); bf16_t* pa = O + (size_t)(unsigned)((rowa_ + ai * HALF + m * 16) * ldc + cola_);
                    HH_STORE(sel4(hi1, wyr, wx), (u32x4*)pa);
                    HH_STORE(sel4(hi1, wx, wyr), (u32x4*)(O + (size_t)(unsigned)((rowa_ + ai * HALF + m * 16 + 8) * ldc + (cola_ ^ 32)))); }
            return;
        }
        if (mode < 2) {
            const float sc = (u.pn * BM < qcols) ? qscale : 1.f;
            const int kind = (u.pn == 3 || u.pn == 4) ? 1 : (u.pn == 6) ? 2 : 0;
            const bool hi0 = (fr & 8) != 0; const int cola0_ = u.pn * BM + wc * 64 + 8 * fq + (hi0 ? 32 : 0);
#pragma unroll
            for (int ai = 0; ai < 2; ++ai)
#pragma unroll
                for (int m = 0; m < 4; ++m) { const int row = row0 + ai * HALF + m * 16;
                    const float rs = rs_tab[u.slot * BM + wr * 64 + fr + ai * HALF + m * 16] * sc;
                    if (kind == 1) {
                        f32x4 v0 = acc[ai][0][m][0] * rs, v1 = acc[ai][0][m][1] * rs; const f32x4 g0 = acc[ai][1][m][0] * rs, g1 = acc[ai][1][m][1] * rs;
#pragma unroll
                        for (int e = 0; e < 4; ++e) { v0[e] *= epi_sigmoid(g0[e]); v1[e] *= epi_sigmoid(g1[e]); }
                        u32x4 w; w.x = cvt_pk_bf16(v0[0], v0[1]); w.y = cvt_pk_bf16(v0[2], v0[3]); w.z = cvt_pk_bf16(v1[0], v1[1]); w.w = cvt_pk_bf16(v1[2], v1[3]);
                        *(u32x4*)(ubuf + (size_t)row * 256 + (u.pn - 3) * HALF + wc * 32 + 8 * fq) = w;
                    } else {
                    u32x4 wx, wy;
#pragma unroll
                    for (int bj = 0; bj < 2; ++bj) { f32x4 v0 = acc[ai][bj][m][0] * rs, v1 = acc[ai][bj][m][1] * rs;
                        if (kind == 2) {
#pragma unroll
                            for (int e = 0; e < 4; ++e) { v0[e] = epi_gelu_tanh(v0[e]); v1[e] = epi_gelu_tanh(v1[e]); } }
                        u32x4 w; w.x = cvt_pk_bf16(v0[0], v0[1]); w.y = cvt_pk_bf16(v0[2], v0[3]); w.z = cvt_pk_bf16(v1[0], v1[1]); w.w = cvt_pk_bf16(v1[2], v1[3]);
                        if (bj) wy = w; else wx = w; }
                    const u32x4 wyr = ror8(wy);
                    *(u32x4*)(O + (size_t)(unsigned)((row - (hi0 ? 8 : 0)) * ldc + cola0_)) = sel4(hi0, wyr, wx);
                    *(u32x4*)(O + (size_t)(unsigned)((row - (hi0 ? 8 : 0) + 8) * ldc + (cola0_ ^ 32))) = sel4(hi0, wx, wyr); } }
        } else {
            typedef float f32x2 __attribute__((ext_vector_type(2)));
            f32x4 sa[2][2][4][2];
            if (mode == 3) {
                f32x4 pp[2][4]; int rowp_ = row0; asm volatile("" : "+v"(rowp_));
#pragma unroll
                for (int ai = 0; ai < 2; ++ai)
#pragma unroll
                    for (int m = 0; m < 4; ++m) { _Pragma("unroll") for (int e = 0; e < 4; ++e) pp[ai][m][e] = ssp_r[ssp_idx(rowp_ + ai * HALF + m * 16, 4 * fq + e)]; }
#pragma unroll
                for (int ai = 0; ai < 2; ++ai)
#pragma unroll
                    for (int m = 0; m < 4; ++m) { const f32x4 p = pp[ai][m]; float s = (p[0] + p[1]) + (p[2] + p[3]); s = rows4_sum(s); const float r2 = __builtin_amdgcn_rcpf(s * (1.0f / 1024.0f) + EPI_RMS_EPS);
#pragma unroll
                        for (int bj = 0; bj < 2; ++bj) { sa[ai][bj][m][0] = acc[ai][bj][m][0] * r2; sa[ai][bj][m][1] = acc[ai][bj][m][1] * r2; } }
                asm volatile("" ::: "memory");
            } else {
#pragma unroll
                for (int ai = 0; ai < 2; ++ai)
#pragma unroll
                    for (int m = 0; m < 4; ++m)
#pragma unroll
                        for (int bj = 0; bj < 2; ++bj) { sa[ai][bj][m][0] = acc[ai][bj][m][0]; sa[ai][bj][m][1] = acc[ai][bj][m][1]; }
            }
            const bool hi = (fr & 8) != 0;
            int rowl_ = row0 - (hi ? 8 : 0), coll_ = u.pn * BM + wc * 64 + 8 * fq + (hi ? 32 : 0); asm volatile("" : "+v"(rowl_), "+v"(coll_));
            const int lane16_ = (fr + 16 * fq) * 16; if (rl) asm volatile("s_waitcnt vmcnt(0)" ::: "memory");
            u32x4 rb[2][4][2];
#pragma unroll
            for (int ai = 0; ai < 2; ++ai)
#pragma unroll
                for (int m = 0; m < 4; ++m) { const int j_ = ai * 4 + m;
                    if (rl && j_ < 7) {
                        rb[ai][m][0] = *(const PG8_LAS u32x4*)(rl + RES_SLOT(j_) + lane16_); rb[ai][m][1] = *(const PG8_LAS u32x4*)(rl + RES_SLOT(j_) + 8192 + lane16_);
                    } else {
                    rb[ai][m][0] = *(const u32x4*)(R + (size_t)(unsigned)((rowl_ + ai * HALF + m * 16) * ldc + coll_));
                    rb[ai][m][1] = *(const u32x4*)(R + (size_t)(unsigned)((rowl_ + ai * HALF + m * 16 + 8) * ldc + (coll_ ^ 32))); } }
            float sqs[2][4];
#pragma unroll
            for (int ai = 0; ai < 2; ++ai)
#pragma unroll
                for (int m = 0; m < 4; ++m) { int row = row0 + ai * HALF + m * 16; asm volatile("" : "+v"(row));
                    f32x2 sq2 = {0.f, 0.f};
                    const u32x4 rx = sel4(hi, rb[ai][m][1], rb[ai][m][0]), ry = ror8(sel4(hi, rb[ai][m][0], rb[ai][m][1]));
                    u32x4 wx, wy;
#pragma unroll
                    for (int bj = 0; bj < 2; ++bj) {
                        const u32x4 r = bj ? ry : rx; const f32x4 a0 = sa[ai][bj][m][0], a1 = sa[ai][bj][m][1];
                        const f32x2 v0 = (f32x2){a0[0], a0[1]} + (f32x2){__builtin_bit_cast(float, r.x << 16), __builtin_bit_cast(float, r.x & 0xffff0000u)};
                        const f32x2 v1 = (f32x2){a0[2], a0[3]} + (f32x2){__builtin_bit_cast(float, r.y << 16), __builtin_bit_cast(float, r.y & 0xffff0000u)};
                        const f32x2 v2 = (f32x2){a1[0], a1[1]} + (f32x2){__builtin_bit_cast(float, r.z << 16), __builtin_bit_cast(float, r.z & 0xffff0000u)};
                        const f32x2 v3 = (f32x2){a1[2], a1[3]} + (f32x2){__builtin_bit_cast(float, r.w << 16), __builtin_bit_cast(float, r.w & 0xffff0000u)};
                        sq2 += v0 * v0 + v1 * v1; sq2 += v2 * v2 + v3 * v3;
                        u32x4 w; w.x = cvt_pk_bf16(v0[0], v0[1]); w.y = cvt_pk_bf16(v1[0], v1[1]); w.z = cvt_pk_bf16(v2[0], v2[1]); w.w = cvt_pk_bf16(v3[0], v3[1]);
                        if (bj) wy = w; else wx = w; }
                    const u32x4 wyr = ror8(wy);
                    const unsigned offa = (unsigned)((row - (hi ? 8 : 0)) * ldc + coll_);
                    *(u32x4*)(O + (size_t)offa) = sel4(hi, wyr, wx);
                    *(u32x4*)(O + (size_t)(unsigned)((row - (hi ? 8 : 0) + 8) * ldc + (coll_ ^ 32))) = sel4(hi, wx, wyr);
                    sqs[ai][m] = rows4_sum(sq2[0] + sq2[1]); }
#pragma unroll
            for (int h = 0; h < 2; ++h) { const float v = fq == 0 ? sqs[0][h] : fq == 1 ? sqs[0][2 + h] : fq == 2 ? sqs[1][h] : sqs[1][2 + h];
                ssp_w[ssp_idx(row0 + (fq >> 1) * HALF + ((fq & 1) * 2 + h) * 16, u.pn * 4 + wc)] = v; }
        }
    }
};
template <class Epi, class Sched, bool ALIGN_EPI = false, bool SP2 = false>
__device__ __forceinline__ void gemm_phase(PG8_LAS unsigned char* lds, const Gemm g, const Sched& S, const Epi& E) {
    int tid_ = threadIdx.x; asm volatile("" : "+v"(tid_));
    const int tid = tid_, wid = __builtin_amdgcn_readfirstlane(tid >> 6), lane = tid & 63, wr = wid >> 2, wc = wid & 3, fr = lane & 15, fq = lane >> 4;
    const int K = g.K, nt = K / BK;
    const int lda = g.lda ? g.lda : K;
    unsigned voffA[2], voffB[2];
#pragma unroll
    for (int i = 0; i < 2; ++i) { int R, C; stage_rc(tid * 16 + i * 8192, R, C); const int Rb = Epi::PERM ? ((g.adj ? (R >> 5) * 64 : (R & ~31)) + perm32(R & 31)) : R;
        voffA[i] = (unsigned)(R * lda + C) * 2u; voffB[i] = (unsigned)(Rb * K + C) * 2u; }
    const bool resid_mode = E.mode >= 2 && E.mode <= 4;
    unsigned voffR[2] = {0u, 0u};
    if (resid_mode) { const int hi_ = (fr >> 3) & 1; const int rl_ = wr * 64 + fr - 8 * hi_, cl_ = wc * 64 + 8 * fq + 32 * hi_;
        voffR[0] = (unsigned)(rl_ * E.ldc + cl_) * 2u; voffR[1] = (unsigned)((rl_ + 8) * E.ldc + (cl_ ^ 32)) * 2u; }
    const size_t kstep = (size_t)(BK * 2);
    const size_t hstepK = (size_t)HALF * K * 2, tstepB = 2 * hstepK;
    const size_t hstep = (size_t)HALF * lda * 2, tstep = 2 * hstep;
    const size_t hstepB = g.adj ? (size_t)32 * K * 2 : hstepK;
    const unsigned ldsw = (unsigned)wid * 1024u;
    const int aoff = lds_byte(wr * 64 + fr, fq * 8), boff = lds_byte(wc * 32 + fr, fq * 8);
#define PG8_SA(b, h) (((b) * 2 + (h)) * HTB)
#define PG8_SB(b, h) ((4 + (b) * 2 + (h)) * HTB)
#define PG8_STAGE(bufoff, gbase, voff) do { _Pragma("unroll") for (int _i = 0; _i < 2; ++_i) \
        __builtin_amdgcn_global_load_lds((const unsigned*)((const char*)(gbase) + (voff)[_i]), (PG8_LAS unsigned*)(lds + (bufoff) + ldsw + _i * 8192), 16, 0, 0); } while (0)
#define PG8_LDA(dst, b, h) do { _Pragma("unroll") for (int m = 0; m < 4; ++m) _Pragma("unroll") for (int k = 0; k < 2; ++k) dst[m][k] = *(const PG8_LAS bf16x8*)(lds + PG8_SA(b, h) + aoff + m * 2048 + k * 1024); } while (0)
#define PG8_LDB(dst, b, h) do { _Pragma("unroll") for (int n = 0; n < 2; ++n) _Pragma("unroll") for (int k = 0; k < 2; ++k) dst[n][k] = *(const PG8_LAS bf16x8*)(lds + PG8_SB(b, h) + boff + n * 2048 + k * 1024); } while (0)
#define PG8_MMA(ai, bj, At, Bt) do { __builtin_amdgcn_s_setprio(1); _Pragma("unroll") for (int m = 0; m < 4; ++m) _Pragma("unroll") for (int n = 0; n < 2; ++n) _Pragma("unroll") for (int k = 0; k < 2; ++k) \
        acc[ai][bj][m][n] = __builtin_amdgcn_mfma_f32_16x16x32_bf16(Bt[n][k], At[m][k], acc[ai][bj][m][n], 0, 0, 0); __builtin_amdgcn_s_setprio(0); } while (0)
#define PG8_WAIT_V(n) asm volatile("s_waitcnt vmcnt(" #n ")" ::: "memory")
#define PG8_WAIT_L(n) asm volatile("s_waitcnt lgkmcnt(" #n ")" ::: "memory")
#define PG8_BAR __builtin_amdgcn_s_barrier()
#define PG8_SCHED __builtin_amdgcn_sched_barrier(0)
    Unit cur, nxt; int ui = 0;
    if (!S.next(0, cur)) return;
    f32x4 acc[2][2][4][2];
#pragma unroll
    for (int a = 0; a < 2; ++a)
#pragma unroll
        for (int b = 0; b < 2; ++b)
#pragma unroll
            for (int m = 0; m < 4; ++m)
#pragma unroll
                for (int n = 0; n < 2; ++n) acc[a][b][m][n] = (f32x4){0.f, 0.f, 0.f, 0.f};
    bf16x8 At[4][2], B0[2][2], B1[2][2];
    const char* cA = (const char*)g.A + (size_t)cur.pm * tstep; const char* cB = (const char*)g.Bt + (size_t)cur.pn * tstepB;
    S.a_ready(cur);
    if constexpr (SP2) {
        PG8_STAGE(PG8_SB(0, 0), cB, voffB); PG8_STAGE(PG8_SB(0, 1), cB + hstepB, voffB); PG8_STAGE(PG8_SA(0, 0), cA, voffA); PG8_STAGE(PG8_SA(0, 1), cA + hstep, voffA);
        if (wr == 1) PG8_BAR;
        PG8_WAIT_V(2); PG8_BAR;
        PG8_STAGE(PG8_SB(1, 0), cB + kstep, voffB); PG8_STAGE(PG8_SA(1, 0), cA + kstep, voffA); PG8_STAGE(PG8_SB(1, 1), cB + hstepB + kstep, voffB);
        PG8_WAIT_V(6); PG8_BAR;
    } else {
        PG8_STAGE(PG8_SB(0, 0), cB, voffB); PG8_STAGE(PG8_SA(0, 0), cA, voffA); PG8_STAGE(PG8_SB(0, 1), cB + hstepB, voffB); PG8_STAGE(PG8_SA(0, 1), cA + hstep, voffA);
        if (wr == 1) PG8_BAR;
        PG8_WAIT_V(4); PG8_BAR;
        PG8_STAGE(PG8_SB(1, 0), cB + kstep, voffB); PG8_STAGE(PG8_SA(1, 0), cA + kstep, voffA); PG8_STAGE(PG8_SB(1, 1), cB + hstepB + kstep, voffB);
        PG8_WAIT_V(6); PG8_BAR;
    }
    for (;;) {
        const bool has_next = S.next(ui + 1, nxt);
        const char* nA = has_next ? (const char*)g.A + (size_t)nxt.pm * tstep : cA; const char* nB = has_next ? (const char*)g.Bt + (size_t)nxt.pn * tstepB : cB;
        for (int t = 0; t < nt; t += 2) {
            const bool last = (t == nt - 2);
            const char* a1 = cA + (size_t)(t + 1) * kstep;
            const char* a2 = last ? nA : cA + (size_t)(t + 2) * kstep; const char* b2 = last ? nB : cB + (size_t)(t + 2) * kstep;
            const char* a3 = a2 + kstep; const char* b3 = b2 + kstep;
            if (last && has_next) S.a_ready(nxt);
            const bool resid = last && !has_next && resid_mode;
            const char* rg = (const char*)E.R + ((size_t)cur.pm * BM * E.ldc + (size_t)cur.pn * BM) * 2;
#define PG8_RG(j) (rg + (size_t)(((j) >> 2) * HALF + ((j) & 3) * 16) * E.ldc * 2)
            const unsigned vsA[2] = {resid ? voffR[0] : voffA[0], resid ? voffR[1] : voffA[1]}, vsB[2] = {resid ? voffR[0] : voffB[0], resid ? voffR[1] : voffB[1]};
            if constexpr (SP2) {
            PG8_LDB(B0, 0, 0); PG8_LDB(B1, 0, 1); PG8_SCHED; PG8_LDA(At, 0, 0); PG8_STAGE(PG8_SA(1, 1), a1 + hstep, voffA);
            PG8_WAIT_V(8); PG8_WAIT_L(0); PG8_BAR; PG8_MMA(0, 0, At, B0); PG8_MMA(0, 1, At, B1); PG8_BAR; PG8_SCHED;
            PG8_LDA(At, 0, 1); PG8_STAGE(PG8_SB(0, 0), resid ? PG8_RG(0) : b2, vsB); PG8_STAGE(PG8_SB(0, 1), resid ? PG8_RG(1) : b2 + hstepB, vsB); PG8_STAGE(PG8_SA(0, 0), resid ? PG8_RG(2) : a2, vsA);
            PG8_WAIT_V(8); PG8_WAIT_L(0); PG8_BAR; PG8_MMA(1, 0, At, B0); PG8_MMA(1, 1, At, B1); PG8_BAR; PG8_SCHED;
            PG8_LDB(B0, 1, 0); PG8_LDB(B1, 1, 1); PG8_SCHED; PG8_LDA(At, 1, 0); PG8_STAGE(PG8_SA(0, 1), resid ? PG8_RG(3) : a2 + hstep, vsA);
            PG8_WAIT_V(8); PG8_WAIT_L(0); PG8_BAR; PG8_MMA(0, 0, At, B0); PG8_MMA(0, 1, At, B1); PG8_BAR; PG8_SCHED;
            PG8_LDA(At, 1, 1); PG8_STAGE(PG8_SB(1, 0), resid ? PG8_RG(4) : b3, vsB); PG8_STAGE(PG8_SB(1, 1), resid ? PG8_RG(5) : b3 + hstepB, vsB); PG8_STAGE(PG8_SA(1, 0), resid ? PG8_RG(6) : a3, vsA);
            PG8_WAIT_V(8); PG8_WAIT_L(0); PG8_BAR; PG8_MMA(1, 0, At, B0); PG8_MMA(1, 1, At, B1); PG8_BAR; PG8_SCHED;
            } else {
            PG8_LDB(B0, 0, 0); PG8_SCHED; PG8_LDA(At, 0, 0); PG8_STAGE(PG8_SA(1, 1), a1 + hstep, voffA);
            PG8_WAIT_L(8); PG8_BAR; PG8_WAIT_L(0); PG8_MMA(0, 0, At, B0); PG8_BAR; PG8_SCHED;
            PG8_LDB(B1, 0, 1); PG8_STAGE(PG8_SB(0, 0), b2, voffB);
            PG8_BAR; PG8_WAIT_L(0); PG8_MMA(0, 1, At, B1); PG8_BAR;
            PG8_LDA(At, 0, 1); PG8_STAGE(PG8_SA(0, 0), a2, voffA);
            PG8_BAR; PG8_WAIT_L(0); PG8_MMA(1, 0, At, B0); PG8_BAR; PG8_SCHED;
            PG8_STAGE(PG8_SB(0, 1), b2 + hstepB, voffB);
            PG8_WAIT_V(6); PG8_BAR; PG8_MMA(1, 1, At, B1); PG8_BAR;
            PG8_LDB(B0, 1, 0); PG8_SCHED; PG8_LDA(At, 1, 0); PG8_STAGE(PG8_SA(0, 1), a2 + hstep, voffA);
            PG8_WAIT_L(8); PG8_BAR; PG8_WAIT_L(0); PG8_MMA(0, 0, At, B0); PG8_BAR; PG8_SCHED;
            PG8_LDB(B1, 1, 1); PG8_STAGE(PG8_SB(1, 0), b3, voffB);
            PG8_BAR; PG8_WAIT_L(0); PG8_MMA(0, 1, At, B1); PG8_BAR;
            PG8_LDA(At, 1, 1); PG8_STAGE(PG8_SA(1, 0), a3, voffA);
            PG8_BAR; PG8_WAIT_L(0); PG8_MMA(1, 0, At, B0); PG8_BAR; PG8_SCHED;
            PG8_STAGE(PG8_SB(1, 1), b3 + hstepB, voffB);
            PG8_WAIT_V(6); PG8_BAR; PG8_MMA(1, 1, At, B1); PG8_BAR;
            }
        }
        if constexpr (ALIGN_EPI) { if (wr == 0) PG8_BAR; }
        if constexpr (!Epi::AFTER_DRAIN) { E(acc, cur, wr, wc, fr, fq, (!has_next && resid_mode) ? lds + ldsw : (PG8_LAS unsigned char*)nullptr); S.done(cur); }
        if (!has_next) break;
#pragma unroll
        for (int a = 0; a < 2; ++a)
#pragma unroll
            for (int b = 0; b < 2; ++b)
#pragma unroll
                for (int m = 0; m < 4; ++m)
#pragma unroll
                    for (int n = 0; n < 2; ++n) acc[a][b][m][n] = (f32x4){0.f, 0.f, 0.f, 0.f};
        cur = nxt; cA = nA; cB = nB; ++ui;
        if constexpr (ALIGN_EPI) { if (wr == 1) PG8_BAR; }
    }
    PG8_WAIT_V(0);
    if constexpr (!ALIGN_EPI) { if (wr == 0) PG8_BAR; }
    PG8_BAR;
    if constexpr (Epi::AFTER_DRAIN) { E.fused(acc, cur, wr, wc, fr, fq, lds, wid, lane); S.done(cur); }
#undef PG8_SA
#undef PG8_SB
#undef PG8_STAGE
#undef PG8_RG
#undef PG8_LDA
#undef PG8_LDB
#undef PG8_MMA
#undef PG8_WAIT_V
#undef PG8_WAIT_L
#undef PG8_BAR
#undef PG8_SCHED
}
}

#ifndef PG8_SP2
#define PG8_SP2 true
#endif
#ifndef PG8_ALIGN
#define PG8_ALIGN true
#endif
constexpr int NWAVES = 8;
constexpr int D = 1024, BATCH = 4, SEQ = 8192, DEPTH = 2;
constexpr int M = BATCH * SEQ;
constexpr int NIN = 1792, FF = 4096;
constexpr int ZQ = 0, ZK = 512, ZV = 640, ZCV = 768, ZCG = 1024, ZRX = 1280, ZRG = 1536;
constexpr float RMS_EPS = 1e-6f, LN_EPS = 1e-5f;
constexpr size_t MiB = 1u << 20;
constexpr size_t WS_CTL = 0, CTL_ZERO_BYTES = 160 * 1024;
constexpr size_t WS_WFRAG = 1 * MiB; constexpr int WFRAG_LAYER = 64 * 512;
constexpr size_t WS_W = 2 * MiB, W_LAYER = 22 * MiB, W_IN = 0, W_OUT = 4 * MiB, W_UP = 6 * MiB, W_DOWN = 14 * MiB;
constexpr size_t WS_SSP = 46 * MiB;
constexpr int HB_LD = D + 64;
constexpr size_t WS_HB = 386 * MiB;
constexpr size_t WS_Z = 112 * MiB;
constexpr int YM_LD = D + 64, HH_LD = FF + 64;
constexpr size_t WS_YMIX = 224 * MiB;
constexpr size_t WS_HH = 112 * MiB;


constexpr size_t WS_SSP2 = 48 * MiB;
constexpr size_t WS_UBUF = 50 * MiB;
constexpr size_t WS_END = 458 * MiB;
constexpr int CW_FIN = 18432;
constexpr int CW_BAR = 4096;
constexpr int RING_OFF = 0, RING_BYTES = 131072;
constexpr int LDSCTL_OFF = RING_BYTES, MISC_OFF = LDSCTL_OFF + 320;
static_assert((CW_FIN + 256 * 64) * 4 <= (int)CTL_ZERO_BYTES && (CW_BAR + 4 * 3456) <= CW_FIN, "control words inside the memset region");
constexpr int LDS_BYTES = 163840;
#define GAS __attribute__((address_space(1)))
#define LAS __attribute__((address_space(3)))
typedef unsigned short bf16;
typedef unsigned v4u __attribute__((ext_vector_type(4)));
typedef float f32x4 __attribute__((ext_vector_type(4)));
typedef short bf16x8 __attribute__((ext_vector_type(8)));
typedef GAS unsigned gu32;
typedef GAS unsigned long long gu64;
#define RLX_AGENT __ATOMIC_RELAXED, __HIP_MEMORY_SCOPE_AGENT
#define LDS_WAIT() asm volatile("s_waitcnt lgkmcnt(0)" ::: "memory")
#define VM_WAIT() asm volatile("s_waitcnt vmcnt(0)" ::: "memory")
__device__ __forceinline__ unsigned long long rt() { return __builtin_amdgcn_s_memrealtime(); }
__device__ __forceinline__ unsigned f2bf(float f) { unsigned u = __builtin_bit_cast(unsigned, f); return (u + 0x7fffu + ((u >> 16) & 1u)) >> 16; }
__device__ __forceinline__ unsigned pk2(float lo, float hi) { return f2bf(lo) | (f2bf(hi) << 16); }
#define XB_TMO      128
#define XB_XCNT(j)  (256  + 64 * (j))
#define XB_XSUB(j)  (1280 + 64 * (j))
#define XB_XGEN(j)  (2304 + 64 * (j))
#define XB_TOP      3328
#define XB_TOPGEN   3392
#define XCD_BAR_WORDS 3456
#define XB_SPIN_CAP (1u << 18)

__device__ __forceinline__ unsigned xb_ld(unsigned* p)              { return __hip_atomic_load(p, __ATOMIC_RELAXED, __HIP_MEMORY_SCOPE_AGENT); }
__device__ __forceinline__ unsigned xb_add(unsigned* p, unsigned v) { return __hip_atomic_fetch_add(p, v, __ATOMIC_RELAXED, __HIP_MEMORY_SCOPE_AGENT); }
__device__ __forceinline__ unsigned xb_xcc_id() { return (unsigned)__builtin_amdgcn_s_getreg((3 << 11) | 20) & 0xFu; }
#define XB_SPIN(cond, bar) do { unsigned _sp = 0; while (cond) { \
    if ((++_sp & 255u) == 0u) { if (xb_ld(&(bar)[XB_TMO])) break; if (_sp > XB_SPIN_CAP) { atomicAdd(&(bar)[XB_TMO], 1u); break; } } } } while (0)

struct XcdBarrier {
    unsigned* bar; unsigned x;
    volatile LAS unsigned* st;
};

__device__ __forceinline__ XcdBarrier xcd_barrier_post(unsigned* bar, volatile LAS unsigned* st) {
    XcdBarrier b; b.bar = bar; b.x = xb_xcc_id(); b.st = st;
    if (threadIdx.x == 0) (void)xb_add(&bar[XB_XCNT(b.x)], 1u);
    return b;
}
__device__ __forceinline__ void xcd_barrier_complete(unsigned* bar, unsigned x, unsigned& nloc, unsigned& nx) {
    const unsigned G = gridDim.x * gridDim.y * gridDim.z;
    unsigned sum, cnt, mine, sp = 0u;
    for (;;) {
        sum = 0u; cnt = 0u; mine = 0u;
#pragma unroll
        for (unsigned j = 0; j < 16; ++j) { const unsigned c = xb_ld(&bar[XB_XCNT(j)]); sum += c; cnt += (c > 0u) ? 1u : 0u; mine = (j == x) ? c : mine; }
        if (sum == G) break;
        if ((++sp & 255u) == 0u) { if (xb_ld(&bar[XB_TMO])) break; if (sp > XB_SPIN_CAP) { atomicAdd(&bar[XB_TMO], 1u); break; } }
    }
    nloc = mine > 0u ? mine : 1u; nx = cnt > 0u ? cnt : 1u;
}

__device__ __forceinline__ void xcd_barrier(const XcdBarrier& b) {
    asm volatile("s_waitcnt vmcnt(0)" ::: "memory");
    __syncthreads();
    if (threadIdx.x == 0) {
        unsigned* bar = b.bar;
        __builtin_amdgcn_s_waitcnt(0);
        unsigned nloc = b.st[0], nx = b.st[1]; const unsigned kbar = b.st[2]; b.st[2] = kbar + 1u;
        if (nloc == 0u) { xcd_barrier_complete(bar, b.x, nloc, nx); b.st[0] = nloc; b.st[1] = nx; }
        const unsigned old = xb_add(&bar[XB_XSUB(b.x)], 1u);
        const unsigned gen = old / nloc;
        if (old + 1u == (gen + 1u) * nloc) {
            __builtin_amdgcn_fence(__ATOMIC_RELEASE, "agent");
            asm volatile("s_waitcnt vmcnt(0)" ::: "memory");
            __hip_atomic_fetch_add(&bar[XB_TOP], 1u, __ATOMIC_RELAXED, __HIP_MEMORY_SCOPE_AGENT);
            __builtin_amdgcn_fence(__ATOMIC_ACQUIRE, "agent");
            XB_SPIN(xb_ld(&bar[XB_TOP]) < (kbar + 1u) * nx, bar);
            asm volatile("s_waitcnt vmcnt(0)" ::: "memory");
        } else {
            __builtin_amdgcn_fence(__ATOMIC_ACQUIRE, "agent");
            XB_SPIN(xb_ld(&bar[XB_TOP]) < (kbar + 1u) * nx, bar);
            asm volatile("s_waitcnt vmcnt(0)" ::: "memory");
        }
    }
    __syncthreads();
}

template <int CTRL> __device__ __forceinline__ float dppmov(float v) { return __builtin_bit_cast(float, __builtin_amdgcn_update_dpp(0, __builtin_bit_cast(int, v), CTRL, 0xf, 0xf, true)); }
__device__ __forceinline__ float wave_sum(float v) {
    v += dppmov<0xB1>(v); v += dppmov<0x4E>(v); v += dppmov<0x141>(v); v += dppmov<0x140>(v);
    return (__builtin_bit_cast(float, __builtin_amdgcn_readlane(__builtin_bit_cast(int, v), 0)) + __builtin_bit_cast(float, __builtin_amdgcn_readlane(__builtin_bit_cast(int, v), 16)))
         + (__builtin_bit_cast(float, __builtin_amdgcn_readlane(__builtin_bit_cast(int, v), 32)) + __builtin_bit_cast(float, __builtin_amdgcn_readlane(__builtin_bit_cast(int, v), 48)));
}
__device__ __forceinline__ float bf2f(unsigned short b) { return __builtin_bit_cast(float, (unsigned)b << 16); }
__device__ __forceinline__ float sigmoidf_(float x) { return __builtin_amdgcn_rcpf(1.f + __builtin_amdgcn_exp2f(-1.4426950408889634f * x)); }

namespace mix {
typedef short bf16x8 __attribute__((ext_vector_type(8)));
typedef short s16x4 __attribute__((ext_vector_type(4)));
typedef float f32x16 __attribute__((ext_vector_type(16)));
typedef float f32x2 __attribute__((ext_vector_type(2)));
typedef unsigned u32x2 __attribute__((ext_vector_type(2)));
constexpr float LOG2E = 1.4426950408889634f;
constexpr float QSCALE = 0.125f * LOG2E;
constexpr int ATT_K = 0, ATT_V = 65536;
constexpr int XCH_OFF = RING_BYTES + 1024;
constexpr size_t WS_AGG = 296 * MiB;
constexpr int NUNIT = BATCH * 64;
constexpr int SUB0_OFF = XCH_OFF + 2048;
constexpr int CWT_OFF = XCH_OFF + 4096;
constexpr int SEG_OFF = XCH_OFF + 12288;
static_assert(SEG_OFF + 16384 <= LDS_BYTES, "LDS exchange tables");

__device__ __forceinline__ int crow(int r, int hi) { return (r & 3) + 8 * (r >> 2) + 4 * hi; }
__device__ __forceinline__ float xhalf_max(float v) { auto rr = __builtin_amdgcn_permlane32_swap(__float_as_uint(v), __float_as_uint(v), false, false); return fmaxf(__uint_as_float(rr[0]), __uint_as_float(rr[1])); }
__device__ __forceinline__ float xhalf_sum(float v) { auto rr = __builtin_amdgcn_permlane32_swap(__float_as_uint(v), __float_as_uint(v), false, false); return __uint_as_float(rr[0]) + __uint_as_float(rr[1]); }
__device__ __forceinline__ float xhalf_other(float v) { auto rr = __builtin_amdgcn_permlane32_swap(__float_as_uint(v), __float_as_uint(v), false, false); return (threadIdx.x & 32) ? __uint_as_float(rr[0]) : __uint_as_float(rr[1]); }
__device__ __forceinline__ s16x4 vtr(const LAS unsigned char* p) { typedef short v4i16_t __attribute__((ext_vector_type(4))); return __builtin_bit_cast(s16x4, __builtin_amdgcn_ds_read_tr16_b64_v4i16((LAS v4i16_t*)p)); }
__device__ __forceinline__ unsigned cvtpk(float lo, float hi) { typedef __bf16 bf16x2_t __attribute__((ext_vector_type(2))); f32x2 v = {lo, hi}; bf16x2_t b = __builtin_convertvector(v, bf16x2_t); return __builtin_bit_cast(unsigned, b); }
__device__ __forceinline__ void fmac_s(float& acc, float a, float b) { asm("v_fmac_f32_e32 %0, %1, %2" : "+v"(acc) : "v"(a), "v"(b)); }
__device__ __forceinline__ float bflo(unsigned w) { return __builtin_bit_cast(float, w << 16); }
__device__ __forceinline__ float bfhi(unsigned w) { return __builtin_bit_cast(float, w & 0xffff0000u); }

__device__ __forceinline__ void attn_unit(LAS unsigned char* lds, const bf16* z, bf16* ymix, const float* sinks, int b, int n, int tid) {
    asm volatile("" : "+v"(tid));
    const int lane = tid & 63, wid = __builtin_amdgcn_readfirstlane(tid >> 6), r32 = lane & 31, hi = lane >> 5;
    const size_t row0 = (size_t)b * SEQ + (size_t)n * 128;
    const int hq = wid, hkv = wid >> 2;
    bf16x8 qr[4];
#pragma unroll
    for (int d0 = 0; d0 < 4; ++d0) qr[d0] = __builtin_nontemporal_load((const GAS bf16x8*)(z + (row0 + r32) * NIN + ZQ + hq * 64 + 16 * d0 + 8 * hi));
#ifndef AREP_STAGE
#define AREP_STAGE 1
#define AREP_LOOP 1
#endif
    for (int arep_ = 0; arep_ < AREP_STAGE; ++arep_) {
    if (arep_) __syncthreads();
#pragma unroll
    for (int half = 0; half < 2; ++half) {
        v4u v[8];
        const bool have = (half == 1) || (n > 0);
#pragma unroll
        for (int i = 0; i < 8; ++i) { const int pi = (half * 8 + i) * 512 + tid, token = pi >> 5, c32 = pi & 31;
            if (have) v[i] = __builtin_nontemporal_load((const GAS v4u*)(z + (row0 + token - 128) * NIN + ZK + 8 * c32)); else v[i] = (v4u){0u, 0u, 0u, 0u}; }
#pragma unroll
        for (int i = 0; i < 8; ++i) { const int pi = (half * 8 + i) * 512 + tid, token = pi >> 5, c32 = pi & 31, kind = c32 >> 3, c = c32 & 7;
            const int dst = (kind < 2) ? (ATT_K + (kind & 1) * 32768 + token * 128 + ((c ^ ((token >> 1) & 7)) << 4))
                                       : (ATT_V + (kind & 1) * 32768 + (c >> 2) * 16384 + token * 64 + (c & 3) * 16);
            *(LAS v4u*)(lds + dst) = v[i]; }
    }
    }
    __syncthreads();
    const float sink2 = sinks[hq] * LOG2E;
    const LAS unsigned char* Kb = lds + ATT_K + hkv * 32768;
    const LAS unsigned char* Vb = lds + ATT_V + hkv * 32768 + ((lane >> 4) & 1) * 32 + (lane & 3) * 8 + (4 * hi + ((lane & 15) >> 2)) * 64;
    int koff[4];
#pragma unroll
    for (int d0 = 0; d0 < 4; ++d0) koff[d0] = r32 * 128 + (((2 * d0 + hi) ^ ((r32 >> 1) & 7)) << 4);
    LAS float* part = (LAS float*)(lds + XCH_OFF);
    const float NEG = -INFINITY;
    f32x16 mask0, mask4;
#pragma unroll
    for (int r = 0; r < 16; ++r) { const int cr = crow(r, hi); mask0[r] = (cr > r32) ? 0.f : NEG; mask4[r] = (cr <= r32) ? 0.f : NEG; }
    bf16x8 ones;
#pragma unroll
    for (int e = 0; e < 8; ++e) ones[e] = (short)0x3F80;
#pragma unroll 1
    for (int i4_ = 0; i4_ < 4 * AREP_LOOP; ++i4_) { const int i = i4_ & 3;
        const size_t qrow = row0 + 32 * i + r32;
        bf16x8 qn[4];
        { const size_t qnrow = row0 + 32 * ((i4_ + 1) & 3) + r32;
#pragma unroll
          for (int d0 = 0; d0 < 4; ++d0) qn[d0] = __builtin_nontemporal_load((const GAS bf16x8*)(z + qnrow * NIN + ZQ + hq * 64 + 16 * d0 + 8 * hi)); }
        const LAS unsigned char* kbi = Kb + 4096 * i;
        const LAS unsigned char* vbi = Vb + 2048 * i;
        f32x16 s[5];
#pragma unroll
        for (int kt = 0; kt < 5; ++kt) { s[kt] = kt == 0 ? mask0 : kt == 4 ? mask4 : (f32x16){};
#pragma unroll
            for (int d0 = 0; d0 < 4; ++d0) { const bf16x8 kf = *(const LAS bf16x8*)(kbi + 4096 * kt + koff[d0]); s[kt] = __builtin_amdgcn_mfma_f32_32x32x16_bf16(kf, qr[d0], s[kt], 0, 0, 0); } }
        if (n == 0) {
#pragma unroll
            for (int kt = 0; kt < 4; ++kt) if (i + kt < 4) {
#pragma unroll
                for (int r = 0; r < 16; ++r) s[kt][r] = NEG; } }
        float m = sink2;
#pragma unroll
        for (int kt = 0; kt < 5; ++kt)
#pragma unroll
            for (int r = 0; r < 16; r += 2) m = fmaxf(fmaxf(m, s[kt][r]), s[kt][r + 1]);
        m = xhalf_max(m);
#pragma unroll
        for (int kt = 0; kt < 5; ++kt)
#pragma unroll
            for (int r = 0; r < 16; ++r) s[kt][r] = __builtin_amdgcn_exp2f(s[kt][r] - m);
        f32x16 o[2], ls; o[0] = (f32x16){}; o[1] = (f32x16){}; ls = (f32x16){};
#pragma unroll
        for (int kt = 0; kt < 5; ++kt)
#pragma unroll
            for (int s2 = 0; s2 < 2; ++s2) {
                v4u pw; pw.x = cvtpk(s[kt][8 * s2 + 0], s[kt][8 * s2 + 1]); pw.y = cvtpk(s[kt][8 * s2 + 2], s[kt][8 * s2 + 3]); pw.z = cvtpk(s[kt][8 * s2 + 4], s[kt][8 * s2 + 5]); pw.w = cvtpk(s[kt][8 * s2 + 6], s[kt][8 * s2 + 7]);
                const bf16x8 pf = __builtin_bit_cast(bf16x8, pw);
#pragma unroll
                for (int blk = 0; blk < 2; ++blk) {
                    const s16x4 lo = vtr(vbi + (blk * 16384 + 2048 * kt + 1024 * s2)), hi4 = vtr(vbi + (blk * 16384 + 2048 * kt + 1024 * s2 + 512));
                    const bf16x8 vf = (bf16x8){lo[0], lo[1], lo[2], lo[3], hi4[0], hi4[1], hi4[2], hi4[3]};
                    o[blk] = __builtin_amdgcn_mfma_f32_32x32x16_bf16(vf, pf, o[blk], 0, 0, 0); }
                ls = __builtin_amdgcn_mfma_f32_32x32x16_bf16(ones, pf, ls, 0, 0, 0);
            }
        const float inv = __builtin_amdgcn_rcpf(ls[0] + __builtin_amdgcn_exp2f(sink2 - m)); float ss = 0.f;
#pragma unroll
        for (int blk = 0; blk < 2; ++blk)
#pragma unroll
            for (int r = 0; r < 16; ++r) ss = fmaf(o[blk][r], o[blk][r], ss);
        ss = xhalf_sum(ss) * (inv * inv);
        LAS float* pp = part + (i4_ & 1) * 256;
        if (hi == 0) pp[wid * 32 + r32] = ss;
        __syncthreads();
        float tot = 0.f;
#pragma unroll
        for (int w = 0; w < 8; ++w) tot += pp[w * 32 + r32];
        const float rs = __builtin_amdgcn_rsqf(tot * (1.0f / 512.0f) + RMS_EPS) * inv;
        bf16* orow = ymix + qrow * YM_LD + hq * 64 + 8 * hi;
#pragma unroll
        for (int blk = 0; blk < 2; ++blk)
#pragma unroll
            for (int gp = 0; gp < 2; ++gp) { const int ge = 2 * gp, go = 2 * gp + 1;
                const unsigned ex = cvtpk(o[blk][4 * ge] * rs, o[blk][4 * ge + 1] * rs), ey = cvtpk(o[blk][4 * ge + 2] * rs, o[blk][4 * ge + 3] * rs);
                const unsigned ox = cvtpk(o[blk][4 * go] * rs, o[blk][4 * go + 1] * rs), oy = cvtpk(o[blk][4 * go + 2] * rs, o[blk][4 * go + 3] * rs);
                auto sx = __builtin_amdgcn_permlane32_swap(ex, ox, false, false); auto sy = __builtin_amdgcn_permlane32_swap(ey, oy, false, false);
                v4u w; w.x = sx[0]; w.y = sy[0]; w.z = sx[1]; w.w = sy[1];
                *(GAS v4u*)(orow + 32 * blk + 16 * gp) = w; }
#pragma unroll
        for (int d0 = 0; d0 < 4; ++d0) qr[d0] = qn[d0];
    }
    __syncthreads();
}

__device__ __forceinline__ void conv_unit(LAS unsigned char* lds, const bf16* ub, bf16* ymix, const float* dw_w, const float* dw_b, const float* ln_g, const float* ln_b, int b, int n, int tid) {
    asm volatile("" : "+v"(tid));
    const int lane = tid & 63, wid = __builtin_amdgcn_readfirstlane(tid >> 6);
    LAS float* U = (LAS float*)lds;
    const int cp = tid & 127, tg = tid >> 7;
    f32x2 w[31];
#pragma unroll
    for (int k = 0; k < 31; ++k) w[k] = *(const GAS f32x2*)(dw_w + k * 256 + 2 * cp);
    const f32x2 bias = *(const GAS f32x2*)(dw_b + 2 * cp);
    const f32x4 lg = *(const GAS f32x4*)(ln_g + 4 * lane), lb = *(const GAS f32x4*)(ln_b + 4 * lane);
#pragma unroll 1
    for (int half = 0; half < 2; ++half) {
        const int t0 = n * 128 + half * 64;
        const size_t rowb = (size_t)b * SEQ;
        {
            v4u vv[6];
#pragma unroll
            for (int j = 0; j < 6; ++j) { const int task = tid + 512 * j, r = task >> 5, c8 = task & 31, tt = t0 - 30 + r;
                if (task < 94 * 32 && tt >= 0) vv[j] = __builtin_nontemporal_load((const GAS v4u*)(ub + (rowb + tt) * 256 + 8 * c8)); else vv[j] = (v4u){0u, 0u, 0u, 0u}; }
#pragma unroll
            for (int j = 0; j < 6; ++j) { const int task = tid + 512 * j, r = task >> 5, c8 = task & 31;
                if (task < 94 * 32) { const f32x4 u0 = (f32x4){bflo(vv[j].x), bfhi(vv[j].x), bflo(vv[j].y), bfhi(vv[j].y)}, u1 = (f32x4){bflo(vv[j].z), bfhi(vv[j].z), bflo(vv[j].w), bfhi(vv[j].w)};
                    *(LAS f32x4*)(U + r * 256 + 8 * c8) = u0; *(LAS f32x4*)(U + r * 256 + 8 * c8 + 4) = u1; } }
        }
        __syncthreads();
        float acc0[2][8], acc1[2][8];
#pragma unroll
        for (int g = 0; g < 2; ++g) {
            const LAS float* up = U + (tg * 16 + g * 8) * 256 + 2 * cp;
#pragma unroll
            for (int jj = 0; jj < 8; ++jj) { acc0[g][jj] = bias[0]; acc1[g][jj] = bias[1]; }
#pragma unroll
            for (int rr = 0; rr < 38; ++rr) { const f32x2 u2 = *(const LAS f32x2*)(up + rr * 256);
#pragma unroll
                for (int jj = 0; jj < 8; ++jj) { const int k = rr - jj; if (k >= 0 && k <= 30) { fmac_s(acc0[g][jj], w[k][0], u2[0]); fmac_s(acc1[g][jj], w[k][1], u2[1]); } } }
        }
        __syncthreads();
#pragma unroll
        for (int g = 0; g < 2; ++g)
#pragma unroll
            for (int jj = 0; jj < 8; ++jj) *(LAS f32x2*)(U + (tg * 16 + g * 8 + jj) * 256 + 2 * cp) = (f32x2){acc0[g][jj], acc1[g][jj]};
        __syncthreads();
#pragma unroll
        for (int jj = 0; jj < 8; ++jj) { const int tok = wid * 8 + jj;
            f32x4 x = *(const LAS f32x4*)(U + tok * 256 + 4 * lane);
            const float s1 = wave_sum((x[0] + x[1]) + (x[2] + x[3])), s2 = wave_sum((x[0] * x[0] + x[1] * x[1]) + (x[2] * x[2] + x[3] * x[3]));
            const float mu = s1 * (1.f / 256.f);
            x = x - mu;
            const float var = fmaxf(s2 * (1.f / 256.f) - mu * mu, 0.f);
            const float rstd = __builtin_amdgcn_rsqf(var + LN_EPS);
            f32x4 y = x * rstd * lg + lb;
#pragma unroll
            for (int e = 0; e < 4; ++e) y[e] = y[e] * sigmoidf_(y[e]);
            const float ss = wave_sum((y[0] * y[0] + y[1] * y[1]) + (y[2] * y[2] + y[3] * y[3]));
            const float rs = __builtin_amdgcn_rsqf(ss * (1.f / 256.f) + RMS_EPS);
            u32x2 o; o.x = cvtpk(y[0] * rs, y[1] * rs); o.y = cvtpk(y[2] * rs, y[3] * rs);
            *(GAS u32x2*)(ymix + (rowb + t0 + tok) * YM_LD + 512 + 4 * lane) = o; }
        __syncthreads();
    }
}

struct LruState { f32x16 H[2][2]; };
__device__ __forceinline__ bf16x8 ident_frag(int s, int hi, int col) {
    bf16x8 f;
#pragma unroll
    for (int e = 0; e < 8; ++e) f[e] = (16 * s + 8 * hi + e == col) ? (short)0x3F80 : (short)0;
    return f;
}
__device__ __forceinline__ void lru_tables(LAS unsigned char* lds, const float* cw, const float* cb, const float* ba, const float* bx, const float* lam, int tid) {
    LAS float* cwt = (LAS float*)(lds + CWT_OFF);
    for (int e = tid; e < 1024; e += 512) cwt[e] = cw[e];
    if (tid < 256) { cwt[1024 + tid] = cb[tid]; cwt[1280 + tid] = ba[tid]; }
    else { const int c = tid - 256; cwt[1536 + c] = bx[c]; const float lm = -lam[c]; cwt[1792 + c] = fmaxf(lm, 0.f) + log1pf(__expf(-fabsf(lm))); }
}
__device__ __forceinline__ int pidx(int token, int ch) { return token * 256 + (ch ^ ((token & 7) << 2)); }
__device__ __forceinline__ void lru_local(LruState& st, const bf16* z, const bf16* wfrag, float* agg, LAS unsigned char* lds, int b, int n, int tid) {
    asm volatile("" : "+v"(tid));
    const int lane = tid & 63, wid = __builtin_amdgcn_readfirstlane(tid >> 6), r32 = lane & 31, hi = lane >> 5, hd = wid >> 1, th = wid & 1;
    float fin[2][2];
    LAS float* PL = (LAS float*)lds;
    const LAS float* cwt = (const LAS float*)(lds + CWT_OFF);
    const size_t row_w = (size_t)b * SEQ + (size_t)n * 128 + th * 64;
    const int tseq_w = n * 128 + th * 64;
    v4u xv[4][4];
#define LRU_LOAD_ROWS(tm) do { const int tseq_ = tseq_w + 32 * (tm) + r32; _Pragma("unroll") for (int s = 0; s < 4; ++s) { const bf16* zp = z + (row_w + 32 * (tm) + r32) * NIN + ZRX + hd * 64 + 16 * s + 8 * hi; \
        _Pragma("unroll") for (int k = 0; k < 4; ++k) xv[s][k] = *(const GAS v4u*)(zp - (ptrdiff_t)(tseq_ >= 3 - k ? 3 - k : 0) * NIN); } } while (0)
#define LRU_BUILD_XF(tm) do { const int tseq_ = tseq_w + 32 * (tm) + r32, tok_ = th * 64 + 32 * (tm) + r32; _Pragma("unroll") for (int s = 0; s < 4; ++s) { const int ch = hd * 64 + 16 * s + 8 * hi; \
            f32x4 a0 = *(const LAS f32x4*)(cwt + 1024 + ch), a1 = *(const LAS f32x4*)(cwt + 1024 + ch + 4); \
            _Pragma("unroll") for (int k = 0; k < 4; ++k) { const float mk = tseq_ >= 3 - k ? 1.f : 0.f; \
                const f32x4 w0 = *(const LAS f32x4*)(cwt + k * 256 + ch), w1 = *(const LAS f32x4*)(cwt + k * 256 + ch + 4); \
                const v4u x = xv[s][k]; \
                a0[0] += w0[0] * (mk * bflo(x.x)); a0[1] += w0[1] * (mk * bfhi(x.x)); a0[2] += w0[2] * (mk * bflo(x.y)); a0[3] += w0[3] * (mk * bfhi(x.y)); \
                a1[0] += w1[0] * (mk * bflo(x.z)); a1[1] += w1[1] * (mk * bfhi(x.z)); a1[2] += w1[2] * (mk * bflo(x.w)); a1[3] += w1[3] * (mk * bfhi(x.w)); } \
            v4u pw; pw.x = cvtpk(a0[0], a0[1]); pw.y = cvtpk(a0[2], a0[3]); pw.z = cvtpk(a1[0], a1[1]); pw.w = cvtpk(a1[2], a1[3]); \
            xf[tm][s] = __builtin_bit_cast(bf16x8, pw); \
            *(LAS f32x4*)(PL + pidx(tok_, ch)) = a0; *(LAS f32x4*)(PL + pidx(tok_, ch + 4)) = a1; } \
        asm volatile("s_waitcnt lgkmcnt(0)" ::: "memory"); } while (0)
    LRU_LOAD_ROWS(0);
    bf16x8 waf[4], wxf[4];
#pragma unroll
    for (int s = 0; s < 4; ++s) { waf[s] = *(const GAS bf16x8*)(wfrag + ((size_t)((0 * 4 + hd) * 2 + 0) * 4 + s) * 512 + lane * 8); wxf[s] = *(const GAS bf16x8*)(wfrag + ((size_t)((1 * 4 + hd) * 2 + 0) * 4 + s) * 512 + lane * 8); }
    bf16x8 xf[2][4];
    LRU_BUILD_XF(0);
    LRU_LOAD_ROWS(1);
#pragma unroll
    for (int tn = 0; tn < 2; ++tn) {
        const int c = hd * 64 + 32 * tn + r32;
        const float bav = cwt[1280 + c], bxv = cwt[1536 + c], sp = cwt[1792 + c];
        int cx[4];
#pragma unroll
        for (int e = 0; e < 4; ++e) cx[e] = c ^ ((4 * hi + e) << 2);
        bf16x8 waf2[4], wxf2[4];
        float CA = 1.f, CB = 0.f;
#pragma unroll
        for (int tm = 0; tm < 2; ++tm) {
            __builtin_amdgcn_sched_barrier(0);
            if (tn == 0 && tm == 1) { LRU_BUILD_XF(1);
#pragma unroll
                for (int s = 0; s < 4; ++s) { waf2[s] = *(const GAS bf16x8*)(wfrag + ((size_t)((0 * 4 + hd) * 2 + 1) * 4 + s) * 512 + lane * 8); wxf2[s] = *(const GAS bf16x8*)(wfrag + ((size_t)((1 * 4 + hd) * 2 + 1) * 4 + s) * 512 + lane * 8); }
                __builtin_amdgcn_sched_barrier(0); }
            f32x16 ra = (f32x16){}, ia = (f32x16){};
#pragma unroll
            for (int s = 0; s < 4; ++s) { ra = __builtin_amdgcn_mfma_f32_32x32x16_bf16(xf[tm][s], waf[s], ra, 0, 0, 0); ia = __builtin_amdgcn_mfma_f32_32x32x16_bf16(xf[tm][s], wxf[s], ia, 0, 0, 0); }
            LAS float* pl = PL + (th * 64 + 32 * tm + 4 * hi) * 256;
#pragma unroll
            for (int r = 0; r < 16; ++r) { const float rg = sigmoidf_(ra[r] + bav), ig = sigmoidf_(ia[r] + bxv);
                const float a = __builtin_amdgcn_exp2f((-8.f * LOG2E) * rg * sp);
                ra[r] = a;
                ia[r] = __builtin_amdgcn_sqrtf(fmaf(-a, a, 1.f)) * (ig * pl[((r & 3) + 8 * (r >> 2)) * 256 + cx[r & 3]]); }
#pragma unroll
            for (int g = 0; g < 4; ++g)
#pragma unroll
                for (int e = 1; e < 4; ++e) { ia[4 * g + e] = ra[4 * g + e] * ia[4 * g + e - 1] + ia[4 * g + e]; ra[4 * g + e] = ra[4 * g + e] * ra[4 * g + e - 1]; }
#pragma unroll
            for (int g = 0; g < 4; ++g) {
                const float ownA = ra[4 * g + 3], ownB = ia[4 * g + 3];
                const float othA = xhalf_other(ownA), othB = xhalf_other(ownB);
                float EA = 0.f, EB = 0.f;
                { const float A = hi ? othA : ownA, B = hi ? othB : ownB; if (!hi) { EA = CA; EB = CB; } CB = A * CB + B; CA = A * CA; }
                { const float A = hi ? ownA : othA, B = hi ? ownB : othB; if (hi) { EA = CA; EB = CB; } CB = A * CB + B; CA = A * CA; }
#pragma unroll
                for (int e = 0; e < 4; ++e) { ia[4 * g + e] += ra[4 * g + e] * EB; pl[(e + 8 * g) * 256 + cx[e]] = ra[4 * g + e] * EA; }
            }
            st.H[tm][tn] = ia;
        }
        fin[tn][0] = CA; fin[tn][1] = CB;
        if (tn == 0) {
#pragma unroll
            for (int s = 0; s < 4; ++s) { waf[s] = waf2[s]; wxf[s] = wxf2[s]; } }
    }
#undef LRU_LOAD_ROWS
#undef LRU_BUILD_XF
    LAS f32x2* sub0 = (LAS f32x2*)(lds + SUB0_OFF);
    if (th == 0 && hi == 0) {
#pragma unroll
        for (int tn = 0; tn < 2; ++tn) sub0[(hd * 2 + tn) * 32 + r32] = (f32x2){fin[tn][0], fin[tn][1]}; }
    __syncthreads();
    if (th == 1 && hi == 0) {
#pragma unroll
        for (int tn = 0; tn < 2; ++tn) { const f32x2 f0 = sub0[(hd * 2 + tn) * 32 + r32]; const int c = hd * 64 + 32 * tn + r32, unit = b * 64 + n;
            agg[(size_t)unit * 256 + c] = fin[tn][0] * f0[0]; agg[(size_t)(NUNIT + unit) * 256 + c] = fin[tn][0] * f0[1] + fin[tn][1]; } }
}
__device__ __forceinline__ float gelu_tanh(float x) { const float u = 0.7978845608028654f * (x + 0.044715f * x * x * x); const float e = __expf(2.f * u); const float th = 1.f - 2.f * __builtin_amdgcn_rcpf(e + 1.f); return 0.5f * x * (1.f + th); }
__device__ __forceinline__ void lru_final(LruState& st, LAS unsigned char* lds, const bf16* z, bf16* ymix, const float* agg, int b, int n, int tid) {
    asm volatile("" : "+v"(tid));
    const int lane = tid & 63, wid = __builtin_amdgcn_readfirstlane(tid >> 6), r32 = lane & 31, hi = lane >> 5, hd = wid >> 1, th = wid & 1;
    const size_t row_u = (size_t)b * SEQ + (size_t)n * 128, row_w = row_u + th * 64;
    LAS float* Y = (LAS float*)lds;
    LAS f32x2* seg = (LAS f32x2*)(lds + SEG_OFF);
    { f32x4 SA = (f32x4){1.f, 1.f, 1.f, 1.f}, SB = (f32x4){0.f, 0.f, 0.f, 0.f}; f32x4 ta[8], tb[8];
      const float* aA = agg + (size_t)(b * 64) * 256 + 4 * lane; const float* aB = agg + (size_t)(NUNIT + b * 64) * 256 + 4 * lane;
#pragma unroll
      for (int jj = 0; jj < 8; ++jj) { const int j = 8 * wid + jj;
          if (j < n) { ta[jj] = *(const GAS f32x4*)(aA + (size_t)j * 256); tb[jj] = *(const GAS f32x4*)(aB + (size_t)j * 256); } else { ta[jj] = (f32x4){1.f, 1.f, 1.f, 1.f}; tb[jj] = (f32x4){0.f, 0.f, 0.f, 0.f}; } }
#pragma unroll
      for (int jj = 0; jj < 8; ++jj) { SB = ta[jj] * SB + tb[jj]; SA = ta[jj] * SA; }
#pragma unroll
      for (int e = 0; e < 4; ++e) seg[wid * 256 + 4 * lane + e] = (f32x2){SA[e], SB[e]}; }
    bf16x8 gf[2][4];
#pragma unroll
    for (int tm = 0; tm < 2; ++tm)
#pragma unroll
        for (int s = 0; s < 4; ++s) gf[tm][s] = __builtin_nontemporal_load((const GAS bf16x8*)(z + (row_w + 32 * tm + r32) * NIN + ZRG + hd * 64 + 16 * s + 8 * hi));
    __syncthreads();
#pragma unroll
    for (int tn = 0; tn < 2; ++tn) {
        const int col = 32 * tn + r32, c = hd * 64 + col;
        float carry = 0.f;
#pragma unroll
        for (int w = 0; w < 8; ++w) { const f32x2 sg = seg[w * 256 + c]; carry = sg[0] * carry + sg[1]; }
        if (th == 1) { const f32x2 f0 = ((const LAS f32x2*)(lds + SUB0_OFF))[(hd * 2 + tn) * 32 + r32]; carry = f0[0] * carry + f0[1]; }
#pragma unroll
        for (int tm = 0; tm < 2; ++tm) {
            f32x16 gd = (f32x16){};
#pragma unroll
            for (int s = 0; s < 4; ++s) gd = __builtin_amdgcn_mfma_f32_32x32x16_bf16(gf[tm][s], ident_frag(s, hi, col), gd, 0, 0, 0);
#pragma unroll
            for (int r = 0; r < 16; ++r) { LAS float* yp = Y + pidx(th * 64 + 32 * tm + crow(r, hi), c);
                const float h = st.H[tm][tn][r] + *yp * carry; *yp = h * gd[r]; }
        }
    }
    __syncthreads();
#pragma unroll
    for (int jj = 0; jj < 16; ++jj) { const int tok = wid * 16 + jj;
        const f32x4 y = *(const LAS f32x4*)(Y + pidx(tok, 4 * lane));
        const float ss = wave_sum((y[0] * y[0] + y[1] * y[1]) + (y[2] * y[2] + y[3] * y[3]));
        const float rs = __builtin_amdgcn_rsqf(ss * (1.f / 256.f) + RMS_EPS);
        u32x2 o; o.x = cvtpk(y[0] * rs, y[1] * rs); o.y = cvtpk(y[2] * rs, y[3] * rs);
        *(GAS u32x2*)(ymix + (row_u + tok) * YM_LD + 768 + 4 * lane) = o; }
    __syncthreads();
}
}

struct Frame {
    LAS unsigned char* lds;
    volatile LAS unsigned* MISC;
    gu32* ctl;
    int vcu, G;
};
__device__ __forceinline__ int otid() { int t = threadIdx.x; asm volatile("" : "+v"(t)); return t; }
struct Lw { int tid, lane, wave; __device__ __forceinline__ Lw() { tid = otid(); lane = tid & 63; wave = __builtin_amdgcn_readfirstlane(tid >> 6); } };
struct Args { const float* in[21]; float* out; unsigned char* ws; int ph_lo, ph_hi, bar_region, pad; };
typedef const __attribute__((address_space(4))) Args* ArgsP;
#define ARGS_PTR() ({ ArgsP p_ = (ArgsP)__builtin_amdgcn_kernarg_segment_ptr(); asm volatile("" : "+s"(p_)); p_; })
enum { I_X = 0, I_NORM1, I_WIN, I_SINKS, I_CDW, I_CDB, I_CLG, I_CLB, I_LCW, I_LCB, I_LWA, I_LBA, I_LWX, I_LBX, I_LAM, I_MIXN, I_WOUT, I_NORM2, I_WUP, I_WDOWN, I_FNORM };
constexpr int PH_PRO = 0, PH_L0 = 1, PH_PER_LAYER = 6, PH_FINAL = PH_L0 + DEPTH * PH_PER_LAYER, PH_N = PH_FINAL + 1;

template <bool REMAP> __device__ __forceinline__ void transpose_item(const float* W, const float* gain, int K, int N, bf16* WT, LAS float* scr, int item, int lane) {
    const int nblk = N / 32, kb = item / nblk, nb = item % nblk, k0 = 64 * kb, n0 = 32 * nb;
    int ns = n0; if (REMAP && n0 >= 768 && n0 < 1280) { const int t = n0 - 768, w = t & 255; ns = 768 + ((w >> 5) & 1) * 256 + (t >> 8) * 128 + (w >> 6) * 32; }
    f32x4 v[8]; float g[8];
#pragma unroll
    for (int i = 0; i < 8; ++i) { const int row = 8 * i + (lane >> 3); v[i] = __builtin_nontemporal_load((const GAS f32x4*)(W + (size_t)(k0 + row) * N + ns + 4 * (lane & 7)));     g[i] = gain ? gain[k0 + row] : 1.f; }
#pragma unroll
    for (int i = 0; i < 8; ++i) { const int row = 8 * i + (lane >> 3); *(LAS f32x4*)(scr + row * 36 + 4 * (lane & 7)) = v[i] * g[i]; }
    LDS_WAIT(); asm volatile("" ::: "memory");
    const int n = lane & 31, h = lane >> 5;
#pragma unroll
    for (int j = 0; j < 4; ++j) { const int kc = 2 * j + h; const LAS float* s = scr + (8 * kc) * 36 + n;
        v4u o; o.x = pk2(s[0 * 36], s[1 * 36]); o.y = pk2(s[2 * 36], s[3 * 36]); o.z = pk2(s[4 * 36], s[5 * 36]); o.w = pk2(s[6 * 36], s[7 * 36]);
        *(GAS v4u*)(WT + (size_t)(n0 + n) * K + k0 + 8 * kc) = o; }
    LDS_WAIT(); asm volatile("" ::: "memory");
}
constexpr int I_IN = (D / 64) * (NIN / 32), I_OUT = (D / 64) * (D / 32), I_UP = (D / 64) * (FF / 32), I_DN = (FF / 64) * (D / 32);
__device__ __forceinline__ void weight_item(ArgsP ap, int l, int mat, int r, LAS float* scr, int lane) {
    unsigned char* wl = ap->ws + WS_W + (size_t)l * W_LAYER;
    if (mat == 0)      transpose_item<true>(ap->in[I_WIN] + (size_t)l * D * NIN, ap->in[I_NORM1] + l * D, D, NIN, (bf16*)(wl + W_IN), scr, r, lane);
    else if (mat == 1) transpose_item<false>(ap->in[I_WOUT] + (size_t)l * D * D, ap->in[I_MIXN] + l * D, D, D, (bf16*)(wl + W_OUT), scr, r, lane);
    else if (mat == 2) transpose_item<false>(ap->in[I_WUP] + (size_t)l * D * FF, ap->in[I_NORM2] + l * D, D, FF, (bf16*)(wl + W_UP), scr, r, lane);
    else               transpose_item<false>(ap->in[I_WDOWN] + (size_t)l * FF * D, nullptr, FF, D, (bf16*)(wl + W_DOWN), scr, r, lane);
}
__device__ __forceinline__ void slack_weights(Frame& F, ArgsP ap, int l) {
    if (blockIdx.x < 128) return;
    const Lw L;
    LAS float* scr = (LAS float*)(F.lds + RING_OFF + L.wave * 16384);
    const int gw = ((int)blockIdx.x - 128) * NWAVES + L.wave, NGW = 128 * NWAVES;
    const int total = I_OUT + I_UP + I_DN + (l == 0 ? I_IN : 0);
    for (int it = gw; it < total; it += NGW) {
        int r = it;
        if (r < I_OUT) { weight_item(ap, l, 1, r, scr, L.lane); continue; } r -= I_OUT;
        if (r < I_UP) { weight_item(ap, l, 2, r, scr, L.lane); continue; } r -= I_UP;
        if (r < I_DN) { weight_item(ap, l, 3, r, scr, L.lane); continue; } r -= I_DN;
        weight_item(ap, 1, 0, r, scr, L.lane);
    }
}
__device__ __forceinline__ void rows_to_bf16_ss(int lane, const float* x, bf16* hb, float* ssp, int m0) {
    f32x4 v[4][4]; float s[4] = {0.f, 0.f, 0.f, 0.f};
#pragma unroll
    for (int q = 0; q < 4; ++q) { const GAS f32x4* xr = (const GAS f32x4*)(x + (size_t)(m0 + q) * D) + lane;
#pragma unroll
        for (int j = 0; j < 4; ++j) v[q][j] = __builtin_nontemporal_load(xr + 64 * j); }
#pragma unroll
    for (int q = 0; q < 4; ++q) {
#pragma unroll
        for (int j = 0; j < 4; ++j) s[q] += (v[q][j].x * v[q][j].x + v[q][j].y * v[q][j].y) + (v[q][j].z * v[q][j].z + v[q][j].w * v[q][j].w);
        s[q] = wave_sum(s[q]);
        GAS unsigned long long* o8 = (GAS unsigned long long*)(hb + (size_t)(m0 + q) * HB_LD) + lane;
#pragma unroll
        for (int j = 0; j < 4; ++j) o8[64 * j] = (unsigned long long)pk2(v[q][j].x, v[q][j].y) | ((unsigned long long)pk2(v[q][j].z, v[q][j].w) << 32);
    }
    if (lane < 16) *(GAS f32x4*)(ssp + pg8::ssp_idx(m0, lane)) = lane == 0 ? (f32x4){s[0], s[1], s[2], s[3]} : (f32x4){0.f, 0.f, 0.f, 0.f};
}
__device__ __forceinline__ void p0_prologue(Frame& F, ArgsP ap) {
    const Lw L;
    LAS float* scr = (LAS float*)(F.lds + RING_OFF + L.wave * 16384);
    const int gw = F.vcu * NWAVES + L.wave, NGW = F.G * NWAVES;
    for (int it = gw; it < I_IN; it += NGW) weight_item(ap, 0, 0, it, scr, L.lane);
    for (int it = gw; it < DEPTH * 64; it += NGW) { const int l = it >> 6, gate = (it >> 5) & 1, hd = (it >> 3) & 3, tn = (it >> 2) & 1, s = it & 3;
        const float* W = ap->in[gate ? I_LWX : I_LWA] + (size_t)l * 4 * 64 * 64; float t[8];
#pragma unroll
        for (int e = 0; e < 8; ++e) t[e] = W[(size_t)(hd * 64 + 16 * s + 8 * (L.lane >> 5) + e) * 64 + 32 * tn + (L.lane & 31)];
        v4u o; o.x = pk2(t[0], t[1]); o.y = pk2(t[2], t[3]); o.z = pk2(t[4], t[5]); o.w = pk2(t[6], t[7]);
        *(GAS v4u*)((bf16*)(ap->ws + WS_WFRAG) + (size_t)l * WFRAG_LAYER + (size_t)(it & 63) * 512 + L.lane * 8) = o; }
    bf16* hb = (bf16*)(ap->ws + WS_HB); float* ssp = (float*)(ap->ws + WS_SSP);
    for (int m = 4 * gw; m < M; m += 4 * NGW) rows_to_bf16_ss(L.lane, ap->in[I_X], hb, ssp, m);
}

__global__ void __launch_bounds__(NWAVES * 64, 2) skel_fwd(Args args) {
    extern __shared__ __attribute__((aligned(16))) unsigned char lds[];
    Frame F;
    F.lds = (LAS unsigned char*)lds;
    F.MISC = (volatile LAS unsigned*)(F.lds + MISC_OFF);
    F.G = gridDim.x; { const int bx = blockIdx.x; F.vcu = (F.G % 8 == 0) ? (bx % 8) * (F.G / 8) + bx / 8 : bx; }
    ArgsP ap0 = ARGS_PTR();
    unsigned char* ws = ap0->ws;
    F.ctl = (gu32*)(ws + WS_CTL);
    for (int u = otid(); u < (LDS_BYTES - LDSCTL_OFF) / 4; u += NWAVES * 64) ((LAS unsigned*)(F.lds + LDSCTL_OFF))[u] = 0u;
    __syncthreads();
    XcdBarrier bar = xcd_barrier_post((unsigned*)(F.ctl + CW_BAR) + ap0->bar_region * XCD_BAR_WORDS, F.MISC + 8);
    bf16* hb = (bf16*)(ws + WS_HB); float* ssp = (float*)(ws + WS_SSP); float* ssp2 = (float*)(ws + WS_SSP2); bf16* z = (bf16*)(ws + WS_Z); bf16* ymix = (bf16*)(ws + WS_YMIX); bf16* hh = (bf16*)(ws + WS_HH);

#ifndef MKEEP
#define MKEEP(x) true
#endif
constexpr unsigned INPROJ_PNPERM = 3u | (4u << 3) | (6u << 6) | (0u << 9) | (1u << 12) | (2u << 15) | (5u << 18);
#ifndef PROBE_KLOOP_PHASE
#define PROBE_KLOOP_AGAIN(l, k) do {} while (0)
#else
#define PROBE_KLOOP_AGAIN(l, k) do { if ((l) == 0 && (k) == PROBE_KLOOP_PHASE) { xcd_barrier(bar); pg8::EpiAny E2 = E; E2.mode = 9 + (int)__hip_atomic_load(F.ctl + 8, __ATOMIC_RELAXED, __HIP_MEMORY_SCOPE_AGENT); pg8::gemm_phase<pg8::EpiAny, pg8::StaticOrder, PG8_ALIGN, PG8_SP2>(F.lds + RING_OFF, g, S, E2); } } while (0)
#endif
#ifndef DOWN_REV
#define DOWN_REV 1
#endif
#ifndef PROBE_UP_AGAIN
#define PROBE_UP_AGAIN(l) do {} while (0)
#endif
#ifndef MREP
#define MREP(x) 1
#endif
#ifndef KEEP
#define KEEP(x) true
#endif
    const int lo = ap0->ph_lo, hi = ap0->ph_hi;
#define IN(p) (lo <= (p) && (p) < hi)
#define SEAM(p) do { if (IN(p) && IN((p) + 1)) xcd_barrier(bar); } while (0)
    if (IN(PH_PRO)) { p0_prologue(F, ARGS_PTR()); SEAM(PH_PRO); }
#if defined(PROBE_DRY)
#define DRYSEL(a, b) (ap0->pad != 0 ? (a) : (b))
#ifndef DRY_EMODE
#define DRY_EMODE 2
#endif
#else
#define DRYSEL(a, b) (b)
#endif
#define LAYER_BODY(l) do { \
        const int p = PH_L0 + l * PH_PER_LAYER; \
        unsigned char* wl = ws + WS_W + (size_t)l * W_LAYER; \
        if (IN(p) && KEEP(0)) { \
            pg8::Gemm g{hb, (const bf16*)(wl + W_IN), M, NIN, D, 1, HB_LD}; pg8::StaticOrder S; S.init(M, NIN, F.G, (int)blockIdx.x); S.pnperm = INPROJ_PNPERM; \
            const LAS float* rs_tab = (const LAS float*)(F.lds + mix::XCH_OFF); \
            { LAS float* tab = (LAS float*)(F.lds + mix::XCH_OFF); pg8::Unit u_; const int t_ = otid(); const int r_ = t_ >> 1, hf_ = t_ & 1; \
              f32x4 a_[4], b_[4]; bool ok_[4]; \
              _Pragma("unroll") for (int i_ = 0; i_ < 4; ++i_) { ok_[i_] = S.next(i_, u_); a_[i_] = (f32x4){0.f, 0.f, 0.f, 0.f}; b_[i_] = a_[i_]; \
                  if (ok_[i_]) { const float* p_ = ssp + pg8::ssp_idx(u_.pm * 256 + r_, 8 * hf_); _Pragma("unroll") for (int e_ = 0; e_ < 4; ++e_) { a_[i_][e_] = p_[16 * e_]; b_[i_][e_] = p_[16 * (4 + e_)]; } } } \
              _Pragma("unroll") for (int i_ = 0; i_ < 4; ++i_) { float s_ = ((a_[i_][0] + a_[i_][1]) + (a_[i_][2] + a_[i_][3])) + ((b_[i_][0] + b_[i_][1]) + (b_[i_][2] + b_[i_][3])); s_ += dppmov<0xB1>(s_); \
                  if (ok_[i_] && !hf_) tab[i_ * 256 + r_] = __builtin_amdgcn_rsqf(s_ * (1.0f / 1024.0f) + RMS_EPS); } \
              __syncthreads(); } \
            pg8::EpiAny E{0, z, NIN, nullptr, nullptr, 512, mix::QSCALE, rs_tab, nullptr, nullptr, nullptr, (bf16*)(ws + WS_UBUF)}; \
            pg8::gemm_phase<pg8::EpiAny, pg8::StaticOrder, PG8_ALIGN, PG8_SP2>(F.lds + RING_OFF, g, S, E); \
            slack_weights(F, ARGS_PTR(), l); \
            { ArgsP ap = ARGS_PTR(); mix::lru_tables(F.lds, ap->in[I_LCW] + l * 4 * 256, ap->in[I_LCB] + l * 256, ap->in[I_LBA] + l * 256, ap->in[I_LBX] + l * 256, ap->in[I_LAM] + l * 256, otid()); }     \
            SEAM(p); \
        } \
        if (IN(p + 1)) { \
            const int b = F.vcu >> 6, n = F.vcu & 63; ArgsP ap = ARGS_PTR(); \
            float* agg = (float*)(ws + mix::WS_AGG); \
            for (int rep_ = 0; rep_ < MREP(0); ++rep_) mix::attn_unit(F.lds, z, ymix, ap->in[I_SINKS] + l * 8, b, n, otid()); \
            for (int rep_ = 0; rep_ < MREP(1); ++rep_) mix::conv_unit(F.lds, (const bf16*)(ws + WS_UBUF), ymix, ap->in[I_CDW] + l * 31 * 256, ap->in[I_CDB] + l * 256, ap->in[I_CLG] + l * 256, ap->in[I_CLB] + l * 256, b, n, otid()); \
            mix::LruState st; \
            for (int rep_ = 0; rep_ < MREP(2); ++rep_) mix::lru_local(st, z, (const bf16*)(ws + WS_WFRAG) + (size_t)l * WFRAG_LAYER, agg, F.lds, b, n, otid()); \
            xcd_barrier(bar); \
            if (MKEEP(3)) mix::lru_final(st, F.lds, z, ymix, agg, b, n, otid()); \
            SEAM(p + 1); \
        } \
        if (IN(p + 3) && KEEP(3)) { \
            pg8::Gemm g{ymix, (const bf16*)(wl + W_OUT), M, D, D, 1, YM_LD}; pg8::StaticOrder S; S.init(M, D, F.G, (int)blockIdx.x); \
            pg8::EpiAny E{DRYSEL(DRY_EMODE, 2), DRYSEL((bf16*)(ws + 66 * MiB), hb), HB_LD, nullptr, DRYSEL((float*)(ws + 140 * MiB), ssp2), 0, 1.f, nullptr, nullptr, nullptr, nullptr, nullptr, DRYSEL((bf16*)(ws + 66 * MiB), hb)}; \
            pg8::gemm_phase<pg8::EpiAny, pg8::StaticOrder, PG8_ALIGN, PG8_SP2>(F.lds + RING_OFF, g, S, E); \
            PROBE_KLOOP_AGAIN(l, 3); \
            SEAM(p + 3); \
        } \
        if (IN(p + 4) && KEEP(4)) { \
            pg8::Gemm g{hb, (const bf16*)(wl + W_UP), M, FF, D, 1, HB_LD}; pg8::StaticOrder S; S.init(M, FF, F.G, (int)blockIdx.x); \
            pg8::EpiAny E{1, hh, HH_LD, nullptr, nullptr, 0, 1.f, nullptr, nullptr, nullptr, nullptr, nullptr}; \
            pg8::gemm_phase<pg8::EpiAny, pg8::StaticOrder, PG8_ALIGN, PG8_SP2>(F.lds + RING_OFF, g, S, E); \
            PROBE_UP_AGAIN(l); \
            SEAM(p + 4); \
        } \
        if (IN(p + 5) && KEEP(5)) { \
            pg8::Gemm g{hh, (const bf16*)(wl + W_DOWN), M, D, FF, 1, HH_LD}; pg8::StaticOrder S; S.init(M, D, F.G, (int)blockIdx.x); S.rev16 = DOWN_REV; \
            ArgsP ap = ARGS_PTR(); \
            pg8::EpiAny E{l == DEPTH - 1 ? 4 : 3, hb, HB_LD, ssp2, ssp, D  , 1.f, nullptr, ap->out, ap->in[I_FNORM], (unsigned*)(F.ctl + CW_FIN), nullptr, hb}; \
            pg8::gemm_phase<pg8::EpiAny, pg8::StaticOrder, PG8_ALIGN, PG8_SP2>(F.lds + RING_OFF, g, S, E); \
            PROBE_KLOOP_AGAIN(l, 5); \
            if (l < DEPTH - 1) SEAM(p + 5); \
        } \
     \
    } while (0)
    LAYER_BODY(0);
    LAYER_BODY(1);
#undef LAYER_BODY
    static_assert(DEPTH == 2, "two layer bodies are expanded by hand");
#undef IN
#undef SEAM
}


#if defined(PROBE_DRY)
#define PROBE_WS_EXTRA 0
#else
#define PROBE_WS_EXTRA 0
#endif
#ifndef MK_N_LAUNCHES
#define MK_N_LAUNCHES 1
#endif
extern "C" void kernel_launch(void* const* d_in, const int* in_sizes, int n_in, void* d_out, int out_size, void* d_ws, size_t ws_size, hipStream_t stream) {
    static int grid = 0;
    if (grid == 0) {
        if (n_in != 21 || in_sizes[0] != M * D || out_size != M * D || ws_size < WS_END + PROBE_WS_EXTRA) {
            fprintf(stderr, "kernel_launch: unexpected shapes n_in %d in0 %d out %d ws %zu\n", n_in, n_in > 0 ? in_sizes[0] : -1, out_size, ws_size); grid = -1; return; }
        int dev = 0, cus = 0;
        if (hipGetDevice(&dev) != hipSuccess || hipDeviceGetAttribute(&cus, hipDeviceAttributeMultiprocessorCount, dev) != hipSuccess) { grid = -1; return; }
        if (hipFuncSetAttribute((const void*)skel_fwd, hipFuncAttributeMaxDynamicSharedMemorySize, LDS_BYTES) != hipSuccess) { fprintf(stderr, "kernel_launch: hipFuncSetAttribute failed\n"); grid = -1; return; }
        grid = cus;
        if (grid != 256) { fprintf(stderr, "kernel_launch: built for 256 CUs, found %d\n", cus); grid = -1; return; }
    }
    if (grid < 0) return;
    (void)hipMemsetAsync((char*)d_ws + WS_CTL, 0, CTL_ZERO_BYTES, stream);
    Args a{};
    for (int i = 0; i < 21; ++i) a.in[i] = (const float*)d_in[i];
    a.out = (float*)d_out; a.ws = (unsigned char*)d_ws;
    int region = 0;
#define SKEL(lo, hi) do { a.ph_lo = (lo); a.ph_hi = (hi); a.bar_region = region++; hipLaunchKernelGGL(skel_fwd, dim3(grid), dim3(NWAVES * 64), LDS_BYTES, stream, a); } while (0)
#if defined(PROBE_DRY)
    SKEL(PH_PRO, PH_L0 + PROBE_DRY); a.pad = 1; SKEL(PH_L0 + PROBE_DRY, PH_L0 + PROBE_DRY + 1); a.pad = 0; SKEL(PH_L0 + PROBE_DRY, PH_N);
#elif defined(PROBE_REPEAT)
    SKEL(PH_PRO, PROBE_REPEAT + 1); SKEL(PROBE_REPEAT, PROBE_REPEAT + 1); SKEL(PROBE_REPEAT + 1, PH_N);
#elif MK_N_LAUNCHES == 1
    SKEL(PH_PRO, PH_N);
#else
    SKEL(PH_PRO, PH_PRO + 1);
    for (int l = 0; l < DEPTH; ++l) { const int p = PH_L0 + l * PH_PER_LAYER; SKEL(p, p + 1); SKEL(p + 1, p + 2); SKEL(p + 3, p + 4); SKEL(p + 4, p + 5); SKEL(p + 5, p + 6); }
    SKEL(PH_FINAL, PH_FINAL + 1);
#endif
#undef SKEL
}
```
